# Optimizing an MI355X kernel written in HIP

```python
import jax, jax.numpy as jnp
from jax import lax
import numpy as np

D_MODEL = 1024
BATCH = 4
SEQ = 8192
DEPTH = 2

GRID_W = 64
CTX_LEN = 256
ROPE_BASE = 10000.0
NORM_EPS = 1e-6

RET_HEADS = 4
RET_DK = 64
RET_DV = 64
RET_CHUNK = 128
FOURIER_GROUPS = 4
FOURIER_GROUP_DIM = 64
NA_HEADS = 4
NA_HEAD_DIM = 64
NA_WIN_R = 8
NA_WIN_C = 16
MLA_HEADS = 4
MLA_NOPE = 64
MLA_ROPE = 32
MLA_V = 64
MLA_Q_RANK = 192
MLA_KV_RANK = 128
N_BRANCHES = 4
BRANCH_WIDTH = 256
Q_BLOCK = 128
FFN_DIM = 2816
MOE_EXPERTS = 8
MOE_TOP_K = 2
MOE_FFN_DIM = 3584
MOE_BLOCK = 256

KV_SIZES = (RET_HEADS * RET_DK, RET_HEADS * RET_DV, NA_HEADS * NA_HEAD_DIM, NA_HEADS * NA_HEAD_DIM,
            MLA_KV_RANK, MLA_ROPE)
Q_SIZES = (RET_HEADS * RET_DK, RET_HEADS * RET_DV, RET_HEADS * RET_DV,
           FOURIER_GROUPS * FOURIER_GROUP_DIM, NA_HEADS * NA_HEAD_DIM, MLA_Q_RANK,
           N_BRANCHES * D_MODEL)
KV_COLS = sum(KV_SIZES)
IN_COLS = KV_COLS + sum(Q_SIZES)

kernel_name = "hybrid_diffusion_parallel_mixer_trunk"


def rmsnorm(x, g):
    xf = x.astype(jnp.float32)
    y = xf * lax.rsqrt(jnp.mean(xf * xf, axis=-1, keepdims=True) + NORM_EPS)
    return (y * g.astype(jnp.float32)).astype(x.dtype)


def split_sizes(t, sizes):
    return jnp.split(t, [int(s) for s in np.cumsum(sizes)[:-1]], axis=-1)


def split_heads(t, n_heads):
    return t.reshape(*t.shape[:-1], n_heads, -1)


def axial_rope_tables(n, rot_dim):
    t = jnp.arange(n)
    row = (t // GRID_W).astype(jnp.float32)
    col = (t % GRID_W).astype(jnp.float32)
    nf = rot_dim // 4
    inv = ROPE_BASE ** (-jnp.arange(nf, dtype=jnp.float32) / nf)
    ang = jnp.concatenate([row[:, None] * inv, col[:, None] * inv], axis=-1)
    return jnp.cos(ang), jnp.sin(ang)


def apply_rope(x, cos, sin):
    half = x.shape[-1] // 2
    x1, x2 = x[..., :half], x[..., half:]
    c, s = cos[:, None, :], sin[:, None, :]
    return jnp.concatenate([x1 * c - x2 * s, x2 * c + x1 * s], axis=-1).astype(x.dtype)


def block_attention(q, k, v, scale):
    B, T, H, dq = q.shape
    nb = T // Q_BLOCK
    qb = jnp.moveaxis(q.reshape(B, nb, Q_BLOCK, H, dq), 1, 0)

    def attend(q_blk):
        s = jnp.einsum('bqhd,bkhd->bhqk', q_blk, k).astype(jnp.float32) * scale
        p = jax.nn.softmax(s, axis=-1).astype(v.dtype)
        return jnp.einsum('bhqk,bkhe->bqhe', p, v)

    o = lax.map(attend, qb)
    return jnp.moveaxis(o, 0, 1).reshape(B, T, H * v.shape[-1])


def retention_scan(q, k, v, log_gamma, s0):
    B, T, H, dk = q.shape
    dv = v.shape[-1]
    C = RET_CHUNK
    n = T // C
    qc = q.reshape(B, n, C, H, dk)
    kc = k.reshape(B, n, C, H, dk)
    vc = v.reshape(B, n, C, H, dv)
    pos = jnp.arange(C, dtype=jnp.float32)
    diff = pos[:, None] - pos[None, :]
    mask = jnp.where(diff >= 0, jnp.exp(log_gamma[:, None, None] * jnp.maximum(diff, 0.0)), 0.0)
    inner = jnp.einsum('bnhij,bnjhe->bnihe',
                       jnp.einsum('bnihd,bnjhd->bnhij', qc, kc) * mask, vc)
    k_w = jnp.exp(log_gamma[None, :] * (C - 1.0 - pos)[:, None])
    d_state = jnp.einsum('bnjhd,bnjhe->nbhde', kc * k_w[:, :, None], vc)
    chunk_decay = jnp.exp(log_gamma * C)[None, :, None, None]

    def step(s_prev, ds):
        return chunk_decay * s_prev + ds, s_prev

    s_final, s_before = lax.scan(step, s0, d_state)
    q_w = jnp.exp(log_gamma[None, :] * (pos + 1.0)[:, None])
    cross = jnp.einsum('bnihd,nbhde->bnihe', qc * q_w[:, :, None], s_before)
    return (inner + cross).reshape(B, T, H, dv), s_final


def retention_state(k, v, log_gamma):
    T = k.shape[1]
    w = jnp.exp(log_gamma[None, :] * (T - 1.0 - jnp.arange(T, dtype=jnp.float32))[:, None])
    return jnp.einsum('bthd,bthe->bhde', k * w[:, :, None], v)


def head_rms(o):
    o = o * lax.rsqrt(jnp.mean(o * o, axis=-1, keepdims=True) + NORM_EPS)
    return o.reshape(*o.shape[:2], -1)


def gate_directions(o_f, o_b, g_f, g_b):
    dt = g_f.dtype
    return jax.nn.silu(g_f) * head_rms(o_f).astype(dt) + jax.nn.silu(g_b) * head_rms(o_b).astype(dt)


def retention_branch(q, k, v, g_f, g_b, qc, kc, vc, gc_f, gc_b, decay_f, decay_b, rope):
    f32 = jnp.float32
    cos, sin = rope
    lg_f = jax.nn.log_sigmoid(decay_f.astype(f32))
    lg_b = jax.nn.log_sigmoid(decay_b.astype(f32))
    scale = RET_DK ** -0.5
    q = apply_rope(split_heads(q, RET_HEADS).astype(f32), cos, sin)
    k = apply_rope(split_heads(k, RET_HEADS).astype(f32), cos, sin) * scale
    v = split_heads(v, RET_HEADS).astype(f32)
    kc = split_heads(kc, RET_HEADS).astype(f32) * scale
    vc = split_heads(vc, RET_HEADS).astype(f32)
    flip = lambda t: jnp.flip(t, axis=1)
    if qc is None:
        s_f = retention_state(kc, vc, lg_f)
        s_b = retention_state(flip(kc), flip(vc), lg_b)
        yc = None
    else:
        zero = jnp.zeros((q.shape[0], RET_HEADS, RET_DK, RET_DV), f32)
        qc = split_heads(qc, RET_HEADS).astype(f32)
        oc_f, s_f = retention_scan(qc, kc, vc, lg_f, zero)
        oc_b, s_b = retention_scan(flip(qc), flip(kc), flip(vc), lg_b, zero)
        yc = gate_directions(oc_f, flip(oc_b), gc_f, gc_b)
    o_f, _ = retention_scan(q, k, v, lg_f, s_f)
    o_b, _ = retention_scan(flip(q), flip(k), flip(v), lg_b, s_b)
    y = gate_directions(o_f, flip(o_b), g_f, g_b)
    return y, yc


def fourier_mix(f):
    B, T, _ = f.shape
    fg = f.astype(jnp.float32).reshape(B, T, FOURIER_GROUPS, FOURIER_GROUP_DIM)
    spec = jnp.fft.fft2(fg, axes=(1, 3), norm='ortho')
    return jnp.real(spec).reshape(B, T, -1).astype(f.dtype)


def na_branch(q, k, v, qc, kc, vc, rpb):
    B, N, _ = q.shape
    rows = N // GRID_W
    wr = min(NA_WIN_R, rows)
    wc = NA_WIN_C
    n_loc = wr * wc
    scale = NA_HEAD_DIM ** -0.5
    qg = q.reshape(B, rows, GRID_W, NA_HEADS, NA_HEAD_DIM)
    kg = k.reshape(B, rows, GRID_W, NA_HEADS, NA_HEAD_DIM)
    vg = v.reshape(B, rows, GRID_W, NA_HEADS, NA_HEAD_DIM)
    kc = split_heads(kc, NA_HEADS)
    vc = split_heads(vc, NA_HEADS)
    cols = jnp.arange(GRID_W)
    col_idx = jnp.clip(cols - wc // 2, 0, GRID_W - wc)[:, None] + jnp.arange(wc)[None, :]
    col_bias_idx = col_idx - cols[:, None] + (NA_WIN_C - 1)
    rpb_f = rpb.astype(jnp.float32)

    def row_block(r):
        rs = jnp.clip(r - wr // 2, 0, rows - wr)
        q_r = lax.dynamic_index_in_dim(qg, r, axis=1, keepdims=False)
        k_r = lax.dynamic_slice_in_dim(kg, rs, wr, axis=1)[:, :, col_idx]
        v_r = lax.dynamic_slice_in_dim(vg, rs, wr, axis=1)[:, :, col_idx]
        k_r = jnp.moveaxis(k_r, 2, 1).reshape(B, GRID_W, n_loc, NA_HEADS, NA_HEAD_DIM)
        v_r = jnp.moveaxis(v_r, 2, 1).reshape(B, GRID_W, n_loc, NA_HEADS, NA_HEAD_DIM)
        row_bias_idx = rs + jnp.arange(wr) - r + (NA_WIN_R - 1)
        bias = rpb_f[:, row_bias_idx][:, :, col_bias_idx]
        bias = bias.transpose(0, 2, 1, 3).reshape(NA_HEADS, GRID_W, n_loc)
        s_loc = jnp.einsum('bqhd,bqkhd->bhqk', q_r, k_r).astype(jnp.float32) * scale + bias
        s_ctx = jnp.einsum('bqhd,bkhd->bhqk', q_r, kc).astype(jnp.float32) * scale
        p = jax.nn.softmax(jnp.concatenate([s_loc, s_ctx], axis=-1), axis=-1).astype(v.dtype)
        return (jnp.einsum('bhqk,bqkhd->bqhd', p[..., :n_loc], v_r)
                + jnp.einsum('bhqk,bkhd->bqhd', p[..., n_loc:], vc))

    o = lax.map(row_block, jnp.arange(rows))
    y = jnp.moveaxis(o, 0, 1).reshape(B, N, NA_HEADS * NA_HEAD_DIM)
    yc = None if qc is None else block_attention(split_heads(qc, NA_HEADS), kc, vc, scale)
    return y, yc


def mla_keys(c_kv, k_rope, kv_norm, w_ukv, rope):
    B, T, _ = c_kv.shape
    kv = split_heads(rmsnorm(c_kv, kv_norm) @ w_ukv, MLA_HEADS)
    k_nope, v = kv[..., :MLA_NOPE], kv[..., MLA_NOPE:]
    k_rope = k_rope[:, :, None, :]
    if rope is not None:
        k_rope = apply_rope(k_rope, *rope)
    k = jnp.concatenate([k_nope, jnp.broadcast_to(k_rope, (B, T, MLA_HEADS, MLA_ROPE))], axis=-1)
    return k, v


def mla_queries(c_q, q_norm, w_uq, rope):
    q = split_heads(rmsnorm(c_q, q_norm) @ w_uq, MLA_HEADS)
    q_nope, q_rope = q[..., :MLA_NOPE], q[..., MLA_NOPE:]
    if rope is not None:
        q_rope = apply_rope(q_rope, *rope)
    return jnp.concatenate([q_nope, q_rope], axis=-1)


def mla_branch(c_q, c_kv, k_r, cc_q, cc_kv, ck_r, q_norm, kv_norm, w_uq, w_ukv, rope):
    scale = (MLA_NOPE + MLA_ROPE) ** -0.5
    k, v = mla_keys(c_kv, k_r, kv_norm, w_ukv, rope)
    kc, vc = mla_keys(cc_kv, ck_r, kv_norm, w_ukv, None)
    q = mla_queries(c_q, q_norm, w_uq, rope)
    y = block_attention(q, jnp.concatenate([k, kc], axis=1), jnp.concatenate([v, vc], axis=1), scale)
    yc = None if cc_q is None else block_attention(mla_queries(cc_q, q_norm, w_uq, None), kc, vc, scale)
    return y, yc


def merge_branches(branches, gate_cols, w_branch, w_out):
    B, T, _ = gate_cols.shape
    g = jax.nn.sigmoid(gate_cols.reshape(B, T, N_BRANCHES, D_MODEL))
    m = g[:, :, 0] * (branches[0] @ w_branch[0])
    for i in range(1, N_BRANCHES):
        m = m + g[:, :, i] * (branches[i] @ w_branch[i])
    return m @ w_out


def mixer_sublayer(h, hc, w_in, decay_f, decay_b, q_norm, kv_norm, w_uq, w_ukv, rpb, w_branch, w_out,
                   ret_rope, mla_rope, ctx_out):
    u = h @ w_in
    r_k, r_v, n_k, n_v, m_ckv, m_kr = split_sizes(u[..., :KV_COLS], KV_SIZES)
    r_q, r_gf, r_gb, f_in, n_q, m_cq, gate = split_sizes(u[..., KV_COLS:], Q_SIZES)
    if ctx_out:
        uc = hc @ w_in
        c_qside = split_sizes(uc[..., KV_COLS:], Q_SIZES)
    else:
        uc = hc @ w_in[:, :KV_COLS]
        c_qside = (None,) * len(Q_SIZES)
    cr_k, cr_v, cn_k, cn_v, cm_ckv, cm_kr = split_sizes(uc[..., :KV_COLS], KV_SIZES)
    cr_q, cr_gf, cr_gb, cf_in, cn_q, cm_cq, cgate = c_qside

    y_ret, yc_ret = retention_branch(r_q, r_k, r_v, r_gf, r_gb, cr_q, cr_k, cr_v, cr_gf, cr_gb,
                                     decay_f, decay_b, ret_rope)
    y_four = fourier_mix(f_in)
    y_na, yc_na = na_branch(n_q, n_k, n_v, cn_q, cn_k, cn_v, rpb)
    y_mla, yc_mla = mla_branch(m_cq, m_ckv, m_kr, cm_cq, cm_ckv, cm_kr, q_norm, kv_norm, w_uq, w_ukv, mla_rope)
    y = merge_branches((y_ret, y_four, y_na, y_mla), gate, w_branch, w_out)
    if not ctx_out:
        return y, None
    yc = merge_branches((yc_ret, fourier_mix(cf_in), yc_na, yc_mla), cgate, w_branch, w_out)
    return y, yc


def swiglu(h, w_gate, w_up, w_down):
    return (jax.nn.silu(h @ w_gate) * (h @ w_up)) @ w_down


def moe_swiglu(h, router, w_gate, w_up, w_down):
    B, T, D = h.shape
    hf = h.reshape(-1, D)
    n_tok = hf.shape[0]
    logits = (hf @ router).astype(jnp.float32)
    top_logit, top_idx = lax.top_k(logits, MOE_TOP_K)
    top_w = jax.nn.softmax(top_logit, axis=-1)
    n_assign = n_tok * MOE_TOP_K
    exp_flat = top_idx.reshape(-1)
    tok_flat = jnp.repeat(jnp.arange(n_tok, dtype=jnp.int32), MOE_TOP_K)
    order = jnp.argsort(exp_flat)
    exp_sorted = exp_flat[order]
    tok_sorted = tok_flat[order]
    w_sorted = top_w.reshape(-1)[order]
    counts = jnp.bincount(exp_flat, length=MOE_EXPERTS)
    padded = (counts + MOE_BLOCK - 1) // MOE_BLOCK * MOE_BLOCK
    pad_end = jnp.cumsum(padded)
    pad_start = pad_end - padded
    grp_start = jnp.cumsum(counts) - counts
    dest = pad_start[exp_sorted] + jnp.arange(n_assign) - grp_start[exp_sorted]
    n_rows = -(-n_assign // MOE_BLOCK) * MOE_BLOCK + MOE_EXPERTS * MOE_BLOCK
    n_blocks = n_rows // MOE_BLOCK
    row_tok = jnp.full((n_rows,), n_tok, jnp.int32).at[dest].set(tok_sorted)
    h_pad = jnp.concatenate([hf, jnp.zeros((1, D), hf.dtype)], axis=0)
    xb = h_pad[row_tok].reshape(n_blocks, MOE_BLOCK, D)
    blk_start = jnp.arange(n_blocks) * MOE_BLOCK
    blk_exp = jnp.minimum(jnp.sum(pad_end[None, :] <= blk_start[:, None], axis=1), MOE_EXPERTS - 1)

    def expert_block(args):
        x_blk, e = args
        return (jax.nn.silu(x_blk @ w_gate[e]) * (x_blk @ w_up[e])) @ w_down[e]

    yb = lax.map(expert_block, (xb, blk_exp)).reshape(n_rows, D)
    y_assign = yb[dest] * w_sorted[:, None].astype(yb.dtype)
    out = jnp.zeros_like(hf).at[tok_sorted].add(y_assign)
    return out.reshape(B, T, D)


def setup_inputs(seed: int = 0) -> dict:
    key = jax.random.key(seed)
    ks = iter(jax.random.split(key, 32))

    def nrm(shape, std):
        return jax.random.normal(next(ks), shape, jnp.float32) * std

    n_dense = (DEPTH + 1) // 2
    n_moe = DEPTH // 2
    d_in = D_MODEL ** -0.5
    decay0 = jnp.asarray(np.log(2.0 ** (5.0 + np.arange(RET_HEADS)) - 1.0), jnp.float32)
    return {
        'x': nrm((BATCH, SEQ, D_MODEL), 1.0),
        'c': nrm((BATCH, D_MODEL), 1.0),
        'ctx': nrm((BATCH, CTX_LEN, D_MODEL), 1.0),
        'c_ctx': nrm((D_MODEL,), 1.0),
        'ada_w': nrm((DEPTH, D_MODEL, 6 * D_MODEL), 0.5 * d_in),
        'ada_b': nrm((DEPTH, 6 * D_MODEL), 0.01),
        'norm_mix': 1.0 + nrm((DEPTH, D_MODEL), 0.01),
        'norm_ffn': 1.0 + nrm((DEPTH, D_MODEL), 0.01),
        'w_in': nrm((DEPTH, D_MODEL, IN_COLS), d_in),
        'ret_decay_fwd': decay0[None, :] + nrm((DEPTH, RET_HEADS), 0.01),
        'ret_decay_bwd': decay0[None, :] + nrm((DEPTH, RET_HEADS), 0.01),
        'mla_q_norm': 1.0 + nrm((DEPTH, MLA_Q_RANK), 0.01),
        'mla_kv_norm': 1.0 + nrm((DEPTH, MLA_KV_RANK), 0.01),
        'mla_w_uq': nrm((DEPTH, MLA_Q_RANK, MLA_HEADS * (MLA_NOPE + MLA_ROPE)), MLA_Q_RANK ** -0.5),
        'mla_w_ukv': nrm((DEPTH, MLA_KV_RANK, MLA_HEADS * (MLA_NOPE + MLA_V)), MLA_KV_RANK ** -0.5),
        'na_rpb': nrm((DEPTH, NA_HEADS, 2 * NA_WIN_R - 1, 2 * NA_WIN_C - 1), 0.02),
        'w_branch': nrm((DEPTH, N_BRANCHES, BRANCH_WIDTH, D_MODEL), BRANCH_WIDTH ** -0.5),
        'w_out': nrm((DEPTH, D_MODEL, D_MODEL), d_in),
        'ffn_w_gate': nrm((n_dense, D_MODEL, FFN_DIM), d_in),
        'ffn_w_up': nrm((n_dense, D_MODEL, FFN_DIM), d_in),
        'ffn_w_down': nrm((n_dense, FFN_DIM, D_MODEL), FFN_DIM ** -0.5),
        'moe_router': nrm((n_moe, D_MODEL, MOE_EXPERTS), d_in),
        'moe_w_gate': nrm((n_moe, MOE_EXPERTS, D_MODEL, MOE_FFN_DIM), d_in),
        'moe_w_up': nrm((n_moe, MOE_EXPERTS, D_MODEL, MOE_FFN_DIM), d_in),
        'moe_w_down': nrm((n_moe, MOE_EXPERTS, MOE_FFN_DIM, D_MODEL), MOE_FFN_DIM ** -0.5),
        'norm_final': 1.0 + nrm((D_MODEL,), 0.01),
    }


def reference(x, c, ctx, c_ctx, ada_w, ada_b, norm_mix, norm_ffn, w_in, ret_decay_fwd, ret_decay_bwd,
              mla_q_norm, mla_kv_norm, mla_w_uq, mla_w_ukv, na_rpb, w_branch, w_out,
              ffn_w_gate, ffn_w_up, ffn_w_down, moe_router, moe_w_gate, moe_w_up, moe_w_down, norm_final):
    n_lat = x.shape[1]
    ret_rope = axial_rope_tables(n_lat, RET_DK)
    mla_rope = axial_rope_tables(n_lat, MLA_ROPE)
    xc = ctx
    for i in range(DEPTH):
        ctx_out = i < DEPTH - 1
        mod = (jax.nn.silu(c) @ ada_w[i] + ada_b[i])[:, None, :]
        mod_c = (jax.nn.silu(c_ctx) @ ada_w[i] + ada_b[i])[None, None, :]
        sh1, sc1, g1, sh2, sc2, g2 = jnp.split(mod, 6, axis=-1)
        csh1, csc1, cg1, csh2, csc2, cg2 = jnp.split(mod_c, 6, axis=-1)

        h = rmsnorm(x, norm_mix[i]) * (1 + sc1) + sh1
        hc = rmsnorm(xc, norm_mix[i]) * (1 + csc1) + csh1
        y, yc = mixer_sublayer(h, hc, w_in[i], ret_decay_fwd[i], ret_decay_bwd[i], mla_q_norm[i],
                               mla_kv_norm[i], mla_w_uq[i], mla_w_ukv[i], na_rpb[i], w_branch[i], w_out[i],
                               ret_rope, mla_rope, ctx_out)
        x = x + g1 * y

        j = i // 2
        if i % 2 == 0:
            ffn = lambda t: swiglu(t, ffn_w_gate[j], ffn_w_up[j], ffn_w_down[j])
        else:
            ffn = lambda t: moe_swiglu(t, moe_router[j], moe_w_gate[j], moe_w_up[j], moe_w_down[j])
        x = x + g2 * ffn(rmsnorm(x, norm_ffn[i]) * (1 + sc2) + sh2)
        if ctx_out:
            xc = xc + cg1 * yc
            xc = xc + cg2 * ffn(rmsnorm(xc, norm_ffn[i]) * (1 + csc2) + csh2)
    return rmsnorm(x, norm_final)
```

```cpp
#include <hip/hip_runtime.h>
#include <stdint.h>
#include <stdio.h>

#define LAS __attribute__((address_space(3)))
typedef unsigned short bf16_t;
typedef short bf16x8 __attribute__((ext_vector_type(8)));
typedef float f32x2 __attribute__((ext_vector_type(2)));
typedef float f32x4 __attribute__((ext_vector_type(4)));
typedef float f32x16 __attribute__((ext_vector_type(16)));
typedef unsigned u32x2 __attribute__((ext_vector_type(2)));
typedef unsigned u32x4 __attribute__((ext_vector_type(4)));

#define DBG_S0 2
#define DBG_S1 3
#ifndef N_LAUNCH_MODE
#define N_LAUNCH_MODE 0
#endif

constexpr int NB = 4, SEQ = 8192, DM = 1024, CTXL = 256;
constexpr int ML = NB * SEQ, MC = NB * CTXL, MT = ML + MC;
constexpr int INC = 6752;
constexpr int UT = 11;
constexpr int FF = 2816, MF = 3584, NE = 8;
constexpr int NRMAX = 65536 + 2048;
constexpr float EPS = 1e-6f;
constexpr float LOG2E = 1.4426950408889634f;

constexpr size_t MiB = 1u << 20;
constexpr size_t WS_CTL = 0;
constexpr size_t WS_MOD = 1 * MiB;
constexpr size_t WS_ROPER = WS_MOD + 256 * 1024;
constexpr size_t WS_ROPEM = WS_ROPER + 2 * MiB;
constexpr size_t WS_M1 = WS_ROPEM + 1 * MiB;
constexpr size_t WS_TW = WS_M1 + 64 * 1024;
constexpr size_t WS_D2 = WS_TW + 64 * 1024;
constexpr size_t WS_EP = WS_D2 + 32 * 1024;
constexpr size_t WS_XC = WS_EP + 16 * 1024;
constexpr size_t WS_CPQ = WS_XC + 4 * MiB;
constexpr size_t WS_WUQ = WS_CPQ + 2 * MiB;
constexpr size_t WS_WUKV = WS_WUQ + 512 * 1024;
constexpr size_t WS_ROWINFO = WS_WUKV + 512 * 1024;
constexpr size_t WS_ROWW = WS_ROWINFO + 512 * 1024;
constexpr size_t WS_TOK = WS_ROWW + 512 * 1024;
constexpr size_t WS_TILEE = WS_TOK + 512 * 1024;
constexpr size_t WS_R0END = 16 * MiB;
static_assert(WS_TILEE + 4096 <= WS_R0END, "R0");
constexpr size_t WS_WNG = WS_R0END;
constexpr size_t WS_WG = WS_WNG + (size_t)2 * 2816 * 1024 * 2;
constexpr size_t WS_WB = WS_WG + (size_t)2 * 4096 * 1024 * 2;
constexpr size_t WS_WO = WS_WB + (size_t)2 * 4 * 1024 * 256 * 2;
constexpr size_t WS_WGU = WS_WO + (size_t)2 * 1024 * 1024 * 2;
constexpr size_t WS_WD = WS_WGU + (size_t)5632 * 1024 * 2;
constexpr size_t WS_RWEND = WS_WD + (size_t)1024 * 2816 * 2;
constexpr size_t WS_H = WS_RWEND;
constexpr size_t WS_YBR = WS_H + (size_t)MT * 1024 * 2;
constexpr size_t WS_MSCR = WS_YBR + (size_t)MT * 1024 * 2;
constexpr size_t WS_BIG = WS_MSCR + (size_t)256 * 262144;
constexpr size_t WS_U = WS_BIG;
constexpr size_t WS_ST = WS_U + (size_t)UT * MT * 256 * 2;
constexpr size_t WS_STC = WS_ST + (size_t)2 * 16 * 64 * 4096 * 4;
constexpr size_t WS_A2 = WS_STC + (size_t)2 * 16 * 2 * 4096 * 4;
constexpr size_t WS_MQ = WS_A2 + (size_t)4 * 64 * 128 * 256 * 4;
constexpr size_t WS_MQC = WS_MQ + (size_t)16 * 8192 * 96 * 2;
constexpr size_t WS_MK = WS_MQC + (size_t)16 * 256 * 96 * 2;
constexpr size_t WS_MVT = WS_MK + (size_t)16 * 8448 * 96 * 2;
constexpr size_t WS_BIGEND = WS_MVT + (size_t)16 * 64 * 8448 * 2;
constexpr size_t WS_SG = WS_BIG;
constexpr size_t WS_HID = WS_BIG;
static_assert(WS_SG + (size_t)MT * 4096 * 2 <= WS_BIGEND, "SG overlay");
constexpr size_t WS_MWGU = WS_R0END;
constexpr size_t WS_MWD = WS_MWGU + (size_t)8 * 7168 * 1024 * 2;
constexpr size_t WS_XG = WS_MWD + (size_t)8 * 1024 * 3584 * 2;
constexpr size_t WS_HIDM = WS_XG + (size_t)NRMAX * 1024 * 2;
constexpr size_t WS_Y01 = WS_HIDM + (size_t)16384 * 3584 * 2;
constexpr size_t WS_MOEEND = WS_Y01 + (size_t)2 * ML * 1024 * 2;
constexpr size_t WS_NEED = WS_BIGEND > WS_MOEEND ? WS_BIGEND : WS_MOEEND;

constexpr int CW_BAR = 0, CW_Q = 4096, CW_CNT = 8192, CW_CUR = 8256;

constexpr int LDS_BYTES = 147456;
constexpr int LDS_MISC = 143360;

__device__ __forceinline__ float bf2f(unsigned h) { return __uint_as_float(h << 16); }
__device__ __forceinline__ float bflo(unsigned w) { return __uint_as_float(w << 16); }
__device__ __forceinline__ float bfhi(unsigned w) { return __uint_as_float(w & 0xffff0000u); }
typedef __bf16 bf16x2_t __attribute__((ext_vector_type(2)));
__device__ __forceinline__ unsigned pk2(float lo, float hi) { f32x2 v = {lo, hi}; bf16x2_t b = __builtin_convertvector(v, bf16x2_t); return __builtin_bit_cast(unsigned, b); }
__device__ __forceinline__ unsigned f2bf(float f) { return pk2(f, 0.f) & 0xffffu; }
__device__ __forceinline__ float wave_sum(float v) {
#pragma unroll
    for (int o = 1; o < 64; o <<= 1) v += __shfl_xor(v, o);
    return v;
}
__device__ __forceinline__ float fexp2(float x) { return __builtin_amdgcn_exp2f(x); }
__device__ __forceinline__ float siluf(float x) { return x / (1.f + __expf(-x)); }
__device__ __forceinline__ int crow(int r, int hi) { return (r & 3) + 8 * (r >> 2) + 4 * hi; }
__device__ __forceinline__ f32x16 mfma32(bf16x8 a, bf16x8 b, f32x16 c) { return __builtin_amdgcn_mfma_f32_32x32x16_bf16(a, b, c, 0, 0, 0); }
__device__ __forceinline__ f32x16 zero16() { f32x16 z;
#pragma unroll
    for (int i = 0; i < 16; ++i) z[i] = 0.f;
    return z; }
__device__ __forceinline__ bf16x8 as_bf16x8(u32x4 w) { return __builtin_bit_cast(bf16x8, w); }
#define LDS_WAIT() asm volatile("s_waitcnt lgkmcnt(0)" ::: "memory")
__device__ __forceinline__ int my_lane() { int l; asm volatile("v_mbcnt_lo_u32_b32 %0, -1, 0\n\tv_mbcnt_hi_u32_b32 %0, -1, %0" : "=v"(l)); return l; }

#define XB_TMO      128
#define XB_XCNT(j)  (256  + 64 * (j))
#define XB_XSUB(j)  (1280 + 64 * (j))
#define XB_XGEN(j)  (2304 + 64 * (j))
#define XB_TOP      3328
#define XB_TOPGEN   3392
#define XCD_BAR_WORDS 3456
#define XB_SPIN_CAP (1u << 22)
__device__ __forceinline__ unsigned xb_ld(unsigned* p)              { return __hip_atomic_load(p, __ATOMIC_RELAXED, __HIP_MEMORY_SCOPE_AGENT); }
__device__ __forceinline__ unsigned xb_add(unsigned* p, unsigned v) { return __hip_atomic_fetch_add(p, v, __ATOMIC_RELAXED, __HIP_MEMORY_SCOPE_AGENT); }
__device__ __forceinline__ unsigned xb_xcc_id() { return (unsigned)__builtin_amdgcn_s_getreg((3 << 11) | 20) & 0xFu; }
#define XB_SPIN(cond, bar) do { unsigned _sp = 0; while (cond) { __builtin_amdgcn_s_sleep(1); \
    if ((++_sp & 255u) == 0u) { if (xb_ld(&(bar)[XB_TMO])) break; if (_sp > XB_SPIN_CAP) { atomicAdd(&(bar)[XB_TMO], 1u); break; } } } } while (0)
struct XcdBarrier { unsigned* bar; unsigned x; volatile LAS unsigned* st; };
__device__ __forceinline__ XcdBarrier xcd_barrier_post(unsigned* bar, volatile LAS unsigned* st, bool leader) {
    XcdBarrier b; b.bar = bar; b.x = xb_xcc_id(); b.st = st;
    if (leader) (void)xb_add(&bar[XB_XCNT(b.x)], 1u);
    return b;
}
__device__ __forceinline__ void xcd_barrier_complete(unsigned* bar, unsigned x, unsigned& nloc, unsigned& nx) {
    const unsigned G = gridDim.x * gridDim.y * gridDim.z;
    unsigned sum, cnt, mine, sp = 0u;
    for (;;) {
        sum = 0u; cnt = 0u; mine = 0u;
#pragma unroll
        for (unsigned j = 0; j < 16; ++j) { const unsigned c = xb_ld(&bar[XB_XCNT(j)]); sum += c; cnt += (c > 0u) ? 1u : 0u; mine = (j == x) ? c : mine; }
        if (sum == G) break;
        __builtin_amdgcn_s_sleep(1);
        if ((++sp & 255u) == 0u) { if (xb_ld(&bar[XB_TMO])) break; if (sp > XB_SPIN_CAP) { atomicAdd(&bar[XB_TMO], 1u); break; } }
    }
    nloc = mine > 0u ? mine : 1u; nx = cnt > 0u ? cnt : 1u;
}
__device__ __forceinline__ void xcd_barrier(const XcdBarrier& b, bool leader) {
    asm volatile("s_waitcnt vmcnt(0)" ::: "memory");
    __syncthreads();
    if (leader) {
        unsigned* bar = b.bar;
        __builtin_amdgcn_s_waitcnt(0);
        unsigned nloc = b.st[0], nx = b.st[1];
        if (nloc == 0u) { xcd_barrier_complete(bar, b.x, nloc, nx); b.st[0] = nloc; b.st[1] = nx; }
        const unsigned old = xb_add(&bar[XB_XSUB(b.x)], 1u);
        const unsigned gen = old / nloc;
        if (old + 1u == (gen + 1u) * nloc) {
            __builtin_amdgcn_fence(__ATOMIC_RELEASE, "agent");
            asm volatile("s_waitcnt vmcnt(0)" ::: "memory");
            const unsigned og = xb_add(&bar[XB_TOP], 1u);
            const unsigned tg = og / nx;
            if (og + 1u == (tg + 1u) * nx) xb_add(&bar[XB_TOPGEN], 1u);
            else XB_SPIN(xb_ld(&bar[XB_TOPGEN]) == tg, bar);
            __builtin_amdgcn_fence(__ATOMIC_ACQUIRE, "agent");
            xb_add(&bar[XB_XGEN(b.x)], 1u);
            asm volatile("s_waitcnt vmcnt(0)" ::: "memory");
        } else {
            XB_SPIN(xb_ld(&bar[XB_XGEN(b.x)]) == gen, bar);
            __builtin_amdgcn_fence(__ATOMIC_ACQUIRE, "agent");
            asm volatile("s_waitcnt vmcnt(0)" ::: "memory");
        }
    }
    __syncthreads();
}

namespace pg8 {
constexpr int BM = 256, BK = 64, HALF = 128, HTB = HALF * BK * 2, STAGE_BYTES = 8 * HTB, NXCD = 8, WGM = 8;
__host__ __device__ __forceinline__ int lds_byte(int r, int c) { const int st = (r >> 4) * 2 + (c >> 5), rr = r & 15, cc = c & 31, ob = rr * 64 + cc * 2; return st * 1024 + (ob ^ (((ob >> 9) & 1) << 5)); }
__host__ __device__ __forceinline__ void stage_rc(int b, int& R, int& C) { const int st = b / 1024, sb = b % 1024, swz = sb ^ (((sb >> 9) & 1) << 5); R = (st >> 1) * 16 + swz / 64; C = (st & 1) * 32 + (swz % 64) / 2; }
__host__ __device__ __forceinline__ int perm32(int rho) { const int n = rho >> 4, i = rho & 15; return 8 * (i >> 2) + 4 * n + (i & 3); }

struct Unit { int pm, pn, aux; long aofs, bofs; };
struct Gemm { const bf16_t* A; const bf16_t* Bt; int lda, ldb, K; };

struct StaticOrder {
    int nM, nN, nwg, G, c;
    __device__ void init(int nM_, int nN_, int G_, int c_) { nM = nM_; nN = nN_; nwg = nM * nN; G = G_; c = c_; }
    __device__ bool next(int i, Unit& u) const {
        const long L = (long)i * G + c; if (L >= nwg) return false;
        int wgid = (int)L; { const int q = nwg / NXCD, r = nwg % NXCD, xcd = wgid % NXCD, off = wgid / NXCD; wgid = (xcd < r ? xcd * (q + 1) : r * (q + 1) + (xcd - r) * q) + off; }
        const int nig = WGM * nN, gid = wgid / nig, fm = gid * WGM, gsz = (nM - fm) < WGM ? (nM - fm) : WGM;
        u.pm = fm + ((wgid % nig) % gsz); u.pn = (wgid % nig) / gsz; u.aux = 0; u.aofs = 0; u.bofs = 0; return true;
    }
};
struct MergeOrder {
    StaticOrder so;
    __device__ bool next(int i, Unit& u) const { if (!so.next(i >> 2, u)) return false; const int s = i & 3; u.aux = s; u.aofs = (long)s * 256 * 2; u.bofs = (long)s * 1024 * 256 * 2; return true; }
};
struct MoeOrder {
    int c0, ntc, nN, G, c; const int* tile_e; long bstride;
    __device__ bool next(int i, Unit& u) const {
        const long L = (long)i * G + c; if (L >= (long)ntc * nN) return false;
        u.pm = c0 + (int)(L % ntc); u.pn = (int)(L / ntc); u.aux = 0; u.aofs = 0;
        int e = tile_e[u.pm]; e = e < 0 ? 0 : e; u.bofs = (long)e * bstride; return true;
    }
};

template <class Epi, class Sched>
__device__ __forceinline__ void gemm_phase(LAS unsigned char* lds, const Gemm g, const Sched& S, const Epi& E, int wid) {
    const int lane = my_lane(), tid = wid * 64 + lane;
    const int wr = wid >> 2, wc = wid & 3, fr = lane & 15, fq = lane >> 4;
    const int K = g.K, nt = K / BK;
    unsigned voffA[2], voffB[2];
#pragma unroll
    for (int i = 0; i < 2; ++i) { int R, C; stage_rc(tid * 16 + i * 8192, R, C); const int Rb = Epi::PERM ? ((R & ~31) + perm32(R & 31)) : R;
        voffA[i] = (unsigned)(R * g.lda + C) * 2u; voffB[i] = (unsigned)(Rb * g.ldb + C) * 2u; }
    const size_t kstep = (size_t)(BK * 2);
    const size_t hstepA = (size_t)HALF * g.lda * 2, hstepB = (size_t)HALF * g.ldb * 2;
    const size_t tstepA = 2 * hstepA, tstepB = 2 * hstepB;
    const unsigned ldsw = (unsigned)wid * 1024u;
    const int aoff = lds_byte(wr * 64 + fr, fq * 8), boff = lds_byte(wc * 32 + fr, fq * 8);
#define PG8_SA(b, h) (((b) * 2 + (h)) * HTB)
#define PG8_SB(b, h) ((4 + (b) * 2 + (h)) * HTB)
#define PG8_STAGE(bufoff, gbase, voff) do { _Pragma("unroll") for (int _i = 0; _i < 2; ++_i) \
        __builtin_amdgcn_global_load_lds((const unsigned*)((const char*)(gbase) + (voff)[_i]), (LAS unsigned*)(lds + (bufoff) + ldsw + _i * 8192), 16, 0, 0); } while (0)
#define PG8_LDA(dst, b, h) do { _Pragma("unroll") for (int m = 0; m < 4; ++m) _Pragma("unroll") for (int k = 0; k < 2; ++k) dst[m][k] = *(const LAS bf16x8*)(lds + PG8_SA(b, h) + aoff + m * 2048 + k * 1024); } while (0)
#define PG8_LDB(dst, b, h) do { _Pragma("unroll") for (int n = 0; n < 2; ++n) _Pragma("unroll") for (int k = 0; k < 2; ++k) dst[n][k] = *(const LAS bf16x8*)(lds + PG8_SB(b, h) + boff + n * 2048 + k * 1024); } while (0)
#define PG8_MMA(ai, bj, At, Bt) do { __builtin_amdgcn_s_setprio(1); _Pragma("unroll") for (int m = 0; m < 4; ++m) _Pragma("unroll") for (int n = 0; n < 2; ++n) _Pragma("unroll") for (int k = 0; k < 2; ++k) \
        acc[ai][bj][m][n] = __builtin_amdgcn_mfma_f32_16x16x32_bf16(Bt[n][k], At[m][k], acc[ai][bj][m][n], 0, 0, 0); __builtin_amdgcn_s_setprio(0); } while (0)
#define PG8_WAIT_V(n) asm volatile("s_waitcnt vmcnt(" #n ")" ::: "memory")
#define PG8_WAIT_L(n) asm volatile("s_waitcnt lgkmcnt(" #n ")" ::: "memory")
#define PG8_BAR __builtin_amdgcn_s_barrier()
#define PG8_SCHED __builtin_amdgcn_sched_barrier(0)
    Unit cur, nxt; int ui = 0;
    if (!S.next(0, cur)) return;
    f32x4 acc[2][2][4][2];
#pragma unroll
    for (int a = 0; a < 2; ++a)
#pragma unroll
        for (int b = 0; b < 2; ++b)
#pragma unroll
            for (int m = 0; m < 4; ++m)
#pragma unroll
                for (int n = 0; n < 2; ++n) acc[a][b][m][n] = (f32x4){0.f, 0.f, 0.f, 0.f};
    bf16x8 At[4][2], B0[2][2], B1[2][2];
    const char* cA = (const char*)g.A + cur.aofs + (size_t)cur.pm * tstepA; const char* cB = (const char*)g.Bt + cur.bofs + (size_t)cur.pn * tstepB;
    PG8_STAGE(PG8_SB(0, 0), cB, voffB); PG8_STAGE(PG8_SB(0, 1), cB + hstepB, voffB); PG8_STAGE(PG8_SA(0, 0), cA, voffA); PG8_STAGE(PG8_SA(0, 1), cA + hstepA, voffA);
    if (wr == 1) PG8_BAR;
    PG8_WAIT_V(2); PG8_BAR;
    PG8_STAGE(PG8_SB(1, 0), cB + kstep, voffB); PG8_STAGE(PG8_SA(1, 0), cA + kstep, voffA); PG8_STAGE(PG8_SB(1, 1), cB + hstepB + kstep, voffB);
    PG8_WAIT_V(6); PG8_BAR;
    for (;;) {
        const bool has_next = S.next(ui + 1, nxt);
        const char* nA = has_next ? (const char*)g.A + nxt.aofs + (size_t)nxt.pm * tstepA : cA; const char* nB = has_next ? (const char*)g.Bt + nxt.bofs + (size_t)nxt.pn * tstepB : cB;
        for (int t = 0; t < nt; t += 2) {
            const bool last = (t == nt - 2);
            const char* a1 = cA + (size_t)(t + 1) * kstep;
            const char* a2 = last ? nA : cA + (size_t)(t + 2) * kstep; const char* b2 = last ? nB : cB + (size_t)(t + 2) * kstep;
            const char* a3 = a2 + kstep; const char* b3 = b2 + kstep;
            PG8_LDB(B0, 0, 0); PG8_LDB(B1, 0, 1); PG8_SCHED; PG8_LDA(At, 0, 0); PG8_STAGE(PG8_SA(1, 1), a1 + hstepA, voffA);
            PG8_WAIT_V(8); PG8_WAIT_L(0); PG8_BAR; PG8_MMA(0, 0, At, B0); PG8_MMA(0, 1, At, B1); PG8_BAR; PG8_SCHED;
            PG8_LDA(At, 0, 1); PG8_STAGE(PG8_SB(0, 0), b2, voffB); PG8_STAGE(PG8_SB(0, 1), b2 + hstepB, voffB); PG8_STAGE(PG8_SA(0, 0), a2, voffA);
            PG8_WAIT_V(8); PG8_WAIT_L(0); PG8_BAR; PG8_MMA(1, 0, At, B0); PG8_MMA(1, 1, At, B1); PG8_BAR; PG8_SCHED;
            PG8_LDB(B0, 1, 0); PG8_LDB(B1, 1, 1); PG8_SCHED; PG8_LDA(At, 1, 0); PG8_STAGE(PG8_SA(0, 1), a2 + hstepA, voffA);
            PG8_WAIT_V(8); PG8_WAIT_L(0); PG8_BAR; PG8_MMA(0, 0, At, B0); PG8_MMA(0, 1, At, B1); PG8_BAR; PG8_SCHED;
            PG8_LDA(At, 1, 1); PG8_STAGE(PG8_SB(1, 0), b3, voffB); PG8_STAGE(PG8_SB(1, 1), b3 + hstepB, voffB); PG8_STAGE(PG8_SA(1, 0), a3, voffA);
            PG8_WAIT_V(8); PG8_WAIT_L(0); PG8_BAR; PG8_MMA(1, 0, At, B0); PG8_MMA(1, 1, At, B1); PG8_BAR; PG8_SCHED;
        }
        if (wr == 0) PG8_BAR;
        E(acc, cur, wr, wc, fr, fq);
        if (!has_next) break;
#pragma unroll
        for (int a = 0; a < 2; ++a)
#pragma unroll
            for (int b = 0; b < 2; ++b)
#pragma unroll
                for (int m = 0; m < 4; ++m)
#pragma unroll
                    for (int n = 0; n < 2; ++n) acc[a][b][m][n] = (f32x4){0.f, 0.f, 0.f, 0.f};
        cur = nxt; cA = nA; cB = nB; ++ui;
        if (wr == 1) PG8_BAR;
    }
    PG8_WAIT_V(0);
    PG8_BAR;
#undef PG8_SA
#undef PG8_SB
#undef PG8_STAGE
#undef PG8_LDA
#undef PG8_LDB
#undef PG8_MMA
#undef PG8_WAIT_V
#undef PG8_WAIT_L
#undef PG8_BAR
#undef PG8_SCHED
}

struct EpiTileBf16 {
    static constexpr bool PERM = true;
    bf16_t* O; size_t tstride;
    __device__ __forceinline__ void operator()(const f32x4 (&acc)[2][2][4][2], const Unit& u, int wr, int wc, int fr, int fq) const {
        const int row0 = u.pm * BM + wr * 64 + fr; bf16_t* base = O + (size_t)u.pn * tstride; const int col0 = wc * 32 + 8 * fq;
#pragma unroll
        for (int ai = 0; ai < 2; ++ai)
#pragma unroll
            for (int m = 0; m < 4; ++m) { bf16_t* rowp = base + (size_t)(row0 + ai * HALF + m * 16) * 256 + col0;
#pragma unroll
                for (int bj = 0; bj < 2; ++bj) { const f32x4 v0 = acc[ai][bj][m][0], v1 = acc[ai][bj][m][1];
                    u32x4 w; w.x = pk2(v0[0], v0[1]); w.y = pk2(v0[2], v0[3]); w.z = pk2(v1[0], v1[1]); w.w = pk2(v1[2], v1[3]);
                    *(u32x4*)(rowp + bj * HALF) = w; } }
    }
};
struct EpiSigmoid {
    static constexpr bool PERM = true;
    bf16_t* O; int ldc;
    __device__ __forceinline__ void operator()(const f32x4 (&acc)[2][2][4][2], const Unit& u, int wr, int wc, int fr, int fq) const {
        const int row0 = u.pm * BM + wr * 64 + fr; const int col0 = u.pn * BM + wc * 32 + 8 * fq;
#pragma unroll
        for (int ai = 0; ai < 2; ++ai)
#pragma unroll
            for (int m = 0; m < 4; ++m) { bf16_t* rowp = O + (size_t)(row0 + ai * HALF + m * 16) * ldc + col0;
#pragma unroll
                for (int bj = 0; bj < 2; ++bj) { f32x4 v0 = acc[ai][bj][m][0], v1 = acc[ai][bj][m][1];
#pragma unroll
                    for (int j = 0; j < 4; ++j) { v0[j] = 1.f / (1.f + __expf(-v0[j])); v1[j] = 1.f / (1.f + __expf(-v1[j])); }
                    u32x4 w; w.x = pk2(v0[0], v0[1]); w.y = pk2(v0[2], v0[3]); w.z = pk2(v1[0], v1[1]); w.w = pk2(v1[2], v1[3]);
                    *(u32x4*)(rowp + bj * HALF) = w; } }
    }
};
struct EpiMerge {
    static constexpr bool PERM = true;
    const bf16_t* SG; bf16_t* M; f32x4* scr;
    template <int MODE>
    __device__ __forceinline__ void run(const f32x4 (&acc)[2][2][4][2], const Unit& u, int wr, int wc, int fr, int fq) const {
        const int row0 = u.pm * BM + wr * 64 + fr; const int col0 = u.pn * BM + wc * 32 + 8 * fq; int tid = (wr * 4 + wc) * 64 + fq * 16 + fr; asm volatile("" : "+v"(tid));
        const bf16_t* sgp = SG + (size_t)row0 * 4096 + u.aux * 1024 + col0; bf16_t* mp = M + (size_t)row0 * 1024 + col0; f32x4* p = scr + tid;
#pragma unroll
        for (int ai = 0; ai < 2; ++ai)
#pragma unroll
            for (int m = 0; m < 4; ++m) {
#pragma unroll
                for (int bj = 0; bj < 2; ++bj) {
                    const u32x4 s = *(const u32x4*)(sgp + (size_t)(ai * HALF + m * 16) * 4096 + bj * HALF);
                    f32x4 v0 = acc[ai][bj][m][0], v1 = acc[ai][bj][m][1];
                    v0[0] *= bflo(s.x); v0[1] *= bfhi(s.x); v0[2] *= bflo(s.y); v0[3] *= bfhi(s.y);
                    v1[0] *= bflo(s.z); v1[1] *= bfhi(s.z); v1[2] *= bflo(s.w); v1[3] *= bfhi(s.w);
                    const int pi = (((ai * 2 + bj) * 4 + m) * 2) * 512;
                    if (MODE != 0) { v0 += p[pi]; v1 += p[pi + 512]; }
                    if (MODE != 2) { p[pi] = v0; p[pi + 512] = v1; }
                    else { u32x4 w; w.x = pk2(v0[0], v0[1]); w.y = pk2(v0[2], v0[3]); w.z = pk2(v1[0], v1[1]); w.w = pk2(v1[2], v1[3]);
                        *(u32x4*)(mp + (size_t)(ai * HALF + m * 16) * 1024 + bj * HALF) = w; } }
                asm volatile("" ::: "memory"); }
    }
    __device__ __forceinline__ void operator()(const f32x4 (&acc)[2][2][4][2], const Unit& u, int wr, int wc, int fr, int fq) const {
        if (u.aux == 0) run<0>(acc, u, wr, wc, fr, fq); else if (u.aux == 3) run<2>(acc, u, wr, wc, fr, fq); else run<1>(acc, u, wr, wc, fr, fq);
    }
};
struct EpiResid {
    static constexpr bool PERM = false;
    const float* sl; const float* sc; float* dl; float* dc; const float* gate;
    __device__ __forceinline__ void operator()(const f32x4 (&acc)[2][2][4][2], const Unit& u, int wr, int wc, int fr, int fq) const {
        const int rt = u.pm * BM; const bool isc = rt >= ML;
        const float* src = isc ? sc + (size_t)(rt - ML) * 1024 : sl + (size_t)rt * 1024;
        float* dst = isc ? dc + (size_t)(rt - ML) * 1024 : dl + (size_t)rt * 1024;
        const float* gv = gate + (size_t)(isc ? 4 : (rt >> 13)) * 6144;
        const int col0 = u.pn * BM + wc * 32 + 4 * fq; const int r0 = wr * 64 + fr;
        f32x4 gg[2][2];
#pragma unroll
        for (int bj = 0; bj < 2; ++bj)
#pragma unroll
            for (int n = 0; n < 2; ++n) gg[bj][n] = *(const f32x4*)(gv + col0 + bj * HALF + n * 16);
#pragma unroll
        for (int ai = 0; ai < 2; ++ai)
#pragma unroll
            for (int m = 0; m < 4; ++m) { const size_t off = (size_t)(r0 + ai * HALF + m * 16) * 1024 + col0;
#pragma unroll
                for (int bj = 0; bj < 2; ++bj)
#pragma unroll
                    for (int n = 0; n < 2; ++n) { const f32x4 x = *(const f32x4*)(src + off + bj * HALF + n * 16);
                        *(f32x4*)(dst + off + bj * HALF + n * 16) = x + gg[bj][n] * acc[ai][bj][m][n]; }
                asm volatile("" ::: "memory"); }
    }
};
struct EpiSwiGLU {
    static constexpr bool PERM = true;
    bf16_t* Hd; int ldc; int rowsub;
    __device__ __forceinline__ void operator()(const f32x4 (&acc)[2][2][4][2], const Unit& u, int wr, int wc, int fr, int fq) const {
        const int row0 = u.pm * BM - rowsub + wr * 64 + fr; const int col0 = u.pn * HALF + wc * 32 + 8 * fq;
#pragma unroll
        for (int ai = 0; ai < 2; ++ai)
#pragma unroll
            for (int m = 0; m < 4; ++m) { bf16_t* rowp = Hd + (size_t)(row0 + ai * HALF + m * 16) * ldc + col0;
                f32x4 v0, v1;
#pragma unroll
                for (int j = 0; j < 4; ++j) { const float g0 = acc[ai][0][m][0][j], g1 = acc[ai][0][m][1][j];
                    v0[j] = g0 / (1.f + __expf(-g0)) * acc[ai][1][m][0][j]; v1[j] = g1 / (1.f + __expf(-g1)) * acc[ai][1][m][1][j]; }
                u32x4 w; w.x = pk2(v0[0], v0[1]); w.y = pk2(v0[2], v0[3]); w.z = pk2(v1[0], v1[1]); w.w = pk2(v1[2], v1[3]);
                *(u32x4*)rowp = w; }
    }
};
struct EpiMoeDown {
    static constexpr bool PERM = true;
    const int* rowinfo; const float* roww; bf16_t* Y;
    __device__ __forceinline__ void operator()(const f32x4 (&acc)[2][2][4][2], const Unit& u, int wr, int wc, int fr, int fq) const {
        const int row0 = u.pm * BM + wr * 64 + fr; const int col0 = u.pn * BM + wc * 32 + 8 * fq;
#pragma unroll
        for (int ai = 0; ai < 2; ++ai)
#pragma unroll
            for (int m = 0; m < 4; ++m) { const int row = row0 + ai * HALF + m * 16; const int info = rowinfo[row];
                if (info >= 0) { const float w8 = roww[row]; bf16_t* rowp = Y + (size_t)(info & 1) * ML * 1024 + (size_t)(info >> 1) * 1024 + col0;
#pragma unroll
                    for (int bj = 0; bj < 2; ++bj) { const f32x4 v0 = acc[ai][bj][m][0] * w8, v1 = acc[ai][bj][m][1] * w8;
                        u32x4 w; w.x = pk2(v0[0], v0[1]); w.y = pk2(v0[2], v0[3]); w.z = pk2(v1[0], v1[1]); w.w = pk2(v1[2], v1[3]);
                        *(u32x4*)(rowp + bj * HALF) = w; } } }
    }
};
}

struct Args { const float* in[26]; float* out; unsigned char* ws; int ph_lo, ph_hi; };
enum { I_X = 0, I_C, I_CTX, I_CCTX, I_ADAW, I_ADAB, I_NMIX, I_NFFN, I_WIN, I_DECF, I_DECB, I_QNORM, I_KVNORM, I_WUQ, I_WUKV, I_RPB, I_WBR, I_WOUT,
       I_FG, I_FU, I_FD, I_ROUTER, I_MG, I_MU, I_MD, I_NFINAL };

__device__ __forceinline__ int q_next(unsigned* qw, volatile LAS int* slot, bool leader) {
    __syncthreads();
    if (leader) *slot = (int)atomicAdd(qw, 1u);
    __syncthreads();
    return *slot;
}

__device__ __forceinline__ void cvt_block(const float* W, int ldw, int k0, int sc0, bf16_t* D, int drow0, int ldd, LAS float* scr, int lane) {
#pragma unroll 8
    for (int i = 0; i < 32; ++i) { const int kk = 2 * i + (lane >> 5); scr[kk * 33 + (lane & 31)] = sc0 >= 0 ? W[(size_t)(k0 + kk) * ldw + sc0 + (lane & 31)] : 0.f; }
    LDS_WAIT();
    const int c = lane & 7;
#pragma unroll
    for (int j = 0; j < 4; ++j) { const int n = (lane >> 3) + 8 * j; const LAS float* s = scr + (8 * c) * 33 + n;
        u32x4 o; o.x = pk2(s[0 * 33], s[1 * 33]); o.y = pk2(s[2 * 33], s[3 * 33]); o.z = pk2(s[4 * 33], s[5 * 33]); o.w = pk2(s[6 * 33], s[7 * 33]);
        *(u32x4*)(D + (size_t)(drow0 + n) * ldd + k0 + 8 * c) = o; }
    LDS_WAIT();
}
__device__ __forceinline__ int map_ng(int j) {
    if (j < 1024) return j;
    if (j < 2304) return 1184 + (j - 1024);
    if (j < 2464) return 1024 + (j - 2304);
    if (j < 2560) return -1;
    if (j < 2752) return 2464 + (j - 2560);
    return -1;
}

__device__ __forceinline__ void ph_prologue(const Args& a, LAS unsigned char* lds, int tid, int lane, int wave, int bid, int G) { asm volatile("" : "+v"(lane)); asm volatile("" : "+v"(tid));
    unsigned char* ws = a.ws;
    LAS float* s = (LAS float*)lds;
    LAS float* red = (LAS float*)(lds + 20480);
    for (int i = tid; i < 5 * 1024; i += 512) { const int r = i >> 10, k = i & 1023; const float v = r < 4 ? a.in[I_C][r * 1024 + k] : a.in[I_CCTX][k]; s[i] = siluf(v); }
    __syncthreads();
    float* MOD = (float*)(ws + WS_MOD);
    for (int unit = bid; unit < 384; unit += G) {
        const int L = unit / 192, j0 = (unit % 192) * 32, jj = tid & 31, ks = tid >> 5;
        float acc[5] = {0.f, 0.f, 0.f, 0.f, 0.f};
        const float* W = a.in[I_ADAW] + (size_t)L * 1024 * 6144 + j0 + jj;
        for (int k = ks * 64; k < ks * 64 + 64; ++k) { const float w = W[(size_t)k * 6144];
#pragma unroll
            for (int r = 0; r < 5; ++r) acc[r] += s[r * 1024 + k] * w; }
#pragma unroll
        for (int r = 0; r < 5; ++r) red[(ks * 5 + r) * 32 + jj] = acc[r];
        __syncthreads();
        if (tid < 160) { const int r = tid >> 5; float t = 0.f;
            for (int q = 0; q < 16; ++q) t += red[(q * 5 + r) * 32 + jj];
            MOD[(size_t)(L * 5 + r) * 6144 + j0 + jj] = t + a.in[I_ADAB][L * 6144 + j0 + jj]; }
        __syncthreads();
    }
    LAS float* scr = (LAS float*)(lds + 32768 + wave * 8448);
    const int gw = bid * 8 + wave, NGW = G * 8;
    constexpr int IA = 16 * 88, IB = 16 * 128, IC = 4 * 4 * 32, ID = 16 * 32, IE = 3 * 12, IF = 2 * 16, IL = IA + IB + IC + ID + IE + IF, IG = 16 * 176, IH = 44 * 32;
    for (int it = gw; it < 2 * IL + IG + IH; it += NGW) {
        int r = it;
        if (r < 2 * IL) { const int L = r / IL; r -= L * IL;
            const float* win = a.in[I_WIN] + (size_t)L * 1024 * INC;
            if (r < IA) { const int kb = r / 88, nb = r % 88; cvt_block(win, INC, kb * 64, map_ng(nb * 32), (bf16_t*)(ws + WS_WNG) + (size_t)L * 2816 * 1024, nb * 32, 1024, scr, lane); continue; } r -= IA;
            if (r < IB) { const int kb = r / 128, nb = r % 128; cvt_block(win, INC, kb * 64, 2656 + nb * 32, (bf16_t*)(ws + WS_WG) + (size_t)L * 4096 * 1024, nb * 32, 1024, scr, lane); continue; } r -= IB;
            if (r < IC) { const int i = r / 128, q = r % 128, kb = q / 32, nb = q % 32;
                cvt_block(a.in[I_WBR] + (size_t)(L * 4 + i) * 256 * 1024, 1024, kb * 64, nb * 32, (bf16_t*)(ws + WS_WB) + (size_t)(L * 4 + i) * 1024 * 256, nb * 32, 256, scr, lane); continue; } r -= IC;
            if (r < ID) { const int kb = r / 32, nb = r % 32; cvt_block(a.in[I_WOUT] + (size_t)L * 1024 * 1024, 1024, kb * 64, nb * 32, (bf16_t*)(ws + WS_WO) + (size_t)L * 1024 * 1024, nb * 32, 1024, scr, lane); continue; } r -= ID;
            if (r < IE) { const int kb = r / 12, nb = r % 12; cvt_block(a.in[I_WUQ] + (size_t)L * 192 * 384, 384, kb * 64, nb * 32, (bf16_t*)(ws + WS_WUQ) + (size_t)L * 384 * 192, nb * 32, 192, scr, lane); continue; } r -= IE;
            { const int kb = r / 16, nb = r % 16; cvt_block(a.in[I_WUKV] + (size_t)L * 128 * 512, 512, kb * 64, nb * 32, (bf16_t*)(ws + WS_WUKV) + (size_t)L * 512 * 128, nb * 32, 128, scr, lane); continue; }
        }
        r -= 2 * IL;
        if (r < IG) { const int kb = r / 176, nb = r % 176, pn = nb >> 3, wi = nb & 7;
            cvt_block(wi < 4 ? a.in[I_FG] : a.in[I_FU], FF, kb * 64, 128 * pn + 32 * (wi & 3), (bf16_t*)(ws + WS_WGU), nb * 32, 1024, scr, lane); continue; } r -= IG;
        { const int kb = r / 32, nb = r % 32; cvt_block(a.in[I_FD], 1024, kb * 64, nb * 32, (bf16_t*)(ws + WS_WD), nb * 32, FF, scr, lane); }
    }
    const int gt = bid * 512 + tid, NGT = G * 512;
    float* RR = (float*)(ws + WS_ROPER); float* RM = (float*)(ws + WS_ROPEM);
    for (int i = gt; i < 8192 * 32; i += NGT) { const int t = i >> 5, f = i & 31; const float pos = (float)(f < 16 ? (t >> 6) : (t & 63));
        const float inv = powf(10000.f, -(float)(f & 15) / 16.f); const float ang = pos * inv; RR[2 * i] = cosf(ang); RR[2 * i + 1] = sinf(ang); }
    for (int i = gt; i < 8192 * 16; i += NGT) { const int t = i >> 4, f = i & 15; const float pos = (float)(f < 8 ? (t >> 6) : (t & 63));
        const float inv = powf(10000.f, -(float)(f & 7) / 8.f); const float ang = pos * inv; RM[2 * i] = cosf(ang); RM[2 * i + 1] = sinf(ang); }
    const float TWO_PI = 6.283185307179586f;
    bf16_t* M1 = (bf16_t*)(ws + WS_M1);
    for (int i = gt; i < 256 * 128; i += NGT) { const int r = i >> 7, t2 = i & 127; const int m = ((r & 127) * t2) & 127; const float ang = TWO_PI * (float)m / 128.f;
        M1[i] = (bf16_t)f2bf(r < 128 ? cosf(ang) : -sinf(ang)); }
    float* TW = (float*)(ws + WS_TW);
    for (int i = gt; i < 8192; i += NGT) { const float ang = TWO_PI * (float)i / 8192.f; TW[2 * i] = cosf(ang); TW[2 * i + 1] = sinf(ang); }
    bf16_t* D2 = (bf16_t*)(ws + WS_D2);
    for (int i = gt; i < 128 * 128; i += NGT) { const int row = i >> 7, k = i & 127; const int ro = row >> 6, k1 = row & 63, t1 = k >> 1, ri = k & 1;
        const float ang = TWO_PI * (float)((k1 * t1) & 63) / 64.f; const float cs = cosf(ang), sn = sinf(ang);
        D2[i] = (bf16_t)f2bf(ro == 0 ? (ri == 0 ? cs : sn) : (ri == 0 ? -sn : cs)); }
    bf16_t* EP = (bf16_t*)(ws + WS_EP);
    for (int i = gt; i < 64 * 128; i += NGT) { const int l = i >> 7, q = i & 127, part = q >> 6, p = q & 63; const int ct = p >> 5, sp = (p >> 4) & 1, hh = (p >> 3) & 1, j = p & 7;
        const int c = ct * 32 + 16 * sp + 8 * (j >> 2) + 4 * hh + (j & 3); const float ang = TWO_PI * (float)((l * c) & 63) / 64.f;
        EP[i] = (bf16_t)f2bf(part == 0 ? cosf(ang) : sinf(ang)); }
}

__device__ __forceinline__ void norm_rows(const float* xl, const float* xc, const float* gain, const float* modL, int sh_off, int sc_off, bf16_t* O, int lane, int gw, int NGW) { asm volatile("" : "+v"(lane));
    f32x4 gn[4];
#pragma unroll
    for (int j = 0; j < 4; ++j) gn[j] = *(const f32x4*)(gain + 4 * lane + 256 * j);
    for (int row = gw; row < MT; row += NGW) {
        const bool isc = row >= ML; const float* xr = isc ? xc + (size_t)(row - ML) * 1024 : xl + (size_t)row * 1024;
        const float* mv = modL + (size_t)(isc ? 4 : (row >> 13)) * 6144;
        f32x4 v[4]; float ss = 0.f;
#pragma unroll
        for (int j = 0; j < 4; ++j) { v[j] = *(const f32x4*)(xr + 4 * lane + 256 * j); ss += (v[j][0] * v[j][0] + v[j][1] * v[j][1]) + (v[j][2] * v[j][2] + v[j][3] * v[j][3]); }
        const float rstd = 1.f / sqrtf(wave_sum(ss) * (1.f / 1024.f) + EPS);
        u32x2* o8 = (u32x2*)(O + (size_t)row * 1024) + lane;
#pragma unroll
        for (int j = 0; j < 4; ++j) { const f32x4 sc = *(const f32x4*)(mv + sc_off + 4 * lane + 256 * j), sh = *(const f32x4*)(mv + sh_off + 4 * lane + 256 * j);
            const f32x4 y = v[j] * rstd * gn[j] * (sc + 1.f) + sh; u32x2 w; w.x = pk2(y[0], y[1]); w.y = pk2(y[2], y[3]); o8[64 * j] = w; }
    }
}

__device__ __forceinline__ float logsig2(float x) { return -log1pf(expf(-x)) * LOG2E; }

template <bool DO_KS, bool DO_QS, bool DO_KT>
__device__ __forceinline__ void ret_stage(const bf16_t* U, const float* RR, int row0, int t0, int hd, LAS bf16_t* Ks, LAS bf16_t* Qs, LAS bf16_t* KT, LAS bf16_t* VT, int tid) {
    const int j = tid >> 2, qd = tid & 3; const size_t rb = (size_t)(row0 + j) * 256 + hd * 64 + 8 * qd;
    float c[8], s[8];
    if (t0 >= 0) { const float* rr = RR + ((size_t)(t0 + j) * 32 + 8 * qd) * 2;
#pragma unroll
        for (int i = 0; i < 8; i += 2) { const f32x4 v = *(const f32x4*)(rr + 2 * i); c[i] = v[0]; s[i] = v[1]; c[i + 1] = v[2]; s[i + 1] = v[3]; } }
    else {
#pragma unroll
        for (int i = 0; i < 8; ++i) { c[i] = 1.f; s[i] = 0.f; } }
    {
        const u32x4 a = *(const u32x4*)(U + rb), b = *(const u32x4*)(U + rb + 32);
        float x1[8] = {bflo(a.x), bfhi(a.x), bflo(a.y), bfhi(a.y), bflo(a.z), bfhi(a.z), bflo(a.w), bfhi(a.w)};
        float x2[8] = {bflo(b.x), bfhi(b.x), bflo(b.y), bfhi(b.y), bflo(b.z), bfhi(b.z), bflo(b.w), bfhi(b.w)};
        float o1[8], o2[8];
#pragma unroll
        for (int i = 0; i < 8; ++i) { o1[i] = (x1[i] * c[i] - x2[i] * s[i]) * 0.125f; o2[i] = (x2[i] * c[i] + x1[i] * s[i]) * 0.125f; }
        if (DO_KS) { u32x4 w1, w2; w1.x = pk2(o1[0], o1[1]); w1.y = pk2(o1[2], o1[3]); w1.z = pk2(o1[4], o1[5]); w1.w = pk2(o1[6], o1[7]);
            w2.x = pk2(o2[0], o2[1]); w2.y = pk2(o2[2], o2[3]); w2.z = pk2(o2[4], o2[5]); w2.w = pk2(o2[6], o2[7]);
            *(LAS u32x4*)(Ks + j * 72 + 8 * qd) = w1; *(LAS u32x4*)(Ks + j * 72 + 32 + 8 * qd) = w2; }
        if (DO_KT) {
#pragma unroll
            for (int i = 0; i < 8; ++i) { KT[(8 * qd + i) * 136 + j] = (bf16_t)f2bf(o1[i]); KT[(32 + 8 * qd + i) * 136 + j] = (bf16_t)f2bf(o2[i]); } }
    }
    if (DO_QS) {
        const bf16_t* Uq = U + (size_t)4 * MT * 256;
        const u32x4 a = *(const u32x4*)(Uq + rb), b = *(const u32x4*)(Uq + rb + 32);
        float x1[8] = {bflo(a.x), bfhi(a.x), bflo(a.y), bfhi(a.y), bflo(a.z), bfhi(a.z), bflo(a.w), bfhi(a.w)};
        float x2[8] = {bflo(b.x), bfhi(b.x), bflo(b.y), bfhi(b.y), bflo(b.z), bfhi(b.z), bflo(b.w), bfhi(b.w)};
        float o1[8], o2[8];
#pragma unroll
        for (int i = 0; i < 8; ++i) { o1[i] = x1[i] * c[i] - x2[i] * s[i]; o2[i] = x2[i] * c[i] + x1[i] * s[i]; }
        u32x4 w1, w2; w1.x = pk2(o1[0], o1[1]); w1.y = pk2(o1[2], o1[3]); w1.z = pk2(o1[4], o1[5]); w1.w = pk2(o1[6], o1[7]);
        w2.x = pk2(o2[0], o2[1]); w2.y = pk2(o2[2], o2[3]); w2.z = pk2(o2[4], o2[5]); w2.w = pk2(o2[6], o2[7]);
        *(LAS u32x4*)(Qs + j * 72 + 8 * qd) = w1; *(LAS u32x4*)(Qs + j * 72 + 32 + 8 * qd) = w2;
    }
    {
        const bf16_t* Uv = U + (size_t)1 * MT * 256;
        const u32x4 a = *(const u32x4*)(Uv + rb), b = *(const u32x4*)(Uv + rb + 32);
        const unsigned wa[4] = {a.x, a.y, a.z, a.w}, wb[4] = {b.x, b.y, b.z, b.w};
#pragma unroll
        for (int i = 0; i < 4; ++i) { VT[(8 * qd + 2 * i) * 136 + j] = (bf16_t)(wa[i] & 0xffffu); VT[(8 * qd + 2 * i + 1) * 136 + j] = (bf16_t)(wa[i] >> 16);
            VT[(32 + 8 * qd + 2 * i) * 136 + j] = (bf16_t)(wb[i] & 0xffffu); VT[(32 + 8 * qd + 2 * i + 1) * 136 + j] = (bf16_t)(wb[i] >> 16); }
    }
}

__device__ __forceinline__ void ret_dstate_unit(const Args& a, int L, int u, LAS unsigned char* lds, int tid, int lane, int wave) { asm volatile("" : "+v"(lane)); asm volatile("" : "+v"(tid));
    const bf16_t* U = (const bf16_t*)(a.ws + WS_U); const float* RR = (const float*)(a.ws + WS_ROPER);
    LAS bf16_t* KT = (LAS bf16_t*)lds; LAS bf16_t* VT = (LAS bf16_t*)(lds + 17408);
    int b, hd, n, row0, t0; float* dst0;
    if (u < 1024) { b = u >> 8; hd = (u >> 6) & 3; n = u & 63; row0 = b * SEQ + n * 128; t0 = n * 128; dst0 = (float*)(a.ws + WS_ST) + ((size_t)((b * 4 + hd) * 64 + n)) * 4096; }
    else { const int v = u - 1024; b = v >> 3; hd = (v >> 1) & 3; n = v & 1; row0 = ML + b * CTXL + n * 128; t0 = -1; dst0 = (float*)(a.ws + WS_STC) + ((size_t)((b * 4 + hd) * 2 + n)) * 4096; }
    ret_stage<false, false, true>(U, RR, row0, t0, hd, KT, KT, KT, VT, tid);
    __syncthreads();
    const int dir = wave >> 2, dkb = (wave >> 1) & 1, dvb = wave & 1, r = lane & 31, h = lane >> 5;
    const float lg2 = logsig2(a.in[dir ? I_DECB : I_DECF][L * 4 + hd]);
    f32x16 acc = zero16();
#pragma unroll
    for (int s = 0; s < 8; ++s) {
        const u32x4 kw = *(const LAS u32x4*)(KT + (dkb * 32 + r) * 136 + 16 * s + 8 * h);
        const int j0 = 16 * s + 8 * h;
        float w[8];
#pragma unroll
        for (int i = 0; i < 8; ++i) w[i] = fexp2(lg2 * (float)(dir ? (j0 + i) : (127 - j0 - i)));
        u32x4 ka; ka.x = pk2(bflo(kw.x) * w[0], bfhi(kw.x) * w[1]); ka.y = pk2(bflo(kw.y) * w[2], bfhi(kw.y) * w[3]);
        ka.z = pk2(bflo(kw.z) * w[4], bfhi(kw.z) * w[5]); ka.w = pk2(bflo(kw.w) * w[6], bfhi(kw.w) * w[7]);
        const bf16x8 vb = *(const LAS bf16x8*)(VT + (dvb * 32 + r) * 136 + 16 * s + 8 * h);
        acc = mfma32(as_bf16x8(ka), vb, acc);
    }
    float* dst = dst0 + (size_t)dir * (u < 1024 ? (size_t)16 * 64 * 4096 : (size_t)16 * 2 * 4096);
#pragma unroll
    for (int q = 0; q < 16; ++q) dst[(dkb * 32 + crow(q, h)) * 64 + dvb * 32 + r] = acc[q];
}

__device__ __forceinline__ void ret_scan_unit(const Args& a, int L, int u, int tid) { asm volatile("" : "+v"(tid));
    const int dir = u >> 7, bh = (u >> 3) & 15, e = (u & 7) * 512 + tid, hd = bh & 3;
    const float lg2 = logsig2(a.in[dir ? I_DECB : I_DECF][L * 4 + hd]); const float g128 = fexp2(lg2 * 128.f);
    float* st = (float*)(a.ws + WS_ST) + ((size_t)(dir * 16 + bh) * 64) * 4096 + e;
    const float* sc = (const float*)(a.ws + WS_STC) + ((size_t)(dir * 16 + bh) * 2) * 4096 + e;
    float S = dir == 0 ? g128 * sc[0] + sc[4096] : sc[0] + g128 * sc[4096];
    for (int n0 = 0; n0 < 64; n0 += 8) {
        float t[8];
#pragma unroll
        for (int i = 0; i < 8; ++i) { const int n = dir == 0 ? n0 + i : 63 - n0 - i; t[i] = st[(size_t)n * 4096]; }
#pragma unroll
        for (int i = 0; i < 8; ++i) { const int n = dir == 0 ? n0 + i : 63 - n0 - i; st[(size_t)n * 4096] = S; S = g128 * S + t[i]; }
    }
}

__device__ __forceinline__ void ret_out_unit(const Args& a, int L, int u, LAS unsigned char* lds, int tid, int lane, int wave) { asm volatile("" : "+v"(lane)); asm volatile("" : "+v"(tid));
    const bf16_t* U = (const bf16_t*)(a.ws + WS_U); const float* RR = (const float*)(a.ws + WS_ROPER);
    LAS bf16_t* Qs = (LAS bf16_t*)lds; LAS bf16_t* Ks = (LAS bf16_t*)(lds + 18432); LAS bf16_t* VT = (LAS bf16_t*)(lds + 36864);
    LAS bf16_t* SfT = (LAS bf16_t*)(lds + 54272); LAS bf16_t* SbT = (LAS bf16_t*)(lds + 63488); LAS float* Ob = (LAS float*)(lds + 72704);
    int b, hd, n, row0, t0; const float* sf; const float* sb;
    if (u < 1024) { b = u >> 8; hd = (u >> 6) & 3; n = u & 63; row0 = b * SEQ + n * 128; t0 = n * 128;
        sf = (const float*)(a.ws + WS_ST) + ((size_t)((b * 4 + hd) * 64 + n)) * 4096; sb = sf + (size_t)16 * 64 * 4096; }
    else { const int v = u - 1024; b = v >> 3; hd = (v >> 1) & 3; n = v & 1; row0 = ML + b * CTXL + n * 128; t0 = -1;
        const float* stc = (const float*)(a.ws + WS_STC) + ((size_t)((b * 4 + hd) * 2)) * 4096;
        sf = n == 1 ? stc : nullptr; sb = n == 0 ? stc + (size_t)16 * 2 * 4096 + 4096 : nullptr; }
    ret_stage<true, true, false>(U, RR, row0, t0, hd, Ks, Qs, Ks, VT, tid);
    {
        const int dk = tid >> 3, dv0 = (tid & 7) * 8;
#pragma unroll
        for (int i = 0; i < 8; ++i) { SfT[(dv0 + i) * 72 + dk] = (bf16_t)f2bf(sf ? sf[dk * 64 + dv0 + i] : 0.f); SbT[(dv0 + i) * 72 + dk] = (bf16_t)f2bf(sb ? sb[dk * 64 + dv0 + i] : 0.f); }
    }
    __syncthreads();
    const int dir = wave >> 2, it = wave & 3, r = lane & 31, h = lane >> 5;
    const float lg2 = logsig2(a.in[dir ? I_DECB : I_DECF][L * 4 + hd]);
    const int iq = it * 32 + r;
    bf16x8 qf[4];
#pragma unroll
    for (int s = 0; s < 4; ++s) qf[s] = *(const LAS bf16x8*)(Qs + iq * 72 + 16 * s + 8 * h);
    f32x16 o[2];
    {
        const LAS bf16_t* ST_ = dir ? SbT : SfT;
        const float fac = fexp2(lg2 * (float)(dir ? (128 - iq) : (iq + 1)));
#pragma unroll
        for (int dvb = 0; dvb < 2; ++dvb) { f32x16 c = zero16();
#pragma unroll
            for (int s = 0; s < 4; ++s) c = mfma32(*(const LAS bf16x8*)(ST_ + (dvb * 32 + r) * 72 + 16 * s + 8 * h), qf[s], c);
            o[dvb] = c * fac; }
    }
    const int jt0 = dir ? it : 0, jt1 = dir ? 3 : it;
    for (int jt = jt0; jt <= jt1; ++jt) {
        f32x16 sT = zero16();
#pragma unroll
        for (int s = 0; s < 4; ++s) sT = mfma32(*(const LAS bf16x8*)(Ks + (jt * 32 + r) * 72 + 16 * s + 8 * h), qf[s], sT);
        float p[16];
#pragma unroll
        for (int q = 0; q < 16; ++q) { const int j = jt * 32 + crow(q, h); const int d = dir ? (j - iq) : (iq - j); p[q] = d >= 0 ? sT[q] * fexp2(lg2 * (float)d) : 0.f; }
#pragma unroll
        for (int sp = 0; sp < 2; ++sp) {
            u32x4 pw; pw.x = pk2(p[8 * sp + 0], p[8 * sp + 1]); pw.y = pk2(p[8 * sp + 2], p[8 * sp + 3]); pw.z = pk2(p[8 * sp + 4], p[8 * sp + 5]); pw.w = pk2(p[8 * sp + 6], p[8 * sp + 7]);
#pragma unroll
            for (int dvb = 0; dvb < 2; ++dvb) {
                const LAS bf16_t* vp = VT + (dvb * 32 + r) * 136 + jt * 32 + 16 * sp + 4 * h;
                const u32x2 v0 = *(const LAS u32x2*)vp, v1 = *(const LAS u32x2*)(vp + 8);
                u32x4 vw; vw.x = v0.x; vw.y = v0.y; vw.z = v1.x; vw.w = v1.y;
                o[dvb] = mfma32(as_bf16x8(vw), as_bf16x8(pw), o[dvb]);
            }
        }
    }
    float ss = 0.f;
#pragma unroll
    for (int dvb = 0; dvb < 2; ++dvb)
#pragma unroll
        for (int q = 0; q < 16; ++q) ss += o[dvb][q] * o[dvb][q];
    ss += __shfl_xor(ss, 32);
    const float rn = 1.f / sqrtf(ss * (1.f / 64.f) + EPS);
    const bf16_t* Ug = U + (size_t)(dir ? 6 : 5) * MT * 256 + (size_t)(row0 + iq) * 256 + hd * 64;
#pragma unroll
    for (int dvb = 0; dvb < 2; ++dvb)
#pragma unroll
        for (int q4 = 0; q4 < 4; ++q4) { const int dv = dvb * 32 + 8 * q4 + 4 * h; const u32x2 gw = *(const u32x2*)(Ug + dv);
            o[dvb][4 * q4 + 0] *= rn * siluf(bflo(gw.x)); o[dvb][4 * q4 + 1] *= rn * siluf(bfhi(gw.x)); o[dvb][4 * q4 + 2] *= rn * siluf(bflo(gw.y)); o[dvb][4 * q4 + 3] *= rn * siluf(bfhi(gw.y)); }
    if (dir == 1) {
#pragma unroll
        for (int dvb = 0; dvb < 2; ++dvb)
#pragma unroll
            for (int q4 = 0; q4 < 4; ++q4) *(LAS f32x4*)(Ob + iq * 68 + dvb * 32 + 8 * q4 + 4 * h) = (f32x4){o[dvb][4 * q4], o[dvb][4 * q4 + 1], o[dvb][4 * q4 + 2], o[dvb][4 * q4 + 3]};
    }
    __syncthreads();
    if (dir == 0) {
        bf16_t* Y = (bf16_t*)(a.ws + WS_YBR) + (size_t)(row0 + iq) * 1024 + hd * 64;
#pragma unroll
        for (int dvb = 0; dvb < 2; ++dvb)
#pragma unroll
            for (int q4 = 0; q4 < 4; ++q4) { const int dv = dvb * 32 + 8 * q4 + 4 * h; const f32x4 ob = *(const LAS f32x4*)(Ob + iq * 68 + dv);
                u32x2 w; w.x = pk2(o[dvb][4 * q4] + ob[0], o[dvb][4 * q4 + 1] + ob[1]); w.y = pk2(o[dvb][4 * q4 + 2] + ob[2], o[dvb][4 * q4 + 3] + ob[3]);
                *(u32x2*)(Y + dv) = w; }
    }
}

__device__ __forceinline__ void mla_prep_wave(const Args& a, int L, int blk, int lane) { asm volatile("" : "+v"(lane));
    const unsigned char* ws = a.ws; const bf16_t* U = (const bf16_t*)(ws + WS_U);
    const int r = lane & 31, h = lane >> 5, row = blk * 32 + r; const bool isc = row >= ML;
    int b, key, t;
    if (!isc) { b = row >> 13; t = row & 8191; key = t; } else { const int rc = row - ML; b = rc >> 8; t = rc & 255; key = SEQ + t; }
    const float* RM = (const float*)(ws + WS_ROPEM);
    bf16_t* MK = (bf16_t*)(a.ws + WS_MK); bf16_t* MVT = (bf16_t*)(a.ws + WS_MVT);
    {
        const bf16_t* up = U + (size_t)9 * MT * 256 + (size_t)row * 256;
        u32x4 xs[8]; float ss = 0.f;
#pragma unroll
        for (int s = 0; s < 8; ++s) { xs[s] = *(const u32x4*)(up + 16 * s + 8 * h);
            const float v[8] = {bflo(xs[s].x), bfhi(xs[s].x), bflo(xs[s].y), bfhi(xs[s].y), bflo(xs[s].z), bfhi(xs[s].z), bflo(xs[s].w), bfhi(xs[s].w)};
#pragma unroll
            for (int i = 0; i < 8; ++i) ss += v[i] * v[i]; }
        ss += __shfl_xor(ss, 32);
        const float rstd = 1.f / sqrtf(ss * (1.f / 128.f) + EPS);
        const float* kvn = a.in[I_KVNORM] + L * 128;
#pragma unroll
        for (int s = 0; s < 8; ++s) { const f32x4 g0 = *(const f32x4*)(kvn + 16 * s + 8 * h), g1 = *(const f32x4*)(kvn + 16 * s + 8 * h + 4);
            u32x4 w; w.x = pk2(bflo(xs[s].x) * rstd * g0[0], bfhi(xs[s].x) * rstd * g0[1]); w.y = pk2(bflo(xs[s].y) * rstd * g0[2], bfhi(xs[s].y) * rstd * g0[3]);
            w.z = pk2(bflo(xs[s].z) * rstd * g1[0], bfhi(xs[s].z) * rstd * g1[1]); w.w = pk2(bflo(xs[s].w) * rstd * g1[2], bfhi(xs[s].w) * rstd * g1[3]); xs[s] = w;  asm volatile("" ::: "memory"); }
        const bf16_t* W = (const bf16_t*)(ws + WS_WUKV) + (size_t)L * 512 * 128;
        for (int ob = 0; ob < 16; ++ob) {
            f32x16 acc = zero16();
#pragma unroll
            for (int s = 0; s < 8; ++s) acc = mfma32(*(const bf16x8*)(W + (size_t)(ob * 32 + r) * 128 + 16 * s + 8 * h), as_bf16x8(xs[s]), acc);
            const int hh = ob >> 2, part = ob & 3;
            if (part < 2) {
                bf16_t* kp = MK + ((size_t)(b * 4 + hh) * 8448 + key) * 96 + part * 32 + 4 * h;
#pragma unroll
                for (int q4 = 0; q4 < 4; ++q4) { u32x2 w; w.x = pk2(acc[4 * q4], acc[4 * q4 + 1]); w.y = pk2(acc[4 * q4 + 2], acc[4 * q4 + 3]); *(u32x2*)(kp + 8 * q4) = w; }
            } else {
                bf16_t* vp = MVT + ((size_t)(b * 4 + hh) * 64 + (part - 2) * 32) * 8448 + key;
#pragma unroll
                for (int q = 0; q < 16; ++q) vp[(size_t)crow(q, h) * 8448] = (bf16_t)f2bf(acc[q]);
            }
        }
        const u32x4 a1 = *(const u32x4*)(up + 128 + 8 * h), a2 = *(const u32x4*)(up + 144 + 8 * h);
        float x1[8] = {bflo(a1.x), bfhi(a1.x), bflo(a1.y), bfhi(a1.y), bflo(a1.z), bfhi(a1.z), bflo(a1.w), bfhi(a1.w)};
        float x2[8] = {bflo(a2.x), bfhi(a2.x), bflo(a2.y), bfhi(a2.y), bflo(a2.z), bfhi(a2.z), bflo(a2.w), bfhi(a2.w)};
        float o1[8], o2[8];
#pragma unroll
        for (int i = 0; i < 8; ++i) { float c = 1.f, s = 0.f; if (!isc) { const f32x2 cs = *(const f32x2*)(RM + ((size_t)t * 16 + 8 * h + i) * 2); c = cs[0]; s = cs[1]; }
            o1[i] = x1[i] * c - x2[i] * s; o2[i] = x2[i] * c + x1[i] * s; }
        u32x4 w1, w2; w1.x = pk2(o1[0], o1[1]); w1.y = pk2(o1[2], o1[3]); w1.z = pk2(o1[4], o1[5]); w1.w = pk2(o1[6], o1[7]);
        w2.x = pk2(o2[0], o2[1]); w2.y = pk2(o2[2], o2[3]); w2.z = pk2(o2[4], o2[5]); w2.w = pk2(o2[6], o2[7]);
#pragma unroll
        for (int hh = 0; hh < 4; ++hh) { bf16_t* kp = MK + ((size_t)(b * 4 + hh) * 8448 + key) * 96 + 64; *(u32x4*)(kp + 8 * h) = w1; *(u32x4*)(kp + 16 + 8 * h) = w2; }
    }
    if (!isc || L == 0) {
        const bf16_t* up = U + (size_t)10 * MT * 256 + (size_t)row * 256;
        u32x4 xs[12]; float ss = 0.f;
#pragma unroll
        for (int s = 0; s < 12; ++s) { xs[s] = *(const u32x4*)(up + 16 * s + 8 * h);
            const float v[8] = {bflo(xs[s].x), bfhi(xs[s].x), bflo(xs[s].y), bfhi(xs[s].y), bflo(xs[s].z), bfhi(xs[s].z), bflo(xs[s].w), bfhi(xs[s].w)};
#pragma unroll
            for (int i = 0; i < 8; ++i) ss += v[i] * v[i]; }
        ss += __shfl_xor(ss, 32);
        const float rstd = 1.f / sqrtf(ss * (1.f / 192.f) + EPS);
        const float* qn = a.in[I_QNORM] + L * 192;
#pragma unroll
        for (int s = 0; s < 12; ++s) { const f32x4 g0 = *(const f32x4*)(qn + 16 * s + 8 * h), g1 = *(const f32x4*)(qn + 16 * s + 8 * h + 4);
            u32x4 w; w.x = pk2(bflo(xs[s].x) * rstd * g0[0], bfhi(xs[s].x) * rstd * g0[1]); w.y = pk2(bflo(xs[s].y) * rstd * g0[2], bfhi(xs[s].y) * rstd * g0[3]);
            w.z = pk2(bflo(xs[s].z) * rstd * g1[0], bfhi(xs[s].z) * rstd * g1[1]); w.w = pk2(bflo(xs[s].w) * rstd * g1[2], bfhi(xs[s].w) * rstd * g1[3]); xs[s] = w;  asm volatile("" ::: "memory"); }
        const bf16_t* W = (const bf16_t*)(ws + WS_WUQ) + (size_t)L * 384 * 192;
        const float qsc = 0.10206207261596577f * LOG2E;
        for (int ob = 0; ob < 12; ++ob) {
            f32x16 acc = zero16();
#pragma unroll
            for (int s = 0; s < 12; ++s) acc = mfma32(*(const bf16x8*)(W + (size_t)(ob * 32 + r) * 192 + 16 * s + 8 * h), as_bf16x8(xs[s]), acc);
            const int hh = ob / 3, part = ob % 3;
            if (part == 2 && !isc) {
#pragma unroll
                for (int q = 0; q < 8; ++q) { const f32x2 cs = *(const f32x2*)(RM + ((size_t)t * 16 + crow(q, h)) * 2); const float x1 = acc[q], x2 = acc[q + 8];
                    acc[q] = x1 * cs[0] - x2 * cs[1]; acc[q + 8] = x2 * cs[0] + x1 * cs[1]; }
            }
            bf16_t* qp = isc ? (bf16_t*)(a.ws + WS_MQC) + ((size_t)(b * 4 + hh) * 256 + t) * 96 : (bf16_t*)(a.ws + WS_MQ) + ((size_t)(b * 4 + hh) * 8192 + t) * 96;
            qp += part * 32 + 4 * h;
#pragma unroll
            for (int q4 = 0; q4 < 4; ++q4) { u32x2 w; w.x = pk2(acc[4 * q4] * qsc, acc[4 * q4 + 1] * qsc); w.y = pk2(acc[4 * q4 + 2] * qsc, acc[4 * q4 + 3] * qsc); *(u32x2*)(qp + 8 * q4) = w; }
        }
    }
}

__device__ __forceinline__ void four_stage1_unit(const Args& a, int u, int lane, int wave) { asm volatile("" : "+v"(lane));
    const unsigned char* ws = a.ws; const bf16_t* F = (const bf16_t*)(ws + WS_U) + (size_t)7 * MT * 256;
    const int b = u >> 6, t1 = u & 63, r = lane & 31, h = lane >> 5, c = wave * 32 + r;
    u32x4 fr[8];
#pragma unroll
    for (int s = 0; s < 8; ++s) { unsigned e[8];
#pragma unroll
        for (int j = 0; j < 8; ++j) e[j] = F[(size_t)(b * SEQ + t1 + 64 * (16 * s + 8 * h + j)) * 256 + c];
        fr[s].x = e[0] | (e[1] << 16); fr[s].y = e[2] | (e[3] << 16); fr[s].z = e[4] | (e[5] << 16); fr[s].w = e[6] | (e[7] << 16); }
    const bf16_t* M1 = (const bf16_t*)(ws + WS_M1); const float* TW = (const float*)(ws + WS_TW);
    unsigned* A2 = (unsigned*)(a.ws + WS_A2) + ((size_t)(b * 64 + t1) * 128) * 256 + c;
    for (int i = 0; i < 4; ++i) {
        f32x16 ar = zero16(), ai = zero16();
#pragma unroll
        for (int s = 0; s < 8; ++s) { ar = mfma32(*(const bf16x8*)(M1 + (size_t)(32 * i + r) * 128 + 16 * s + 8 * h), as_bf16x8(fr[s]), ar);
            ai = mfma32(*(const bf16x8*)(M1 + (size_t)(128 + 32 * i + r) * 128 + 16 * s + 8 * h), as_bf16x8(fr[s]), ai); }
#pragma unroll
        for (int q = 0; q < 16; ++q) { const int k2 = 32 * i + crow(q, h); const f32x2 w = *(const f32x2*)(TW + 2 * (k2 * t1));
            A2[(size_t)k2 * 256] = pk2(ar[q] * w[0] + ai[q] * w[1], ai[q] * w[0] - ar[q] * w[1]); }
    }
}
__device__ __forceinline__ void four_stage2_unit(const Args& a, int u, int lane, int wave) { asm volatile("" : "+v"(lane));
    const unsigned char* ws = a.ws;
    const int b = u >> 7, k2 = u & 127, r = lane & 31, h = lane >> 5, g = wave >> 1, kb = wave & 1;
    const unsigned* A2 = (const unsigned*)(ws + WS_A2) + ((size_t)(b * 64) * 128 + k2) * 256;
    const bf16_t* D2 = (const bf16_t*)(ws + WS_D2); const bf16_t* EP = (const bf16_t*)(ws + WS_EP);
    f32x16 acc[2][2];
#pragma unroll
    for (int ct = 0; ct < 2; ++ct)
#pragma unroll
        for (int ro = 0; ro < 2; ++ro) acc[ct][ro] = zero16();
#pragma unroll
    for (int s = 0; s < 8; ++s) {
        const bf16x8 d0 = *(const bf16x8*)(D2 + (size_t)(kb * 32 + r) * 128 + 16 * s + 8 * h), d1 = *(const bf16x8*)(D2 + (size_t)(64 + kb * 32 + r) * 128 + 16 * s + 8 * h);
#pragma unroll
        for (int ct = 0; ct < 2; ++ct) { const int c = g * 64 + ct * 32 + r; u32x4 f;
            f.x = A2[(size_t)(8 * s + 4 * h + 0) * 128 * 256 + c]; f.y = A2[(size_t)(8 * s + 4 * h + 1) * 128 * 256 + c];
            f.z = A2[(size_t)(8 * s + 4 * h + 2) * 128 * 256 + c]; f.w = A2[(size_t)(8 * s + 4 * h + 3) * 128 * 256 + c];
            acc[ct][0] = mfma32(as_bf16x8(f), d0, acc[ct][0]); acc[ct][1] = mfma32(as_bf16x8(f), d1, acc[ct][1]); }
    }
    f32x16 y[2] = {zero16(), zero16()};
#pragma unroll
    for (int ro = 0; ro < 2; ++ro)
#pragma unroll
        for (int ct = 0; ct < 2; ++ct)
#pragma unroll
            for (int sp = 0; sp < 2; ++sp) { const f32x16& x = acc[ct][ro];
                u32x4 xw; xw.x = pk2(x[8 * sp + 0], x[8 * sp + 1]); xw.y = pk2(x[8 * sp + 2], x[8 * sp + 3]); xw.z = pk2(x[8 * sp + 4], x[8 * sp + 5]); xw.w = pk2(x[8 * sp + 6], x[8 * sp + 7]);
#pragma unroll
                for (int lb = 0; lb < 2; ++lb) y[lb] = mfma32(*(const bf16x8*)(EP + (size_t)(lb * 32 + r) * 128 + ro * 64 + ct * 32 + sp * 16 + h * 8), as_bf16x8(xw), y[lb]); }
    const float sc = 0.0013810679320049757f;
    bf16_t* Y = (bf16_t*)(a.ws + WS_YBR) + ((size_t)(b * SEQ + 128 * (kb * 32 + r) + k2)) * 1024 + 256 + g * 64;
#pragma unroll
    for (int lb = 0; lb < 2; ++lb)
#pragma unroll
        for (int q4 = 0; q4 < 4; ++q4) { u32x2 w; w.x = pk2(y[lb][4 * q4] * sc, y[lb][4 * q4 + 1] * sc); w.y = pk2(y[lb][4 * q4 + 2] * sc, y[lb][4 * q4 + 3] * sc);
            *(u32x2*)(Y + lb * 32 + 8 * q4 + 4 * h) = w; }
}
__device__ __forceinline__ void cfour_step1_unit(const Args& a, int u, LAS unsigned char* lds, int tid) { asm volatile("" : "+v"(tid));
    LAS float* fl = (LAS float*)lds;
    LAS float* cs = (LAS float*)(lds + 2048);
    const bf16_t* F = (const bf16_t*)(a.ws + WS_U) + (size_t)7 * MT * 256;
    const int rr = tid >> 8, col = tid & 255, row = 2 * u + rr;
    fl[tid] = bf2f(F[(size_t)(ML + row) * 256 + col]);
    if (tid < 64) { const float ang = 6.283185307179586f * (float)tid / 64.f; cs[2 * tid] = cosf(ang); cs[2 * tid + 1] = sinf(ang); }
    __syncthreads();
    const int g = col >> 6, l = col & 63; float p = 0.f, q = 0.f;
    for (int c = 0; c < 64; ++c) { const float f = fl[rr * 256 + g * 64 + c]; const int m = (l * c) & 63; p += f * cs[2 * m]; q += f * cs[2 * m + 1]; }
    float* O = (float*)(a.ws + WS_CPQ) + (size_t)row * 512; O[col] = p; O[256 + col] = q;
}
__device__ __forceinline__ void cfour_step2_unit(const Args& a, int u, LAS unsigned char* lds, int tid) { asm volatile("" : "+v"(tid));
    LAS float* cs = (LAS float*)lds;
    if (tid < 256) { const float ang = 6.283185307179586f * (float)tid / 256.f; cs[2 * tid] = cosf(ang); cs[2 * tid + 1] = sinf(ang); }
    __syncthreads();
    const int b = u >> 7, k = (u & 127) * 2 + (tid >> 8), col = tid & 255;
    const float* P = (const float*)(a.ws + WS_CPQ) + (size_t)(b * 256) * 512 + col; float acc = 0.f;
    for (int t = 0; t < 256; ++t) { const int m = (k * t) & 255; acc += cs[2 * m] * P[(size_t)t * 512] - cs[2 * m + 1] * P[(size_t)t * 512 + 256]; }
    ((bf16_t*)(a.ws + WS_YBR))[(size_t)(ML + b * 256 + k) * 1024 + 256 + col] = (bf16_t)f2bf(acc * (1.f / 128.f));
}

__device__ __forceinline__ void osm_step(const f32x16& x, float& m, float& l, f32x16& o0, f32x16& o1, u32x4& p0, u32x4& p1) {
    float bm = fmaxf(fmaxf(x[0], x[1]), fmaxf(x[2], x[3]));
#pragma unroll
    for (int q = 4; q < 16; q += 4) bm = fmaxf(bm, fmaxf(fmaxf(x[q], x[q + 1]), fmaxf(x[q + 2], x[q + 3])));
    bm = fmaxf(bm, __shfl_xor(bm, 32));
    const float mn = fmaxf(m, bm);
    const float alpha = fexp2(m - mn);
    float p[16]; float ps = 0.f;
#pragma unroll
    for (int q = 0; q < 16; ++q) { p[q] = fexp2(x[q] - mn); ps += p[q]; }
    l = l * alpha + ps; m = mn;
    o0 = o0 * alpha; o1 = o1 * alpha;
    p0.x = pk2(p[0], p[1]); p0.y = pk2(p[2], p[3]); p0.z = pk2(p[4], p[5]); p0.w = pk2(p[6], p[7]);
    p1.x = pk2(p[8], p[9]); p1.y = pk2(p[10], p[11]); p1.z = pk2(p[12], p[13]); p1.w = pk2(p[14], p[15]);
}

__device__ __forceinline__ void na_unit(const Args& a, int L, int u, LAS unsigned char* lds, int tid, int lane, int wave) { asm volatile("" : "+v"(lane)); asm volatile("" : "+v"(tid));
    const bf16_t* U = (const bf16_t*)(a.ws + WS_U);
    const bf16_t* UK = U + (size_t)2 * MT * 256; const bf16_t* UV = U + (size_t)3 * MT * 256; const bf16_t* UQ = U + (size_t)8 * MT * 256;
    LAS float* rp = (LAS float*)lds;
    for (int i = tid; i < 4 * 465; i += 512) rp[i] = a.in[I_RPB][(size_t)L * 4 * 465 + i];
    __syncthreads();
    const int hd = wave >> 1, qh = wave & 1, r = lane & 31, h = lane >> 5;
    const bool isc = u >= 512; int b, gr = 0, rs = 0, qrow;
    if (!isc) { b = u >> 7; gr = u & 127; rs = gr - 4; rs = rs < 0 ? 0 : (rs > 120 ? 120 : rs); qrow = b * SEQ + gr * 64 + qh * 32 + r; }
    else { const int v = u - 512; b = v >> 2; qrow = ML + b * CTXL + (v & 3) * 64 + qh * 32 + r; }
    const int cq = qh * 32 + r; int cs = cq - 8; cs = cs < 0 ? 0 : (cs > 48 ? 48 : cs);
    bf16x8 qf[4];
#pragma unroll
    for (int s = 0; s < 4; ++s) qf[s] = *(const bf16x8*)(UQ + (size_t)qrow * 256 + hd * 64 + 16 * s + 8 * h);
    float m = -INFINITY, l = 0.f; f32x16 o0 = zero16(), o1 = zero16();
    const int nblk = isc ? 8 : 24;
    for (int kb = 0; kb < nblk; ++kb) {
        int krow0; int li = 0, cbk = 0;
        if (kb < 8) krow0 = ML + b * CTXL + kb * 32;
        else { li = (kb - 8) >> 1; cbk = (kb - 8) & 1; krow0 = b * SEQ + (rs + li) * 64 + cbk * 32; }
        f32x16 sT = zero16();
#pragma unroll
        for (int s = 0; s < 4; ++s) sT = mfma32(*(const bf16x8*)(UK + (size_t)(krow0 + r) * 256 + hd * 64 + 16 * s + 8 * h), qf[s], sT);
        f32x16 x;
        if (kb < 8) {
#pragma unroll
            for (int q = 0; q < 16; ++q) x[q] = sT[q] * (0.125f * LOG2E);
        } else {
            const LAS float* bp = rp + hd * 465 + (rs + li - gr + 7) * 31 + 15 - cq;
#pragma unroll
            for (int q = 0; q < 16; ++q) { const int ck = cbk * 32 + crow(q, h); const bool ok = (ck >= cs) && (ck < cs + 16);
                x[q] = ok ? (sT[q] * 0.125f + bp[ok ? ck : cq]) * LOG2E : -INFINITY; }
        }
        u32x4 p0, p1;
        osm_step(x, m, l, o0, o1, p0, p1);
#pragma unroll
        for (int sp = 0; sp < 2; ++sp) {
#pragma unroll
            for (int dvb = 0; dvb < 2; ++dvb) { unsigned e[8];
#pragma unroll
                for (int j = 0; j < 8; ++j) e[j] = UV[(size_t)(krow0 + 16 * sp + 8 * (j >> 2) + 4 * h + (j & 3)) * 256 + hd * 64 + dvb * 32 + r];
                u32x4 vw; vw.x = e[0] | (e[1] << 16); vw.y = e[2] | (e[3] << 16); vw.z = e[4] | (e[5] << 16); vw.w = e[6] | (e[7] << 16);
                if (dvb == 0) o0 = mfma32(as_bf16x8(vw), as_bf16x8(sp ? p1 : p0), o0); else o1 = mfma32(as_bf16x8(vw), as_bf16x8(sp ? p1 : p0), o1); }
        }
    }
    l += __shfl_xor(l, 32);
    const float il = 1.f / l;
    bf16_t* Y = (bf16_t*)(a.ws + WS_YBR) + (size_t)qrow * 1024 + 512 + hd * 64 + 4 * h;
#pragma unroll
    for (int q4 = 0; q4 < 4; ++q4) { u32x2 w; w.x = pk2(o0[4 * q4] * il, o0[4 * q4 + 1] * il); w.y = pk2(o0[4 * q4 + 2] * il, o0[4 * q4 + 3] * il); *(u32x2*)(Y + 8 * q4) = w;
        u32x2 w2; w2.x = pk2(o1[4 * q4] * il, o1[4 * q4 + 1] * il); w2.y = pk2(o1[4 * q4 + 2] * il, o1[4 * q4 + 3] * il); *(u32x2*)(Y + 32 + 8 * q4) = w2; }
}

__device__ __forceinline__ void mla_unit(const Args& a, int u, LAS unsigned char* lds, int tid, int lane, int wave) { asm volatile("" : "+v"(lane)); asm volatile("" : "+v"(tid));
    const bool isc = u >= 512; int bh, q0, key0, nt; size_t orow0;
    if (!isc) { bh = u >> 5; q0 = (u & 31) * 256; key0 = 0; nt = 132; orow0 = (size_t)(bh >> 2) * SEQ + q0; }
    else { bh = u - 512; q0 = 0; key0 = SEQ; nt = 4; orow0 = (size_t)ML + (size_t)(bh >> 2) * CTXL; }
    const int hd = bh & 3, r = lane & 31, h = lane >> 5;
    const bf16_t* Q = isc ? (const bf16_t*)(a.ws + WS_MQC) + (size_t)bh * 256 * 96 : (const bf16_t*)(a.ws + WS_MQ) + ((size_t)bh * 8192 + q0) * 96;
    const bf16_t* Kg = (const bf16_t*)(a.ws + WS_MK) + ((size_t)bh * 8448 + key0) * 96;
    const bf16_t* Vg = (const bf16_t*)(a.ws + WS_MVT) + (size_t)bh * 64 * 8448 + key0;
    LAS unsigned char* KB = lds; LAS unsigned char* VB = lds + 26624;
    bf16x8 qf[6];
#pragma unroll
    for (int s = 0; s < 6; ++s) qf[s] = *(const bf16x8*)(Q + (size_t)(wave * 32 + r) * 96 + 16 * s + 8 * h);
    const int p0k = tid, p1k = tid + 512; const int k0key = p0k / 12, k0part = p0k % 12, k1key = p1k / 12, k1part = p1k % 12; const int vdv = tid >> 3, vpart = tid & 7;
    u32x4 rk0, rk1, rv;
    rk0 = *(const u32x4*)(Kg + (size_t)k0key * 96 + k0part * 8); if (p1k < 768) rk1 = *(const u32x4*)(Kg + (size_t)k1key * 96 + k1part * 8);
    rv = *(const u32x4*)(Vg + (size_t)vdv * 8448 + vpart * 8);
    *(LAS u32x4*)(KB + k0key * 208 + k0part * 16) = rk0; if (p1k < 768) *(LAS u32x4*)(KB + k1key * 208 + k1part * 16) = rk1;
    *(LAS u32x4*)(VB + vdv * 144 + vpart * 16) = rv;
    __syncthreads();
    float m = -INFINITY, l = 0.f; f32x16 o0 = zero16(), o1 = zero16();
    for (int t = 0; t < nt; ++t) {
        const int cur = t & 1;
        if (t + 1 < nt) { const bf16_t* kg = Kg + (size_t)(t + 1) * 64 * 96; rk0 = *(const u32x4*)(kg + (size_t)k0key * 96 + k0part * 8); if (p1k < 768) rk1 = *(const u32x4*)(kg + (size_t)k1key * 96 + k1part * 8);
            rv = *(const u32x4*)(Vg + (size_t)vdv * 8448 + (t + 1) * 64 + vpart * 8); }
        const LAS unsigned char* kb_ = KB + cur * 13312; const LAS unsigned char* vb_ = VB + cur * 9216;
#pragma unroll
        for (int blk = 0; blk < 2; ++blk) {
            f32x16 sT = zero16();
#pragma unroll
            for (int s = 0; s < 6; ++s) sT = mfma32(*(const LAS bf16x8*)(kb_ + (blk * 32 + r) * 208 + 32 * s + 16 * h), qf[s], sT);
            u32x4 p0, p1;
            osm_step(sT, m, l, o0, o1, p0, p1);
#pragma unroll
            for (int sp = 0; sp < 2; ++sp) {
#pragma unroll
                for (int dvb = 0; dvb < 2; ++dvb) { const LAS unsigned char* vp = vb_ + (dvb * 32 + r) * 144 + (blk * 32 + 16 * sp + 4 * h) * 2;
                    const u32x2 v0 = *(const LAS u32x2*)vp, v1 = *(const LAS u32x2*)(vp + 16); u32x4 vw; vw.x = v0.x; vw.y = v0.y; vw.z = v1.x; vw.w = v1.y;
                    if (dvb == 0) o0 = mfma32(as_bf16x8(vw), as_bf16x8(sp ? p1 : p0), o0); else o1 = mfma32(as_bf16x8(vw), as_bf16x8(sp ? p1 : p0), o1); }
            }
        }
        if (t + 1 < nt) { LAS unsigned char* kn = KB + (cur ^ 1) * 13312; LAS unsigned char* vn = VB + (cur ^ 1) * 9216;
            *(LAS u32x4*)(kn + k0key * 208 + k0part * 16) = rk0; if (p1k < 768) *(LAS u32x4*)(kn + k1key * 208 + k1part * 16) = rk1;
            *(LAS u32x4*)(vn + vdv * 144 + vpart * 16) = rv; }
        __syncthreads();
    }
    l += __shfl_xor(l, 32);
    const float il = 1.f / l;
    bf16_t* Y = (bf16_t*)(a.ws + WS_YBR) + (orow0 + wave * 32 + r) * 1024 + 768 + hd * 64 + 4 * h;
#pragma unroll
    for (int q4 = 0; q4 < 4; ++q4) { u32x2 w; w.x = pk2(o0[4 * q4] * il, o0[4 * q4 + 1] * il); w.y = pk2(o0[4 * q4 + 2] * il, o0[4 * q4 + 3] * il); *(u32x2*)(Y + 8 * q4) = w;
        u32x2 w2; w2.x = pk2(o1[4 * q4] * il, o1[4 * q4 + 1] * il); w2.y = pk2(o1[4 * q4 + 2] * il, o1[4 * q4 + 3] * il); *(u32x2*)(Y + 32 + 8 * q4) = w2; }
}

__device__ __forceinline__ void moe_offsets(const unsigned* cnt, int (&pst)[NE], int& ntiles) {
    int acc = 0;
#pragma unroll
    for (int e = 0; e < NE; ++e) { pst[e] = acc; const int c = (int)__hip_atomic_load(cnt + e, __ATOMIC_RELAXED, __HIP_MEMORY_SCOPE_AGENT); acc += (c + 255) / 256 * 256; }
    ntiles = acc / 256;
}
__device__ __forceinline__ void ffn_norm_row(const float* xr, const f32x4 (&gn)[4], const float* mv, int lane, f32x4 (&y)[4]) {
    f32x4 v[4]; float ss = 0.f;
#pragma unroll
    for (int j = 0; j < 4; ++j) { v[j] = *(const f32x4*)(xr + 4 * lane + 256 * j); ss += (v[j][0] * v[j][0] + v[j][1] * v[j][1]) + (v[j][2] * v[j][2] + v[j][3] * v[j][3]); }
    const float rstd = 1.f / sqrtf(wave_sum(ss) * (1.f / 1024.f) + EPS);
#pragma unroll
    for (int j = 0; j < 4; ++j) { const f32x4 sc = *(const f32x4*)(mv + 4096 + 4 * lane + 256 * j), sh = *(const f32x4*)(mv + 3072 + 4 * lane + 256 * j);
        y[j] = v[j] * rstd * gn[j] * (sc + 1.f) + sh; }
}
__device__ __forceinline__ void ph_route(const Args& a, LAS unsigned char* lds, int tid, int lane, int wave, int bid, int G) { asm volatile("" : "+v"(lane)); asm volatile("" : "+v"(tid));
    unsigned char* ws = a.ws; unsigned* ctl = (unsigned*)(ws + WS_CTL);
    const int gt = bid * 512 + tid, NGT = G * 512, gw = bid * 8 + wave, NGW = G * 8;
    int* rowinfo = (int*)(ws + WS_ROWINFO);
    for (int i = gt; i < NRMAX; i += NGT) rowinfo[i] = -1;
    LAS float* rt = (LAS float*)lds;
    for (int i = tid; i < 8192; i += 512) rt[i] = a.in[I_ROUTER][i];
    __syncthreads();
    const float* modL = (const float*)(ws + WS_MOD) + (size_t)5 * 6144;
    f32x4 gn[4];
#pragma unroll
    for (int j = 0; j < 4; ++j) gn[j] = *(const f32x4*)(a.in[I_NFFN] + 1024 + 4 * lane + 256 * j);
    unsigned mycnt = 0;
    for (int row = gw; row < ML; row += NGW) {
        f32x4 y[4]; ffn_norm_row(a.out + (size_t)row * 1024, gn, modL + (size_t)(row >> 13) * 6144, lane, y);
        float lg[8] = {0.f, 0.f, 0.f, 0.f, 0.f, 0.f, 0.f, 0.f};
#pragma unroll
        for (int j = 0; j < 4; ++j)
#pragma unroll
            for (int i = 0; i < 4; ++i) { const int k = 4 * lane + 256 * j + i; const f32x4 r0 = *(const LAS f32x4*)(rt + k * 8), r1 = *(const LAS f32x4*)(rt + k * 8 + 4); const float hv = y[j][i];
                lg[0] += hv * r0[0]; lg[1] += hv * r0[1]; lg[2] += hv * r0[2]; lg[3] += hv * r0[3]; lg[4] += hv * r1[0]; lg[5] += hv * r1[1]; lg[6] += hv * r1[2]; lg[7] += hv * r1[3]; }
#pragma unroll
        for (int e = 0; e < 8; ++e) lg[e] = wave_sum(lg[e]);
        int e0 = 0; float l0 = lg[0];
#pragma unroll
        for (int e = 1; e < 8; ++e) if (lg[e] > l0) { l0 = lg[e]; e0 = e; }
        int e1 = -1; float l1 = -INFINITY;
#pragma unroll
        for (int e = 0; e < 8; ++e) if (e != e0 && lg[e] > l1) { l1 = lg[e]; e1 = e; }
        const float w0 = 1.f / (1.f + expf(l1 - l0)), w1 = 1.f - w0;
        if (lane == 0) { u32x4 t; t.x = (unsigned)e0; t.y = (unsigned)e1; t.z = __float_as_uint(w0); t.w = __float_as_uint(w1); *(u32x4*)(ws + WS_TOK + (size_t)row * 16) = t; }
        mycnt += (lane == e0 || lane == e1) ? 1u : 0u;
    }
    if (lane < 8 && mycnt) atomicAdd(ctl + CW_CNT + lane, mycnt);
    __syncthreads();
    LAS float* scr = (LAS float*)(lds + 32768 + wave * 8448);
    constexpr int IGU = 16 * 224, IDN = 56 * 32;
    for (int it = gw; it < NE * (IGU + IDN); it += NGW) {
        const int e = it / (IGU + IDN); int r = it % (IGU + IDN);
        if (r < IGU) { const int kb = r / 224, nb = r % 224, pn = nb >> 3, wi = nb & 7;
            cvt_block((wi < 4 ? a.in[I_MG] : a.in[I_MU]) + (size_t)e * 1024 * MF, MF, kb * 64, 128 * pn + 32 * (wi & 3), (bf16_t*)(ws + WS_MWGU) + (size_t)e * 7168 * 1024, nb * 32, 1024, scr, lane); }
        else { r -= IGU; const int kb = r / 32, nb = r % 32;
            cvt_block(a.in[I_MD] + (size_t)e * MF * 1024, 1024, kb * 64, nb * 32, (bf16_t*)(ws + WS_MWD) + (size_t)e * 1024 * MF, nb * 32, MF, scr, lane); }
    }
}
__device__ __forceinline__ void ph_place(const Args& a, int tid, int lane, int wave, int bid, int G) { asm volatile("" : "+v"(lane)); asm volatile("" : "+v"(tid));
    unsigned char* ws = a.ws; unsigned* ctl = (unsigned*)(ws + WS_CTL);
    int pst[NE], ntiles; moe_offsets(ctl + CW_CNT, pst, ntiles);
    if (bid == 0 && tid < 264) { int e = -1;
#pragma unroll
        for (int q = 0; q < NE; ++q) if (tid * 256 >= pst[q]) e = q;
        ((int*)(ws + WS_TILEE))[tid] = tid < ntiles ? e : -1; }
    const int gw = bid * 8 + wave, NGW = G * 8;
    const float* modL = (const float*)(ws + WS_MOD) + (size_t)5 * 6144;
    f32x4 gn[4];
#pragma unroll
    for (int j = 0; j < 4; ++j) gn[j] = *(const f32x4*)(a.in[I_NFFN] + 1024 + 4 * lane + 256 * j);
    int* rowinfo = (int*)(ws + WS_ROWINFO); float* roww = (float*)(ws + WS_ROWW); bf16_t* XG = (bf16_t*)(ws + WS_XG);
    for (int row = gw; row < ML; row += NGW) {
        f32x4 y[4]; ffn_norm_row(a.out + (size_t)row * 1024, gn, modL + (size_t)(row >> 13) * 6144, lane, y);
        u32x2 w[4];
#pragma unroll
        for (int j = 0; j < 4; ++j) { w[j].x = pk2(y[j][0], y[j][1]); w[j].y = pk2(y[j][2], y[j][3]); }
        const u32x4 tk = *(const u32x4*)(ws + WS_TOK + (size_t)row * 16);
#pragma unroll
        for (int k = 0; k < 2; ++k) { const int e = (int)(k ? tk.y : tk.x); const float wt = __uint_as_float(k ? tk.w : tk.z);
            int pe = 0;
#pragma unroll
            for (int q = 0; q < NE; ++q) pe = (q == e) ? pst[q] : pe;
            int slot = 0; if (lane == 0) slot = (int)atomicAdd(ctl + CW_CUR + e, 1u);
            slot = __builtin_amdgcn_readfirstlane(slot);
            const int dest = pe + slot;
            if (lane == 0) { rowinfo[dest] = row * 2 + k; roww[dest] = wt; }
            u32x2* o8 = (u32x2*)(XG + (size_t)dest * 1024) + lane;
#pragma unroll
            for (int j = 0; j < 4; ++j) o8[64 * j] = w[j]; }
    }
}
__device__ __forceinline__ void ph_final(const Args& a, int lane, int wave, int bid, int G) { asm volatile("" : "+v"(lane));
    unsigned char* ws = a.ws; const int gw = bid * 8 + wave, NGW = G * 8;
    const float* modL = (const float*)(ws + WS_MOD) + (size_t)5 * 6144;
    const bf16_t* Y0 = (const bf16_t*)(ws + WS_Y01); const bf16_t* Y1 = Y0 + (size_t)ML * 1024;
    f32x4 gn[4];
#pragma unroll
    for (int j = 0; j < 4; ++j) gn[j] = *(const f32x4*)(a.in[I_NFINAL] + 4 * lane + 256 * j);
    for (int row = gw; row < ML; row += NGW) {
        float* xr = a.out + (size_t)row * 1024; const float* g2 = modL + (size_t)(row >> 13) * 6144 + 5120;
        f32x4 v[4]; float ss = 0.f;
#pragma unroll
        for (int j = 0; j < 4; ++j) { const f32x4 x = *(const f32x4*)(xr + 4 * lane + 256 * j), gg = *(const f32x4*)(g2 + 4 * lane + 256 * j);
            const u32x2 ya = *(const u32x2*)(Y0 + (size_t)row * 1024 + 4 * lane + 256 * j), yb = *(const u32x2*)(Y1 + (size_t)row * 1024 + 4 * lane + 256 * j);
            f32x4 yy; yy[0] = bflo(ya.x) + bflo(yb.x); yy[1] = bfhi(ya.x) + bfhi(yb.x); yy[2] = bflo(ya.y) + bflo(yb.y); yy[3] = bfhi(ya.y) + bfhi(yb.y);
            v[j] = x + gg * yy; ss += (v[j][0] * v[j][0] + v[j][1] * v[j][1]) + (v[j][2] * v[j][2] + v[j][3] * v[j][3]); }
        const float rstd = 1.f / sqrtf(wave_sum(ss) * (1.f / 1024.f) + EPS);
#ifdef DBG_FINAL
        { float so = 0.f; bool nn = false;
#pragma unroll
          for (int j = 0; j < 4; ++j) { const f32x4 o = v[j] * rstd * gn[j];
#pragma unroll
            for (int i = 0; i < 4; ++i) { so += o[i] * o[i]; if (!(o[i] - o[i] == 0.f)) nn = true; } }
          const float sv = wave_sum(ss), so2 = wave_sum(so);
          if (lane == 0) { atomicAdd((float*)(ws + WS_CTL) + 9001, sv); atomicAdd((float*)(ws + WS_CTL) + 9002, so2); }
          if (nn) atomicMax((unsigned*)(ws + WS_CTL) + 9003, 1u); }
#endif
#pragma unroll
        for (int j = 0; j < 4; ++j) { f32x4 o = v[j] * rstd * gn[j];
#ifdef DBG_FINAL
            o = v[j];
#endif
#ifdef DBG_SANITIZE
#pragma unroll
            for (int i = 0; i < 4; ++i) o[i] = (o[i] - o[i] == 0.f) ? o[i] : 0.f;
#endif
            *(f32x4*)(xr + 4 * lane + 256 * j) = o; }
    }
}

#ifndef DIS
#define DIS 0
#endif
#ifndef PH_MASK
#define PH_MASK 0xFFFFFFFFu
#endif
#define IN(k) (((PH_MASK >> ((k) >= 25 ? ((k) == 35 ? 15 : 13 + (((k) - 25) & 1)) : (k) == 0 ? 0 : (((k) - 1) % 12) + 1)) & 1u) && lo <= (k) && (k) < hi)
#define SEAM() do { if (multi) xcd_barrier(bar, wave == 0 && my_lane() == 0); } while (0)
template <int L>
__device__ __forceinline__ void layer_phases(const Args& a, LAS unsigned char* lds, int wave, int bid, int G, int lo, int hi, bool multi, const XcdBarrier& bar, volatile LAS int* qslot) {
    unsigned char* ws = a.ws; unsigned* ctl = (unsigned*)(ws + WS_CTL);
    const int gw = bid * 8 + wave, NGW = G * 8;
    float* MOD = (float*)(ws + WS_MOD);
    bf16_t* Hb = (bf16_t*)(ws + WS_H); bf16_t* Ub = (bf16_t*)(ws + WS_U); bf16_t* YBR = (bf16_t*)(ws + WS_YBR); bf16_t* SG = (bf16_t*)(ws + WS_SG);
    float* XC = (float*)(ws + WS_XC);
        const int LB = 1 + 12 * L;
        const float* modL = MOD + (size_t)L * 5 * 6144;
        const float* xl = L == 0 ? a.in[I_X] : a.out; const float* xc = L == 0 ? a.in[I_CTX] : XC;
        if (IN(LB + 0)) { const int lane = my_lane(), tid = wave * 64 + lane; (void)tid; (void)lane; norm_rows(xl, xc, a.in[I_NMIX] + L * 1024, modL, 0, 1024, Hb, lane, gw, NGW); SEAM(); }
        if (IN(LB + 1)) { const int lane = my_lane(), tid = wave * 64 + lane; (void)tid; (void)lane;
            pg8::Gemm g{Hb, (const bf16_t*)(ws + WS_WNG) + (size_t)L * 2816 * 1024, 1024, 1024, 1024};
            pg8::StaticOrder S; S.init(MT / 256, UT, G, bid);
            pg8::EpiTileBf16 E{Ub, (size_t)MT * 256};
            pg8::gemm_phase(lds, g, S, E, wave); SEAM();
        }
        if (IN(LB + 2)) { const int lane = my_lane(), tid = wave * 64 + lane; (void)tid; (void)lane;
            unsigned* qw = ctl + CW_Q + 64 * (LB + 2);
            for (;;) { const int u = q_next(qw, qslot, tid == 0); if (u >= 256) break; if (!(DIS & 1)) four_stage1_unit(a, u, lane, wave); }
            for (;;) { const int u = q_next(qw + 16, qslot, tid == 0); if (u >= 1056) break; if (!(DIS & 2)) ret_dstate_unit(a, L, u, lds, tid, lane, wave); }
            for (;;) { const int u = q_next(qw + 32, qslot, tid == 0); if (u >= 132) break; if (!(DIS & 4)) mla_prep_wave(a, L, u * 8 + wave, lane); }
            if (L == 0) for (;;) { const int u = q_next(qw + 48, qslot, tid == 0); if (u >= 512) break; if (!(DIS & 8)) cfour_step1_unit(a, u, lds, tid); }
            SEAM();
        }
        if (IN(LB + 3)) { const int lane = my_lane(), tid = wave * 64 + lane; (void)tid; (void)lane; for (int u = bid; u < 256; u += G) ret_scan_unit(a, L, u, tid); SEAM(); }
        if (IN(LB + 4)) { const int lane = my_lane(), tid = wave * 64 + lane; (void)tid; (void)lane;
            unsigned* qw = ctl + CW_Q + 64 * (LB + 4);
            const int nc = L == 0 ? 16 : 0;
            for (;;) { const int u = q_next(qw, qslot, tid == 0); if (u >= 512 + nc) break; mla_unit(a, u, lds, tid, lane, wave); }
            for (;;) { const int u = q_next(qw + 16, qslot, tid == 0); if (u >= 512 + nc) break; na_unit(a, L, u, lds, tid, lane, wave); }
            for (;;) { const int u = q_next(qw + 32, qslot, tid == 0); if (u >= 1024 + 2 * nc) break; ret_out_unit(a, L, u, lds, tid, lane, wave); }
            for (;;) { const int u = q_next(qw + 48, qslot, tid == 0); if (u >= 512) break; four_stage2_unit(a, u, lane, wave); }
            if (L == 0) for (;;) { const int u = q_next(qw + 56, qslot, tid == 0); if (u >= 512) break; cfour_step2_unit(a, u, lds, tid); }
            SEAM();
        }
        const int nMm = L == 0 ? MT / 256 : ML / 256;
        if (IN(LB + 5)) { const int lane = my_lane(), tid = wave * 64 + lane; (void)tid; (void)lane;
            pg8::Gemm g{Hb, (const bf16_t*)(ws + WS_WG) + (size_t)L * 4096 * 1024, 1024, 1024, 1024};
            pg8::StaticOrder S; S.init(nMm, 16, G, bid);
            pg8::EpiSigmoid E{SG, 4096};
            pg8::gemm_phase(lds, g, S, E, wave); SEAM();
        }
        if (IN(LB + 6)) { const int lane = my_lane(), tid = wave * 64 + lane; (void)tid; (void)lane;
            pg8::Gemm g{YBR, (const bf16_t*)(ws + WS_WB) + (size_t)L * 4 * 1024 * 256, 1024, 256, 256};
            pg8::MergeOrder S; S.so.init(nMm, 4, G, bid);
            pg8::EpiMerge E{SG, Hb, (f32x4*)(ws + WS_MSCR) + (size_t)bid * 16384};
            pg8::gemm_phase(lds, g, S, E, wave); SEAM();
        }
        if (IN(LB + 7)) { const int lane = my_lane(), tid = wave * 64 + lane; (void)tid; (void)lane;
            pg8::Gemm g{Hb, (const bf16_t*)(ws + WS_WO) + (size_t)L * 1024 * 1024, 1024, 1024, 1024};
            pg8::StaticOrder S; S.init(nMm, 4, G, bid);
            pg8::EpiResid E{xl, xc, a.out, XC, modL + 2048};
            pg8::gemm_phase(lds, g, S, E, wave); SEAM();
        }
        if (L == 0) {
            if (IN(LB + 8)) { const int lane = my_lane(), tid = wave * 64 + lane; (void)tid; (void)lane; norm_rows(a.out, XC, a.in[I_NFFN], modL, 3072, 4096, Hb, lane, gw, NGW); SEAM(); }
            if (IN(LB + 9)) { const int lane = my_lane(), tid = wave * 64 + lane; (void)tid; (void)lane;
                pg8::Gemm g{Hb, (const bf16_t*)(ws + WS_WGU), 1024, 1024, 1024};
                pg8::StaticOrder S; S.init(MT / 256, 22, G, bid);
                pg8::EpiSwiGLU E{(bf16_t*)(ws + WS_HID), FF, 0};
                pg8::gemm_phase(lds, g, S, E, wave); SEAM();
            }
            if (IN(LB + 10)) { const int lane = my_lane(), tid = wave * 64 + lane; (void)tid; (void)lane;
                pg8::Gemm g{(const bf16_t*)(ws + WS_HID), (const bf16_t*)(ws + WS_WD), FF, FF, FF};
                pg8::StaticOrder S; S.init(MT / 256, 4, G, bid);
                pg8::EpiResid E{a.out, XC, a.out, XC, modL + 5120};
                pg8::gemm_phase(lds, g, S, E, wave); SEAM();
            }
        } else {
            if (IN(LB + 8)) { const int lane = my_lane(), tid = wave * 64 + lane; (void)tid; (void)lane; ph_route(a, lds, tid, lane, wave, bid, G); SEAM(); }
            if (IN(LB + 9)) { const int lane = my_lane(), tid = wave * 64 + lane; (void)tid; (void)lane; ph_place(a, tid, lane, wave, bid, G); SEAM(); }
        }
    }

constexpr int NPH = 36;
__global__ void __launch_bounds__(512, 2) mega(Args a) {
    extern __shared__ __attribute__((aligned(16))) unsigned char lds_raw[];
    LAS unsigned char* lds = (LAS unsigned char*)lds_raw;
    const int wave = __builtin_amdgcn_readfirstlane(threadIdx.x >> 6), bid = blockIdx.x, G = gridDim.x;
    unsigned char* ws = a.ws; unsigned* ctl = (unsigned*)(ws + WS_CTL);
    volatile LAS unsigned* misc = (volatile LAS unsigned*)(lds + LDS_MISC);
    volatile LAS int* qslot = (volatile LAS int*)(lds + LDS_MISC + 64);
    const int lo = a.ph_lo, hi = a.ph_hi; const bool multi = (hi - lo) > 1;
    if (threadIdx.x < 32) misc[threadIdx.x] = 0u;
    __syncthreads();
    XcdBarrier bar; bar.bar = ctl + CW_BAR; bar.x = 0; bar.st = misc;
    if (multi) bar = xcd_barrier_post(ctl + CW_BAR, misc, threadIdx.x == 0);

    const int gw = bid * 8 + wave, NGW = G * 8;
    float* MOD = (float*)(ws + WS_MOD);
    bf16_t* Hb = (bf16_t*)(ws + WS_H); bf16_t* Ub = (bf16_t*)(ws + WS_U); bf16_t* YBR = (bf16_t*)(ws + WS_YBR); bf16_t* SG = (bf16_t*)(ws + WS_SG);
    float* XC = (float*)(ws + WS_XC);

    if (IN(0)) { const int lane = my_lane(), tid = wave * 64 + lane; (void)tid; (void)lane; ph_prologue(a, lds, tid, lane, wave, bid, G); SEAM(); }

    layer_phases<0>(a, lds, wave, bid, G, lo, hi, multi, bar, qslot);
    layer_phases<1>(a, lds, wave, bid, G, lo, hi, multi, bar, qslot);
    for (int c = 0; c < 5; ++c) {
        if (IN(25 + 2 * c) || IN(26 + 2 * c)) {
            int pst[NE], ntiles; moe_offsets(ctl + CW_CNT, pst, ntiles);
            const int c0 = 64 * c; int ntc = ntiles - c0; ntc = ntc > 64 ? 64 : ntc;
            if (IN(25 + 2 * c)) { const int lane = my_lane(), tid = wave * 64 + lane; (void)tid; (void)lane;
                if (ntc > 0) {
                    pg8::Gemm g{(const bf16_t*)(ws + WS_XG), (const bf16_t*)(ws + WS_MWGU), 1024, 1024, 1024};
                    pg8::MoeOrder S{c0, ntc, 28, G, bid, (const int*)(ws + WS_TILEE), (long)7168 * 1024 * 2};
                    pg8::EpiSwiGLU E{(bf16_t*)(ws + WS_HIDM), MF, c0 * 256};
                    pg8::gemm_phase(lds, g, S, E, wave);
                }
                SEAM();
            }
            if (IN(26 + 2 * c)) { const int lane = my_lane(), tid = wave * 64 + lane; (void)tid; (void)lane;
                if (ntc > 0) {
                    pg8::Gemm g{(const bf16_t*)(ws + WS_HIDM) - (size_t)c0 * 256 * MF, (const bf16_t*)(ws + WS_MWD), MF, MF, MF};
                    pg8::MoeOrder S{c0, ntc, 4, G, bid, (const int*)(ws + WS_TILEE), (long)1024 * MF * 2};
                    pg8::EpiMoeDown E{(const int*)(ws + WS_ROWINFO), (const float*)(ws + WS_ROWW), (bf16_t*)(ws + WS_Y01)};
                    pg8::gemm_phase(lds, g, S, E, wave);
                }
                SEAM();
            }
        }
    }
    if (IN(35)) { const int lane = my_lane(); ph_final(a, lane, wave, bid, G); }
#undef IN
#undef SEAM
}


#ifdef DBG_SCAN
constexpr int CW_DBG = 9000;
__global__ void dbg_scan(const void* p, size_t n, int flags, int code, unsigned* ctl) { const int is_bf16 = flags & 1; const unsigned te = 127u + (unsigned)(flags >> 8);
    size_t i = (size_t)blockIdx.x * blockDim.x + threadIdx.x, st = (size_t)gridDim.x * blockDim.x; bool bad = false;
    if (is_bf16) { const unsigned short* q = (const unsigned short*)p; for (; i < n; i += st) { const unsigned v = q[i]; if (((v >> 7) & 0xffu) >= te) bad = true; } }
    else { const unsigned* q = (const unsigned*)p; for (; i < n; i += st) { const unsigned v = q[i]; if (((v >> 23) & 0xffu) >= te) bad = true; } }
    if (bad) atomicMax(ctl + CW_DBG, (unsigned)(1000 - code));
}
__global__ void dbg_scan2(const unsigned short* p, int rows, int ld, int c0, int nc, int code, unsigned* ctl) {
    size_t i = (size_t)blockIdx.x * blockDim.x + threadIdx.x, st = (size_t)gridDim.x * blockDim.x; bool bad = false;
    for (; i < (size_t)rows * nc; i += st) { const unsigned v = p[(i / nc) * ld + c0 + (i % nc)]; if (((v >> 7) & 0xffu) >= 127u + 6u) bad = true; }
    if (bad) atomicMax(ctl + CW_DBG, (unsigned)(1000 - code));
}
__global__ void dbg_delta(const float* a, const float* b, size_t n, int slot, unsigned* ctl) {
    size_t i = (size_t)blockIdx.x * blockDim.x + threadIdx.x, st = (size_t)gridDim.x * blockDim.x; float d = 0.f, r = 0.f;
    for (; i < n; i += st) { const float x = a[i], y = b[i]; d += (x - y) * (x - y); r += y * y; }
    for (int o = 32; o >= 1; o >>= 1) { d += __shfl_xor(d, o); r += __shfl_xor(r, o); }
    if ((threadIdx.x & 63) == 0) { atomicAdd((float*)ctl + 9010 + 2 * slot, d); atomicAdd((float*)ctl + 9011 + 2 * slot, r); }
}
__device__ int dbg_digit(float d, float r) { const float q = d / r; if (!(q == q)) return 9; int k = (int)rintf(-log2f(q)); return k < 0 ? 0 : (k > 8 ? 8 : k); }
__global__ void dbg_emit2(float* out, const unsigned* ctl, int s0, int s1) { const float* cf = (const float*)ctl;
    const int A = dbg_digit(cf[9010 + 2 * s0], cf[9011 + 2 * s0]), B = dbg_digit(cf[9010 + 2 * s1], cf[9011 + 2 * s1]); out[0] = sqrtf(33554432.f * (float)(10 * A + B)); }
__global__ void dbg_emit(float* out, const unsigned* ctl) { const float* cf = (const float*)ctl; const float msv = cf[9001] / 33554432.f, mso = cf[9002] / 33554432.f;
    int A = (int)rintf(log2f(msv)) + 4; A = A < 0 ? 0 : (A > 8 ? 8 : A); int B = (int)rintf(log2f(mso)) + 4; B = B < 0 ? 0 : (B > 8 ? 8 : B); if (ctl[9003]) B = 9;
    out[0] = sqrtf(33554432.f * (float)(10 * A + B)); }
#endif
extern "C" void kernel_launch(void* const* d_in, const int* in_sizes, int n_in, void* d_out, int out_size, void* d_ws, size_t ws_size, hipStream_t stream) {
    static int grid = 0;
    if (grid == 0) {
        if (n_in != 26 || in_sizes[0] != ML * DM || out_size != ML * DM || ws_size < WS_NEED) { fprintf(stderr, "kernel_launch: unexpected problem (n_in %d, ws %zu, need %zu)\n", n_in, ws_size, (size_t)WS_NEED); grid = -1; return; }
        int dev = 0, cus = 0, per_cu = 0;
        if (hipGetDevice(&dev) != hipSuccess || hipDeviceGetAttribute(&cus, hipDeviceAttributeMultiprocessorCount, dev) != hipSuccess) { grid = -1; return; }
        if (hipFuncSetAttribute((const void*)mega, hipFuncAttributeMaxDynamicSharedMemorySize, LDS_BYTES) != hipSuccess) { fprintf(stderr, "kernel_launch: hipFuncSetAttribute failed\n"); grid = -1; return; }
        if (hipOccupancyMaxActiveBlocksPerMultiprocessor(&per_cu, (const void*)mega, 512, LDS_BYTES) != hipSuccess || per_cu < 1) fprintf(stderr, "kernel_launch: occupancy query says %d\n", per_cu);
        (void)hipGetLastError();
        grid = cus;
    }
    if (grid < 0) return;
    if (hipMemsetAsync((char*)d_ws + WS_CTL, 0, 1 * MiB, stream) != hipSuccess) return;
    Args a{};
    for (int i = 0; i < 26; ++i) a.in[i] = (const float*)d_in[i];
    a.out = (float*)d_out; a.ws = (unsigned char*)d_ws;
#if N_LAUNCH_MODE == 1
    a.ph_lo = 0; a.ph_hi = NPH;
    hipLaunchKernelGGL(mega, dim3(grid), dim3(512), LDS_BYTES, stream, a);
#else
    for (int p = 0; p < NPH; ++p) {
        if (p == 12 || p == 23 || p == 24) continue;
        a.ph_lo = p; a.ph_hi = p + 1;
        hipLaunchKernelGGL(mega, dim3(grid), dim3(512), LDS_BYTES, stream, a);
#ifdef DBG_SCAN
        {
            unsigned char* ws = (unsigned char*)d_ws; unsigned* ctl = (unsigned*)(ws + WS_CTL);
#define SCAN(ptr, n, bf, code) SCANT(ptr, n, bf, code, 6)
#define SCANT(ptr, n, bf, code, TE) hipLaunchKernelGGL(dbg_scan, dim3(1024), dim3(256), 0, stream, (const void*)(ptr), (size_t)(n), (bf) | ((TE) << 8), code, ctl)
            const int L = p >= 13 ? 1 : 0, k = p == 0 ? -1 : (p - 1) % 12; const int cb = 1 + (p == 0 ? 0 : 4 + L * 40 + k * 3);
            const size_t nm = (L == 0 ? MT : ML);
            if (p == 0) { SCAN(ws + WS_MOD, 2 * 5 * 6144, 0, 1); SCAN(ws + WS_ROPER, 8192 * 64 + 8192 * 32, 0, 2); SCAN(ws + WS_WNG, (WS_RWEND - WS_WNG) / 2, 1, 3); SCAN(ws + WS_M1, 256 * 128, 1, 4); SCAN(ws + WS_WUQ, 2 * 384 * 192, 1, 4); SCAN(ws + WS_WUKV, 2 * 512 * 128, 1, 4); }
            else if (p < 25) {
                if (k == 0) SCAN(ws + WS_H, (size_t)MT * 1024, 1, cb);
                if (k == 1) SCAN(ws + WS_U, (size_t)UT * MT * 256, 1, cb);
                if (k == 2) { SCANT(ws + WS_A2, (size_t)4 * 64 * 128 * 256 * 2, 1, cb, 14); SCANT(ws + WS_ST, (size_t)2 * 16 * 66 * 4096, 0, cb + 1, 14); SCAN(ws + WS_MK, (size_t)16 * 8448 * 96 + (size_t)16 * 64 * 8448, 1, cb + 2); SCAN(ws + WS_MQ, (size_t)16 * 8192 * 96, 1, cb + 2); }
                if (k == 3) SCANT(ws + WS_ST, (size_t)2 * 16 * 64 * 4096, 0, cb, 14);
                if (k == 4) { for (int r4 = 0; r4 < 4; ++r4) { hipLaunchKernelGGL(dbg_scan2, dim3(1024), dim3(256), 0, stream, (const unsigned short*)(ws + WS_YBR), ML, 1024, r4 * 256, 256, (L == 0 ? 15 : 55) + r4, ctl); if (L == 0) hipLaunchKernelGGL(dbg_scan2, dim3(1024), dim3(256), 0, stream, (const unsigned short*)(ws + WS_YBR) + (size_t)ML * 1024, MC, 1024, r4 * 256, 256, 19, ctl); } }
                if (k == 5) SCAN(ws + WS_SG, nm * 4096, 1, cb);
                if (k == 6) SCAN(ws + WS_H, nm * 1024, 1, cb);
                if (k == 7) { SCAN(d_out, (size_t)ML * 1024, 0, cb); if (L == 0) SCAN(ws + WS_XC, (size_t)MC * 1024, 0, cb + 1); }
                if (k == 8 && L == 0) SCAN(ws + WS_H, (size_t)MT * 1024, 1, cb);
                if (k == 9 && L == 0) SCAN(ws + WS_HID, (size_t)MT * FF, 1, cb);
                if (k == 10 && L == 0) { SCAN(d_out, (size_t)ML * 1024, 0, cb); SCAN(ws + WS_XC, (size_t)MC * 1024, 0, cb + 1); }
            } else if (p == 34) SCAN(ws + WS_Y01, (size_t)2 * ML * 1024, 1, 95);
            if (p == 8) hipLaunchKernelGGL(dbg_delta, dim3(1024), dim3(256), 0, stream, (const float*)d_out, (const float*)d_in[0], (size_t)ML * 1024, 0, ctl);
            if (p == 11) hipLaunchKernelGGL(dbg_delta, dim3(1024), dim3(256), 0, stream, (const float*)d_out, (const float*)d_in[0], (size_t)ML * 1024, 1, ctl);
            if (p == 20) hipLaunchKernelGGL(dbg_delta, dim3(1024), dim3(256), 0, stream, (const float*)d_out, (const float*)d_in[0], (size_t)ML * 1024, 2, ctl);
            if (p == 35) { hipLaunchKernelGGL(dbg_delta, dim3(1024), dim3(256), 0, stream, (const float*)d_out, (const float*)d_in[0], (size_t)ML * 1024, 3, ctl); hipMemsetAsync(d_out, 0, (size_t)ML * 1024 * 4, stream); }
            if (p == 35) hipLaunchKernelGGL(dbg_emit2, dim3(1), dim3(1), 0, stream, (float*)d_out, (const unsigned*)ctl, DBG_S0, DBG_S1);
        }
#endif
    }
#endif
}
```

```cpp
#include <hip/hip_runtime.h>
#include <stdint.h>
#include <stdio.h>

#define LAS __attribute__((address_space(3)))
typedef unsigned short bf16_t;
typedef short bf16x8 __attribute__((ext_vector_type(8)));
typedef float f32x2 __attribute__((ext_vector_type(2)));
typedef float f32x4 __attribute__((ext_vector_type(4)));
typedef float f32x16 __attribute__((ext_vector_type(16)));
typedef unsigned u32x2 __attribute__((ext_vector_type(2)));
typedef unsigned u32x4 __attribute__((ext_vector_type(4)));

#define DBG_S0 2
#define DBG_S1 3
#ifndef N_LAUNCH_MODE
#define N_LAUNCH_MODE 1
#endif

constexpr int NB = 4, SEQ = 8192, DM = 1024, CTXL = 256;
constexpr int ML = NB * SEQ, MC = NB * CTXL, MT = ML + MC;
constexpr int INC = 6752;
constexpr int UT = 11;
constexpr int FF = 2816, MF = 3584, NE = 8;
constexpr int NRMAX = 65536 + 2048;
constexpr float EPS = 1e-6f;
constexpr float LOG2E = 1.4426950408889634f;

constexpr size_t MiB = 1u << 20;
constexpr size_t WS_CTL = 0;
constexpr size_t WS_MOD = 1 * MiB;
constexpr size_t WS_ROPER = WS_MOD + 256 * 1024;
constexpr size_t WS_ROPEM = WS_ROPER + 2 * MiB;
constexpr size_t WS_M1 = WS_ROPEM + 1 * MiB;
constexpr size_t WS_TW = WS_M1 + 64 * 1024;
constexpr size_t WS_D2 = WS_TW + 64 * 1024;
constexpr size_t WS_EP = WS_D2 + 32 * 1024;
constexpr size_t WS_XC = WS_EP + 16 * 1024;
constexpr size_t WS_CPQ = WS_XC + 4 * MiB;
constexpr size_t WS_WUQ = WS_CPQ + 2 * MiB;
constexpr size_t WS_WUKV = WS_WUQ + 512 * 1024;
constexpr size_t WS_ROWINFO = WS_WUKV + 512 * 1024;
constexpr size_t WS_ROWW = WS_ROWINFO + 512 * 1024;
constexpr size_t WS_TOK = WS_ROWW + 512 * 1024;
constexpr size_t WS_TILEE = WS_TOK + 512 * 1024;
constexpr size_t WS_R0END = 16 * MiB;
static_assert(WS_TILEE + 4096 <= WS_R0END, "R0");
constexpr size_t WS_WNG = WS_R0END;
constexpr size_t WS_WG = WS_WNG + (size_t)2 * 2816 * 1024 * 2;
constexpr size_t WS_WB = WS_WG + (size_t)2 * 4096 * 1024 * 2;
constexpr size_t WS_WO = WS_WB + (size_t)2 * 4 * 1024 * 256 * 2;
constexpr size_t WS_WGU = WS_WO + (size_t)2 * 1024 * 1024 * 2;
constexpr size_t WS_WD = WS_WGU + (size_t)5632 * 1024 * 2;
constexpr size_t WS_RWEND = WS_WD + (size_t)1024 * 2816 * 2;
constexpr size_t WS_H = WS_RWEND;
constexpr size_t WS_YBR = WS_H + (size_t)MT * 1024 * 2;
constexpr size_t WS_MSCR = WS_YBR + (size_t)MT * 1024 * 2;
constexpr size_t WS_BIG = WS_MSCR + (size_t)256 * 262144;
constexpr size_t WS_U = WS_BIG;
constexpr size_t WS_ST = WS_U + (size_t)UT * MT * 256 * 2;
constexpr size_t WS_STC = WS_ST + (size_t)2 * 16 * 64 * 4096 * 4;
constexpr size_t WS_A2 = WS_STC + (size_t)2 * 16 * 2 * 4096 * 4;
constexpr size_t WS_MQ = WS_A2 + (size_t)4 * 64 * 128 * 256 * 4;
constexpr size_t WS_MQC = WS_MQ + (size_t)16 * 8192 * 96 * 2;
constexpr size_t WS_MK = WS_MQC + (size_t)16 * 256 * 96 * 2;
constexpr size_t WS_MVT = WS_MK + (size_t)16 * 8448 * 96 * 2;
constexpr size_t WS_BIGEND = WS_MVT + (size_t)16 * 64 * 8448 * 2;
constexpr size_t WS_SG = WS_BIG;
constexpr size_t WS_HID = WS_BIG;
static_assert(WS_SG + (size_t)MT * 4096 * 2 <= WS_BIGEND, "SG overlay");
constexpr size_t WS_MWGU = WS_R0END;
constexpr size_t WS_MWD = WS_MWGU + (size_t)8 * 7168 * 1024 * 2;
constexpr size_t WS_XG = WS_MWD + (size_t)8 * 1024 * 3584 * 2;
constexpr size_t WS_HIDM = WS_XG + (size_t)NRMAX * 1024 * 2;
constexpr size_t WS_Y01 = WS_HIDM + (size_t)16384 * 3584 * 2;
constexpr size_t WS_MOEEND = WS_Y01 + (size_t)2 * ML * 1024 * 2;
constexpr size_t WS_NEED = WS_BIGEND > WS_MOEEND ? WS_BIGEND : WS_MOEEND;

constexpr int CW_BAR = 0, CW_Q = 4096, CW_CNT = 8192, CW_CUR = 8256;

constexpr int LDS_BYTES = 147456;
constexpr int LDS_MISC = 143360;

__device__ __forceinline__ float bf2f(unsigned h) { return __uint_as_float(h << 16); }
__device__ __forceinline__ float bflo(unsigned w) { return __uint_as_float(w << 16); }
__device__ __forceinline__ float bfhi(unsigned w) { return __uint_as_float(w & 0xffff0000u); }
typedef __bf16 bf16x2_t __attribute__((ext_vector_type(2)));
__device__ __forceinline__ unsigned pk2(float lo, float hi) { f32x2 v = {lo, hi}; bf16x2_t b = __builtin_convertvector(v, bf16x2_t); return __builtin_bit_cast(unsigned, b); }
__device__ __forceinline__ unsigned f2bf(float f) { return pk2(f, 0.f) & 0xffffu; }
__device__ __forceinline__ float wave_sum(float v) {
#pragma unroll
    for (int o = 1; o < 64; o <<= 1) v += __shfl_xor(v, o);
    return v;
}
__device__ __forceinline__ float fexp2(float x) { return __builtin_amdgcn_exp2f(x); }
__device__ __forceinline__ float siluf(float x) { return x / (1.f + __expf(-x)); }
__device__ __forceinline__ int crow(int r, int hi) { return (r & 3) + 8 * (r >> 2) + 4 * hi; }
__device__ __forceinline__ f32x16 mfma32(bf16x8 a, bf16x8 b, f32x16 c) { return __builtin_amdgcn_mfma_f32_32x32x16_bf16(a, b, c, 0, 0, 0); }
__device__ __forceinline__ f32x16 zero16() { f32x16 z;
#pragma unroll
    for (int i = 0; i < 16; ++i) z[i] = 0.f;
    return z; }
__device__ __forceinline__ bf16x8 as_bf16x8(u32x4 w) { return __builtin_bit_cast(bf16x8, w); }
#define LDS_WAIT() asm volatile("s_waitcnt lgkmcnt(0)" ::: "memory")
__device__ __forceinline__ int my_lane() { int l; asm volatile("v_mbcnt_lo_u32_b32 %0, -1, 0\n\tv_mbcnt_hi_u32_b32 %0, -1, %0" : "=v"(l)); return l; }

#define XB_TMO      128
#define XB_XCNT(j)  (256  + 64 * (j))
#define XB_XSUB(j)  (1280 + 64 * (j))
#define XB_XGEN(j)  (2304 + 64 * (j))
#define XB_TOP      3328
#define XB_TOPGEN   3392
#define XCD_BAR_WORDS 3456
#define XB_SPIN_CAP (1u << 22)
__device__ __forceinline__ unsigned xb_ld(unsigned* p)              { return __hip_atomic_load(p, __ATOMIC_RELAXED, __HIP_MEMORY_SCOPE_AGENT); }
__device__ __forceinline__ unsigned xb_add(unsigned* p, unsigned v) { return __hip_atomic_fetch_add(p, v, __ATOMIC_RELAXED, __HIP_MEMORY_SCOPE_AGENT); }
__device__ __forceinline__ unsigned xb_xcc_id() { return (unsigned)__builtin_amdgcn_s_getreg((3 << 11) | 20) & 0xFu; }
#define XB_SPIN(cond, bar) do { unsigned _sp = 0; while (cond) { __builtin_amdgcn_s_sleep(1); \
    if ((++_sp & 255u) == 0u) { if (xb_ld(&(bar)[XB_TMO])) break; if (_sp > XB_SPIN_CAP) { atomicAdd(&(bar)[XB_TMO], 1u); break; } } } } while (0)
struct XcdBarrier { unsigned* bar; unsigned x; volatile LAS unsigned* st; };
__device__ __forceinline__ XcdBarrier xcd_barrier_post(unsigned* bar, volatile LAS unsigned* st, bool leader) {
    XcdBarrier b; b.bar = bar; b.x = xb_xcc_id(); b.st = st;
    if (leader) (void)xb_add(&bar[XB_XCNT(b.x)], 1u);
    return b;
}
__device__ __forceinline__ void xcd_barrier_complete(unsigned* bar, unsigned x, unsigned& nloc, unsigned& nx) {
    const unsigned G = gridDim.x * gridDim.y * gridDim.z;
    unsigned sum, cnt, mine, sp = 0u;
    for (;;) {
        sum = 0u; cnt = 0u; mine = 0u;
#pragma unroll
        for (unsigned j = 0; j < 16; ++j) { const unsigned c = xb_ld(&bar[XB_XCNT(j)]); sum += c; cnt += (c > 0u) ? 1u : 0u; mine = (j == x) ? c : mine; }
        if (sum == G) break;
        __builtin_amdgcn_s_sleep(1);
        if ((++sp & 255u) == 0u) { if (xb_ld(&bar[XB_TMO])) break; if (sp > XB_SPIN_CAP) { atomicAdd(&bar[XB_TMO], 1u); break; } }
    }
    nloc = mine > 0u ? mine : 1u; nx = cnt > 0u ? cnt : 1u;
}
__device__ __forceinline__ void xcd_barrier(const XcdBarrier& b, bool leader) {
    asm volatile("s_waitcnt vmcnt(0)" ::: "memory");
    __syncthreads();
    if (leader) {
        unsigned* bar = b.bar;
        __builtin_amdgcn_s_waitcnt(0);
        unsigned nloc = b.st[0], nx = b.st[1];
        if (nloc == 0u) { xcd_barrier_complete(bar, b.x, nloc, nx); b.st[0] = nloc; b.st[1] = nx; }
        const unsigned old = xb_add(&bar[XB_XSUB(b.x)], 1u);
        const unsigned gen = old / nloc;
        if (old + 1u == (gen + 1u) * nloc) {
            __builtin_amdgcn_fence(__ATOMIC_RELEASE, "agent");
            asm volatile("s_waitcnt vmcnt(0)" ::: "memory");
            const unsigned og = xb_add(&bar[XB_TOP], 1u);
            const unsigned tg = og / nx;
            if (og + 1u == (tg + 1u) * nx) xb_add(&bar[XB_TOPGEN], 1u);
            else XB_SPIN(xb_ld(&bar[XB_TOPGEN]) == tg, bar);
            __builtin_amdgcn_fence(__ATOMIC_ACQUIRE, "agent");
            xb_add(&bar[XB_XGEN(b.x)], 1u);
            asm volatile("s_waitcnt vmcnt(0)" ::: "memory");
        } else {
            XB_SPIN(xb_ld(&bar[XB_XGEN(b.x)]) == gen, bar);
            __builtin_amdgcn_fence(__ATOMIC_ACQUIRE, "agent");
            asm volatile("s_waitcnt vmcnt(0)" ::: "memory");
        }
    }
    __syncthreads();
}

namespace pg8 {
constexpr int BM = 256, BK = 64, HALF = 128, HTB = HALF * BK * 2, STAGE_BYTES = 8 * HTB, NXCD = 8, WGM = 8;
__host__ __device__ __forceinline__ int lds_byte(int r, int c) { const int st = (r >> 4) * 2 + (c >> 5), rr = r & 15, cc = c & 31, ob = rr * 64 + cc * 2; return st * 1024 + (ob ^ (((ob >> 9) & 1) << 5)); }
__host__ __device__ __forceinline__ void stage_rc(int b, int& R, int& C) { const int st = b / 1024, sb = b % 1024, swz = sb ^ (((sb >> 9) & 1) << 5); R = (st >> 1) * 16 + swz / 64; C = (st & 1) * 32 + (swz % 64) / 2; }
__host__ __device__ __forceinline__ int perm32(int rho) { const int n = rho >> 4, i = rho & 15; return 8 * (i >> 2) + 4 * n + (i & 3); }

struct Unit { int pm, pn, aux; long aofs, bofs; };
struct Gemm { const bf16_t* A; const bf16_t* Bt; int lda, ldb, K; };

struct StaticOrder {
    int nM, nN, nwg, G, c;
    __device__ void init(int nM_, int nN_, int G_, int c_) { nM = nM_; nN = nN_; nwg = nM * nN; G = G_; c = c_; }
    __device__ bool next(int i, Unit& u) const {
        const long L = (long)i * G + c; if (L >= nwg) return false;
        int wgid = (int)L; { const int q = nwg / NXCD, r = nwg % NXCD, xcd = wgid % NXCD, off = wgid / NXCD; wgid = (xcd < r ? xcd * (q + 1) : r * (q + 1) + (xcd - r) * q) + off; }
        const int nig = WGM * nN, gid = wgid / nig, fm = gid * WGM, gsz = (nM - fm) < WGM ? (nM - fm) : WGM;
        u.pm = fm + ((wgid % nig) % gsz); u.pn = (wgid % nig) / gsz; u.aux = 0; u.aofs = 0; u.bofs = 0; return true;
    }
};
struct MergeOrder {
    StaticOrder so;
    __device__ bool next(int i, Unit& u) const { if (!so.next(i >> 2, u)) return false; const int s = i & 3; u.aux = s; u.aofs = (long)s * 256 * 2; u.bofs = (long)s * 1024 * 256 * 2; return true; }
};
struct MoeOrder {
    int c0, ntc, nN, G, c; const int* tile_e; long bstride;
    __device__ bool next(int i, Unit& u) const {
        const long L = (long)i * G + c; if (L >= (long)ntc * nN) return false;
        u.pm = c0 + (int)(L % ntc); u.pn = (int)(L / ntc); u.aux = 0; u.aofs = 0;
        int e = tile_e[u.pm]; e = e < 0 ? 0 : e; u.bofs = (long)e * bstride; return true;
    }
};

template <class Epi, class Sched>
__device__ __forceinline__ void gemm_phase(LAS unsigned char* lds, const Gemm g, const Sched& S, const Epi& E, int wid) {
    const int lane = my_lane(), tid = wid * 64 + lane;
    const int wr = wid >> 2, wc = wid & 3, fr = lane & 15, fq = lane >> 4;
    const int K = g.K, nt = K / BK;
    unsigned voffA[2], voffB[2];
#pragma unroll
    for (int i = 0; i < 2; ++i) { int R, C; stage_rc(tid * 16 + i * 8192, R, C); const int Rb = Epi::PERM ? ((R & ~31) + perm32(R & 31)) : R;
        voffA[i] = (unsigned)(R * g.lda + C) * 2u; voffB[i] = (unsigned)(Rb * g.ldb + C) * 2u; }
    const size_t kstep = (size_t)(BK * 2);
    const size_t hstepA = (size_t)HALF * g.lda * 2, hstepB = (size_t)HALF * g.ldb * 2;
    const size_t tstepA = 2 * hstepA, tstepB = 2 * hstepB;
    const unsigned ldsw = (unsigned)wid * 1024u;
    const int aoff = lds_byte(wr * 64 + fr, fq * 8), boff = lds_byte(wc * 32 + fr, fq * 8);
#define PG8_SA(b, h) (((b) * 2 + (h)) * HTB)
#define PG8_SB(b, h) ((4 + (b) * 2 + (h)) * HTB)
#define PG8_STAGE(bufoff, gbase, voff) do { _Pragma("unroll") for (int _i = 0; _i < 2; ++_i) \
        __builtin_amdgcn_global_load_lds((const unsigned*)((const char*)(gbase) + (voff)[_i]), (LAS unsigned*)(lds + (bufoff) + ldsw + _i * 8192), 16, 0, 0); } while (0)
#define PG8_LDA(dst, b, h) do { _Pragma("unroll") for (int m = 0; m < 4; ++m) _Pragma("unroll") for (int k = 0; k < 2; ++k) dst[m][k] = *(const LAS bf16x8*)(lds + PG8_SA(b, h) + aoff + m * 2048 + k * 1024); } while (0)
#define PG8_LDB(dst, b, h) do { _Pragma("unroll") for (int n = 0; n < 2; ++n) _Pragma("unroll") for (int k = 0; k < 2; ++k) dst[n][k] = *(const LAS bf16x8*)(lds + PG8_SB(b, h) + boff + n * 2048 + k * 1024); } while (0)
#define PG8_MMA(ai, bj, At, Bt) do { __builtin_amdgcn_s_setprio(1); _Pragma("unroll") for (int m = 0; m < 4; ++m) _Pragma("unroll") for (int n = 0; n < 2; ++n) _Pragma("unroll") for (int k = 0; k < 2; ++k) \
        acc[ai][bj][m][n] = __builtin_amdgcn_mfma_f32_16x16x32_bf16(Bt[n][k], At[m][k], acc[ai][bj][m][n], 0, 0, 0); __builtin_amdgcn_s_setprio(0); } while (0)
#define PG8_WAIT_V(n) asm volatile("s_waitcnt vmcnt(" #n ")" ::: "memory")
#define PG8_WAIT_L(n) asm volatile("s_waitcnt lgkmcnt(" #n ")" ::: "memory")
#define PG8_BAR __builtin_amdgcn_s_barrier()
#define PG8_SCHED __builtin_amdgcn_sched_barrier(0)
    Unit cur, nxt; int ui = 0;
    if (!S.next(0, cur)) return;
    f32x4 acc[2][2][4][2];
#pragma unroll
    for (int a = 0; a < 2; ++a)
#pragma unroll
        for (int b = 0; b < 2; ++b)
#pragma unroll
            for (int m = 0; m < 4; ++m)
#pragma unroll
                for (int n = 0; n < 2; ++n) acc[a][b][m][n] = (f32x4){0.f, 0.f, 0.f, 0.f};
    bf16x8 At[4][2], B0[2][2], B1[2][2];
    const char* cA = (const char*)g.A + cur.aofs + (size_t)cur.pm * tstepA; const char* cB = (const char*)g.Bt + cur.bofs + (size_t)cur.pn * tstepB;
    PG8_STAGE(PG8_SB(0, 0), cB, voffB); PG8_STAGE(PG8_SB(0, 1), cB + hstepB, voffB); PG8_STAGE(PG8_SA(0, 0), cA, voffA); PG8_STAGE(PG8_SA(0, 1), cA + hstepA, voffA);
    if (wr == 1) PG8_BAR;
    PG8_WAIT_V(2); PG8_BAR;
    PG8_STAGE(PG8_SB(1, 0), cB + kstep, voffB); PG8_STAGE(PG8_SA(1, 0), cA + kstep, voffA); PG8_STAGE(PG8_SB(1, 1), cB + hstepB + kstep, voffB);
    PG8_WAIT_V(6); PG8_BAR;
    for (;;) {
        const bool has_next = S.next(ui + 1, nxt);
        const char* nA = has_next ? (const char*)g.A + nxt.aofs + (size_t)nxt.pm * tstepA : cA; const char* nB = has_next ? (const char*)g.Bt + nxt.bofs + (size_t)nxt.pn * tstepB : cB;
        for (int t = 0; t < nt; t += 2) {
            const bool last = (t == nt - 2);
            const char* a1 = cA + (size_t)(t + 1) * kstep;
            const char* a2 = last ? nA : cA + (size_t)(t + 2) * kstep; const char* b2 = last ? nB : cB + (size_t)(t + 2) * kstep;
            const char* a3 = a2 + kstep; const char* b3 = b2 + kstep;
            PG8_LDB(B0, 0, 0); PG8_LDB(B1, 0, 1); PG8_SCHED; PG8_LDA(At, 0, 0); PG8_STAGE(PG8_SA(1, 1), a1 + hstepA, voffA);
            PG8_WAIT_V(8); PG8_WAIT_L(0); PG8_BAR; PG8_MMA(0, 0, At, B0); PG8_MMA(0, 1, At, B1); PG8_BAR; PG8_SCHED;
            PG8_LDA(At, 0, 1); PG8_STAGE(PG8_SB(0, 0), b2, voffB); PG8_STAGE(PG8_SB(0, 1), b2 + hstepB, voffB); PG8_STAGE(PG8_SA(0, 0), a2, voffA);
            PG8_WAIT_V(8); PG8_WAIT_L(0); PG8_BAR; PG8_MMA(1, 0, At, B0); PG8_MMA(1, 1, At, B1); PG8_BAR; PG8_SCHED;
            PG8_LDB(B0, 1, 0); PG8_LDB(B1, 1, 1); PG8_SCHED; PG8_LDA(At, 1, 0); PG8_STAGE(PG8_SA(0, 1), a2 + hstepA, voffA);
            PG8_WAIT_V(8); PG8_WAIT_L(0); PG8_BAR; PG8_MMA(0, 0, At, B0); PG8_MMA(0, 1, At, B1); PG8_BAR; PG8_SCHED;
            PG8_LDA(At, 1, 1); PG8_STAGE(PG8_SB(1, 0), b3, voffB); PG8_STAGE(PG8_SB(1, 1), b3 + hstepB, voffB); PG8_STAGE(PG8_SA(1, 0), a3, voffA);
            PG8_WAIT_V(8); PG8_WAIT_L(0); PG8_BAR; PG8_MMA(1, 0, At, B0); PG8_MMA(1, 1, At, B1); PG8_BAR; PG8_SCHED;
        }
        if (wr == 0) PG8_BAR;
        E(acc, cur, wr, wc, fr, fq);
        if (!has_next) break;
#pragma unroll
        for (int a = 0; a < 2; ++a)
#pragma unroll
            for (int b = 0; b < 2; ++b)
#pragma unroll
                for (int m = 0; m < 4; ++m)
#pragma unroll
                    for (int n = 0; n < 2; ++n) acc[a][b][m][n] = (f32x4){0.f, 0.f, 0.f, 0.f};
        cur = nxt; cA = nA; cB = nB; ++ui;
        if (wr == 1) PG8_BAR;
    }
    PG8_WAIT_V(0);
    PG8_BAR;
#undef PG8_SA
#undef PG8_SB
#undef PG8_STAGE
#undef PG8_LDA
#undef PG8_LDB
#undef PG8_MMA
#undef PG8_WAIT_V
#undef PG8_WAIT_L
#undef PG8_BAR
#undef PG8_SCHED
}

struct EpiTileBf16 {
    static constexpr bool PERM = true;
    bf16_t* O; size_t tstride;
    __device__ __forceinline__ void operator()(const f32x4 (&acc)[2][2][4][2], const Unit& u, int wr, int wc, int fr, int fq) const {
        const int row0 = u.pm * BM + wr * 64 + fr; bf16_t* base = O + (size_t)u.pn * tstride; const int col0 = wc * 32 + 8 * fq;
#pragma unroll
        for (int ai = 0; ai < 2; ++ai)
#pragma unroll
            for (int m = 0; m < 4; ++m) { bf16_t* rowp = base + (size_t)(row0 + ai * HALF + m * 16) * 256 + col0;
#pragma unroll
                for (int bj = 0; bj < 2; ++bj) { const f32x4 v0 = acc[ai][bj][m][0], v1 = acc[ai][bj][m][1];
                    u32x4 w; w.x = pk2(v0[0], v0[1]); w.y = pk2(v0[2], v0[3]); w.z = pk2(v1[0], v1[1]); w.w = pk2(v1[2], v1[3]);
                    *(u32x4*)(rowp + bj * HALF) = w; } }
    }
};
struct EpiSigmoid {
    static constexpr bool PERM = true;
    bf16_t* O; int ldc;
    __device__ __forceinline__ void operator()(const f32x4 (&acc)[2][2][4][2], const Unit& u, int wr, int wc, int fr, int fq) const {
        const int row0 = u.pm * BM + wr * 64 + fr; const int col0 = u.pn * BM + wc * 32 + 8 * fq;
#pragma unroll
        for (int ai = 0; ai < 2; ++ai)
#pragma unroll
            for (int m = 0; m < 4; ++m) { bf16_t* rowp = O + (size_t)(row0 + ai * HALF + m * 16) * ldc + col0;
#pragma unroll
                for (int bj = 0; bj < 2; ++bj) { f32x4 v0 = acc[ai][bj][m][0], v1 = acc[ai][bj][m][1];
#pragma unroll
                    for (int j = 0; j < 4; ++j) { v0[j] = 1.f / (1.f + __expf(-v0[j])); v1[j] = 1.f / (1.f + __expf(-v1[j])); }
                    u32x4 w; w.x = pk2(v0[0], v0[1]); w.y = pk2(v0[2], v0[3]); w.z = pk2(v1[0], v1[1]); w.w = pk2(v1[2], v1[3]);
                    *(u32x4*)(rowp + bj * HALF) = w; } }
    }
};
struct EpiMerge {
    static constexpr bool PERM = true;
    const bf16_t* SG; bf16_t* M; f32x4* scr;
    template <int MODE>
    __device__ __forceinline__ void run(const f32x4 (&acc)[2][2][4][2], const Unit& u, int wr, int wc, int fr, int fq) const {
        const int row0 = u.pm * BM + wr * 64 + fr; const int col0 = u.pn * BM + wc * 32 + 8 * fq; int tid = (wr * 4 + wc) * 64 + fq * 16 + fr; asm volatile("" : "+v"(tid));
        const bf16_t* sgp = SG + (size_t)row0 * 4096 + u.aux * 1024 + col0; bf16_t* mp = M + (size_t)row0 * 1024 + col0; f32x4* p = scr + tid;
#pragma unroll
        for (int ai = 0; ai < 2; ++ai)
#pragma unroll
            for (int m = 0; m < 4; ++m) {
#pragma unroll
                for (int bj = 0; bj < 2; ++bj) {
                    const u32x4 s = *(const u32x4*)(sgp + (size_t)(ai * HALF + m * 16) * 4096 + bj * HALF);
                    f32x4 v0 = acc[ai][bj][m][0], v1 = acc[ai][bj][m][1];
                    v0[0] *= bflo(s.x); v0[1] *= bfhi(s.x); v0[2] *= bflo(s.y); v0[3] *= bfhi(s.y);
                    v1[0] *= bflo(s.z); v1[1] *= bfhi(s.z); v1[2] *= bflo(s.w); v1[3] *= bfhi(s.w);
                    const int pi = (((ai * 2 + bj) * 4 + m) * 2) * 512;
                    if (MODE != 0) { v0 += p[pi]; v1 += p[pi + 512]; }
                    if (MODE != 2) { p[pi] = v0; p[pi + 512] = v1; }
                    else { u32x4 w; w.x = pk2(v0[0], v0[1]); w.y = pk2(v0[2], v0[3]); w.z = pk2(v1[0], v1[1]); w.w = pk2(v1[2], v1[3]);
                        *(u32x4*)(mp + (size_t)(ai * HALF + m * 16) * 1024 + bj * HALF) = w; } }
                asm volatile("" ::: "memory"); }
    }
    __device__ __forceinline__ void operator()(const f32x4 (&acc)[2][2][4][2], const Unit& u, int wr, int wc, int fr, int fq) const {
        if (u.aux == 0) run<0>(acc, u, wr, wc, fr, fq); else if (u.aux == 3) run<2>(acc, u, wr, wc, fr, fq); else run<1>(acc, u, wr, wc, fr, fq);
    }
};
struct EpiResid {
    static constexpr bool PERM = false;
    const float* sl; const float* sc; float* dl; float* dc; const float* gate;
    __device__ __forceinline__ void operator()(const f32x4 (&acc)[2][2][4][2], const Unit& u, int wr, int wc, int fr, int fq) const {
        const int rt = u.pm * BM; const bool isc = rt >= ML;
        const float* src = isc ? sc + (size_t)(rt - ML) * 1024 : sl + (size_t)rt * 1024;
        float* dst = isc ? dc + (size_t)(rt - ML) * 1024 : dl + (size_t)rt * 1024;
        const float* gv = gate + (size_t)(isc ? 4 : (rt >> 13)) * 6144;
        const int col0 = u.pn * BM + wc * 32 + 4 * fq; const int r0 = wr * 64 + fr;
        f32x4 gg[2][2];
#pragma unroll
        for (int bj = 0; bj < 2; ++bj)
#pragma unroll
            for (int n = 0; n < 2; ++n) gg[bj][n] = *(const f32x4*)(gv + col0 + bj * HALF + n * 16);
#pragma unroll
        for (int ai = 0; ai < 2; ++ai)
#pragma unroll
            for (int m = 0; m < 4; ++m) { const size_t off = (size_t)(r0 + ai * HALF + m * 16) * 1024 + col0;
#pragma unroll
                for (int bj = 0; bj < 2; ++bj)
#pragma unroll
                    for (int n = 0; n < 2; ++n) { const f32x4 x = *(const f32x4*)(src + off + bj * HALF + n * 16);
                        *(f32x4*)(dst + off + bj * HALF + n * 16) = x + gg[bj][n] * acc[ai][bj][m][n]; }
                asm volatile("" ::: "memory"); }
    }
};
struct EpiSwiGLU {
    static constexpr bool PERM = true;
    bf16_t* Hd; int ldc; int rowsub;
    __device__ __forceinline__ void operator()(const f32x4 (&acc)[2][2][4][2], const Unit& u, int wr, int wc, int fr, int fq) const {
        const int row0 = u.pm * BM - rowsub + wr * 64 + fr; const int col0 = u.pn * HALF + wc * 32 + 8 * fq;
#pragma unroll
        for (int ai = 0; ai < 2; ++ai)
#pragma unroll
            for (int m = 0; m < 4; ++m) { bf16_t* rowp = Hd + (size_t)(row0 + ai * HALF + m * 16) * ldc + col0;
                f32x4 v0, v1;
#pragma unroll
                for (int j = 0; j < 4; ++j) { const float g0 = acc[ai][0][m][0][j], g1 = acc[ai][0][m][1][j];
                    v0[j] = g0 / (1.f + __expf(-g0)) * acc[ai][1][m][0][j]; v1[j] = g1 / (1.f + __expf(-g1)) * acc[ai][1][m][1][j]; }
                u32x4 w; w.x = pk2(v0[0], v0[1]); w.y = pk2(v0[2], v0[3]); w.z = pk2(v1[0], v1[1]); w.w = pk2(v1[2], v1[3]);
                *(u32x4*)rowp = w; }
    }
};
struct EpiMoeDown {
    static constexpr bool PERM = true;
    const int* rowinfo; const float* roww; bf16_t* Y;
    __device__ __forceinline__ void operator()(const f32x4 (&acc)[2][2][4][2], const Unit& u, int wr, int wc, int fr, int fq) const {
        const int row0 = u.pm * BM + wr * 64 + fr; const int col0 = u.pn * BM + wc * 32 + 8 * fq;
#pragma unroll
        for (int ai = 0; ai < 2; ++ai)
#pragma unroll
            for (int m = 0; m < 4; ++m) { const int row = row0 + ai * HALF + m * 16; const int info = rowinfo[row];
                if (info >= 0) { const float w8 = roww[row]; bf16_t* rowp = Y + (size_t)(info & 1) * ML * 1024 + (size_t)(info >> 1) * 1024 + col0;
#pragma unroll
                    for (int bj = 0; bj < 2; ++bj) { const f32x4 v0 = acc[ai][bj][m][0] * w8, v1 = acc[ai][bj][m][1] * w8;
                        u32x4 w; w.x = pk2(v0[0], v0[1]); w.y = pk2(v0[2], v0[3]); w.z = pk2(v1[0], v1[1]); w.w = pk2(v1[2], v1[3]);
                        *(u32x4*)(rowp + bj * HALF) = w; } } }
    }
};
}

struct Args { const float* in[26]; float* out; unsigned char* ws; int ph_lo, ph_hi; };
enum { I_X = 0, I_C, I_CTX, I_CCTX, I_ADAW, I_ADAB, I_NMIX, I_NFFN, I_WIN, I_DECF, I_DECB, I_QNORM, I_KVNORM, I_WUQ, I_WUKV, I_RPB, I_WBR, I_WOUT,
       I_FG, I_FU, I_FD, I_ROUTER, I_MG, I_MU, I_MD, I_NFINAL };

__device__ __forceinline__ int q_next(unsigned* qw, volatile LAS int* slot, bool leader) {
    __syncthreads();
    if (leader) *slot = (int)atomicAdd(qw, 1u);
    __syncthreads();
    return *slot;
}

__device__ __forceinline__ void cvt_block(const float* W, int ldw, int k0, int sc0, bf16_t* D, int drow0, int ldd, LAS float* scr, int lane) {
#pragma unroll 8
    for (int i = 0; i < 32; ++i) { const int kk = 2 * i + (lane >> 5); scr[kk * 33 + (lane & 31)] = sc0 >= 0 ? W[(size_t)(k0 + kk) * ldw + sc0 + (lane & 31)] : 0.f; }
    LDS_WAIT();
    const int c = lane & 7;
#pragma unroll
    for (int j = 0; j < 4; ++j) { const int n = (lane >> 3) + 8 * j; const LAS float* s = scr + (8 * c) * 33 + n;
        u32x4 o; o.x = pk2(s[0 * 33], s[1 * 33]); o.y = pk2(s[2 * 33], s[3 * 33]); o.z = pk2(s[4 * 33], s[5 * 33]); o.w = pk2(s[6 * 33], s[7 * 33]);
        *(u32x4*)(D + (size_t)(drow0 + n) * ldd + k0 + 8 * c) = o; }
    LDS_WAIT();
}
__device__ __forceinline__ int map_ng(int j) {
    if (j < 1024) return j;
    if (j < 2304) return 1184 + (j - 1024);
    if (j < 2464) return 1024 + (j - 2304);
    if (j < 2560) return -1;
    if (j < 2752) return 2464 + (j - 2560);
    return -1;
}

__device__ __forceinline__ void ph_prologue(const Args& a, LAS unsigned char* lds, int tid, int lane, int wave, int bid, int G) { asm volatile("" : "+v"(lane)); asm volatile("" : "+v"(tid));
    unsigned char* ws = a.ws;
    LAS float* s = (LAS float*)lds;
    LAS float* red = (LAS float*)(lds + 20480);
    for (int i = tid; i < 5 * 1024; i += 512) { const int r = i >> 10, k = i & 1023; const float v = r < 4 ? a.in[I_C][r * 1024 + k] : a.in[I_CCTX][k]; s[i] = siluf(v); }
    __syncthreads();
    float* MOD = (float*)(ws + WS_MOD);
    for (int unit = bid; unit < 384; unit += G) {
        const int L = unit / 192, j0 = (unit % 192) * 32, jj = tid & 31, ks = tid >> 5;
        float acc[5] = {0.f, 0.f, 0.f, 0.f, 0.f};
        const float* W = a.in[I_ADAW] + (size_t)L * 1024 * 6144 + j0 + jj;
        for (int k = ks * 64; k < ks * 64 + 64; ++k) { const float w = W[(size_t)k * 6144];
#pragma unroll
            for (int r = 0; r < 5; ++r) acc[r] += s[r * 1024 + k] * w; }
#pragma unroll
        for (int r = 0; r < 5; ++r) red[(ks * 5 + r) * 32 + jj] = acc[r];
        __syncthreads();
        if (tid < 160) { const int r = tid >> 5; float t = 0.f;
            for (int q = 0; q < 16; ++q) t += red[(q * 5 + r) * 32 + jj];
            MOD[(size_t)(L * 5 + r) * 6144 + j0 + jj] = t + a.in[I_ADAB][L * 6144 + j0 + jj]; }
        __syncthreads();
    }
    LAS float* scr = (LAS float*)(lds + 32768 + wave * 8448);
    const int gw = bid * 8 + wave, NGW = G * 8;
    constexpr int IA = 16 * 88, IB = 16 * 128, IC = 4 * 4 * 32, ID = 16 * 32, IE = 3 * 12, IF = 2 * 16, IL = IA + IB + IC + ID + IE + IF, IG = 16 * 176, IH = 44 * 32;
    for (int it = gw; it < 2 * IL + IG + IH; it += NGW) {
        int r = it;
        if (r < 2 * IL) { const int L = r / IL; r -= L * IL;
            const float* win = a.in[I_WIN] + (size_t)L * 1024 * INC;
            if (r < IA) { const int kb = r / 88, nb = r % 88; cvt_block(win, INC, kb * 64, map_ng(nb * 32), (bf16_t*)(ws + WS_WNG) + (size_t)L * 2816 * 1024, nb * 32, 1024, scr, lane); continue; } r -= IA;
            if (r < IB) { const int kb = r / 128, nb = r % 128; cvt_block(win, INC, kb * 64, 2656 + nb * 32, (bf16_t*)(ws + WS_WG) + (size_t)L * 4096 * 1024, nb * 32, 1024, scr, lane); continue; } r -= IB;
            if (r < IC) { const int i = r / 128, q = r % 128, kb = q / 32, nb = q % 32;
                cvt_block(a.in[I_WBR] + (size_t)(L * 4 + i) * 256 * 1024, 1024, kb * 64, nb * 32, (bf16_t*)(ws + WS_WB) + (size_t)(L * 4 + i) * 1024 * 256, nb * 32, 256, scr, lane); continue; } r -= IC;
            if (r < ID) { const int kb = r / 32, nb = r % 32; cvt_block(a.in[I_WOUT] + (size_t)L * 1024 * 1024, 1024, kb * 64, nb * 32, (bf16_t*)(ws + WS_WO) + (size_t)L * 1024 * 1024, nb * 32, 1024, scr, lane); continue; } r -= ID;
            if (r < IE) { const int kb = r / 12, nb = r % 12; cvt_block(a.in[I_WUQ] + (size_t)L * 192 * 384, 384, kb * 64, nb * 32, (bf16_t*)(ws + WS_WUQ) + (size_t)L * 384 * 192, nb * 32, 192, scr, lane); continue; } r -= IE;
            { const int kb = r / 16, nb = r % 16; cvt_block(a.in[I_WUKV] + (size_t)L * 128 * 512, 512, kb * 64, nb * 32, (bf16_t*)(ws + WS_WUKV) + (size_t)L * 512 * 128, nb * 32, 128, scr, lane); continue; }
        }
        r -= 2 * IL;
        if (r < IG) { const int kb = r / 176, nb = r % 176, pn = nb >> 3, wi = nb & 7;
            cvt_block(wi < 4 ? a.in[I_FG] : a.in[I_FU], FF, kb * 64, 128 * pn + 32 * (wi & 3), (bf16_t*)(ws + WS_WGU), nb * 32, 1024, scr, lane); continue; } r -= IG;
        { const int kb = r / 32, nb = r % 32; cvt_block(a.in[I_FD], 1024, kb * 64, nb * 32, (bf16_t*)(ws + WS_WD), nb * 32, FF, scr, lane); }
    }
    const int gt = bid * 512 + tid, NGT = G * 512;
    float* RR = (float*)(ws + WS_ROPER); float* RM = (float*)(ws + WS_ROPEM);
    for (int i = gt; i < 8192 * 32; i += NGT) { const int t = i >> 5, f = i & 31; const float pos = (float)(f < 16 ? (t >> 6) : (t & 63));
        const float inv = powf(10000.f, -(float)(f & 15) / 16.f); const float ang = pos * inv; RR[2 * i] = cosf(ang); RR[2 * i + 1] = sinf(ang); }
    for (int i = gt; i < 8192 * 16; i += NGT) { const int t = i >> 4, f = i & 15; const float pos = (float)(f < 8 ? (t >> 6) : (t & 63));
        const float inv = powf(10000.f, -(float)(f & 7) / 8.f); const float ang = pos * inv; RM[2 * i] = cosf(ang); RM[2 * i + 1] = sinf(ang); }
    const float TWO_PI = 6.283185307179586f;
    bf16_t* M1 = (bf16_t*)(ws + WS_M1);
    for (int i = gt; i < 256 * 128; i += NGT) { const int r = i >> 7, t2 = i & 127; const int m = ((r & 127) * t2) & 127; const float ang = TWO_PI * (float)m / 128.f;
        M1[i] = (bf16_t)f2bf(r < 128 ? cosf(ang) : -sinf(ang)); }
    float* TW = (float*)(ws + WS_TW);
    for (int i = gt; i < 8192; i += NGT) { const float ang = TWO_PI * (float)i / 8192.f; TW[2 * i] = cosf(ang); TW[2 * i + 1] = sinf(ang); }
    bf16_t* D2 = (bf16_t*)(ws + WS_D2);
    for (int i = gt; i < 128 * 128; i += NGT) { const int row = i >> 7, k = i & 127; const int ro = row >> 6, k1 = row & 63, t1 = k >> 1, ri = k & 1;
        const float ang = TWO_PI * (float)((k1 * t1) & 63) / 64.f; const float cs = cosf(ang), sn = sinf(ang);
        D2[i] = (bf16_t)f2bf(ro == 0 ? (ri == 0 ? cs : sn) : (ri == 0 ? -sn : cs)); }
    bf16_t* EP = (bf16_t*)(ws + WS_EP);
    for (int i = gt; i < 64 * 128; i += NGT) { const int l = i >> 7, q = i & 127, part = q >> 6, p = q & 63; const int ct = p >> 5, sp = (p >> 4) & 1, hh = (p >> 3) & 1, j = p & 7;
        const int c = ct * 32 + 16 * sp + 8 * (j >> 2) + 4 * hh + (j & 3); const float ang = TWO_PI * (float)((l * c) & 63) / 64.f;
        EP[i] = (bf16_t)f2bf(part == 0 ? cosf(ang) : sinf(ang)); }
}

__device__ __forceinline__ void norm_rows(const float* xl, const float* xc, const float* gain, const float* modL, int sh_off, int sc_off, bf16_t* O, int lane, int gw, int NGW) { asm volatile("" : "+v"(lane));
    f32x4 gn[4];
#pragma unroll
    for (int j = 0; j < 4; ++j) gn[j] = *(const f32x4*)(gain + 4 * lane + 256 * j);
    for (int row = gw; row < MT; row += NGW) {
        const bool isc = row >= ML; const float* xr = isc ? xc + (size_t)(row - ML) * 1024 : xl + (size_t)row * 1024;
        const float* mv = modL + (size_t)(isc ? 4 : (row >> 13)) * 6144;
        f32x4 v[4]; float ss = 0.f;
#pragma unroll
        for (int j = 0; j < 4; ++j) { v[j] = *(const f32x4*)(xr + 4 * lane + 256 * j); ss += (v[j][0] * v[j][0] + v[j][1] * v[j][1]) + (v[j][2] * v[j][2] + v[j][3] * v[j][3]); }
        const float rstd = 1.f / sqrtf(wave_sum(ss) * (1.f / 1024.f) + EPS);
        u32x2* o8 = (u32x2*)(O + (size_t)row * 1024) + lane;
#pragma unroll
        for (int j = 0; j < 4; ++j) { const f32x4 sc = *(const f32x4*)(mv + sc_off + 4 * lane + 256 * j), sh = *(const f32x4*)(mv + sh_off + 4 * lane + 256 * j);
            const f32x4 y = v[j] * rstd * gn[j] * (sc + 1.f) + sh; u32x2 w; w.x = pk2(y[0], y[1]); w.y = pk2(y[2], y[3]); o8[64 * j] = w; }
    }
}

__device__ __forceinline__ float logsig2(float x) { return -log1pf(expf(-x)) * LOG2E; }

template <bool DO_KS, bool DO_QS, bool DO_KT>
__device__ __forceinline__ void ret_stage(const bf16_t* U, const float* RR, int row0, int t0, int hd, LAS bf16_t* Ks, LAS bf16_t* Qs, LAS bf16_t* KT, LAS bf16_t* VT, int tid) {
    const int j = tid >> 2, qd = tid & 3; const size_t rb = (size_t)(row0 + j) * 256 + hd * 64 + 8 * qd;
    float c[8], s[8];
    if (t0 >= 0) { const float* rr = RR + ((size_t)(t0 + j) * 32 + 8 * qd) * 2;
#pragma unroll
        for (int i = 0; i < 8; i += 2) { const f32x4 v = *(const f32x4*)(rr + 2 * i); c[i] = v[0]; s[i] = v[1]; c[i + 1] = v[2]; s[i + 1] = v[3]; } }
    else {
#pragma unroll
        for (int i = 0; i < 8; ++i) { c[i] = 1.f; s[i] = 0.f; } }
    {
        const u32x4 a = *(const u32x4*)(U + rb), b = *(const u32x4*)(U + rb + 32);
        float x1[8] = {bflo(a.x), bfhi(a.x), bflo(a.y), bfhi(a.y), bflo(a.z), bfhi(a.z), bflo(a.w), bfhi(a.w)};
        float x2[8] = {bflo(b.x), bfhi(b.x), bflo(b.y), bfhi(b.y), bflo(b.z), bfhi(b.z), bflo(b.w), bfhi(b.w)};
        float o1[8], o2[8];
#pragma unroll
        for (int i = 0; i < 8; ++i) { o1[i] = (x1[i] * c[i] - x2[i] * s[i]) * 0.125f; o2[i] = (x2[i] * c[i] + x1[i] * s[i]) * 0.125f; }
        if (DO_KS) { u32x4 w1, w2; w1.x = pk2(o1[0], o1[1]); w1.y = pk2(o1[2], o1[3]); w1.z = pk2(o1[4], o1[5]); w1.w = pk2(o1[6], o1[7]);
            w2.x = pk2(o2[0], o2[1]); w2.y = pk2(o2[2], o2[3]); w2.z = pk2(o2[4], o2[5]); w2.w = pk2(o2[6], o2[7]);
            *(LAS u32x4*)(Ks + j * 72 + 8 * qd) = w1; *(LAS u32x4*)(Ks + j * 72 + 32 + 8 * qd) = w2; }
        if (DO_KT) {
#pragma unroll
            for (int i = 0; i < 8; ++i) { KT[(8 * qd + i) * 136 + j] = (bf16_t)f2bf(o1[i]); KT[(32 + 8 * qd + i) * 136 + j] = (bf16_t)f2bf(o2[i]); } }
    }
    if (DO_QS) {
        const bf16_t* Uq = U + (size_t)4 * MT * 256;
        const u32x4 a = *(const u32x4*)(Uq + rb), b = *(const u32x4*)(Uq + rb + 32);
        float x1[8] = {bflo(a.x), bfhi(a.x), bflo(a.y), bfhi(a.y), bflo(a.z), bfhi(a.z), bflo(a.w), bfhi(a.w)};
        float x2[8] = {bflo(b.x), bfhi(b.x), bflo(b.y), bfhi(b.y), bflo(b.z), bfhi(b.z), bflo(b.w), bfhi(b.w)};
        float o1[8], o2[8];
#pragma unroll
        for (int i = 0; i < 8; ++i) { o1[i] = x1[i] * c[i] - x2[i] * s[i]; o2[i] = x2[i] * c[i] + x1[i] * s[i]; }
        u32x4 w1, w2; w1.x = pk2(o1[0], o1[1]); w1.y = pk2(o1[2], o1[3]); w1.z = pk2(o1[4], o1[5]); w1.w = pk2(o1[6], o1[7]);
        w2.x = pk2(o2[0], o2[1]); w2.y = pk2(o2[2], o2[3]); w2.z = pk2(o2[4], o2[5]); w2.w = pk2(o2[6], o2[7]);
        *(LAS u32x4*)(Qs + j * 72 + 8 * qd) = w1; *(LAS u32x4*)(Qs + j * 72 + 32 + 8 * qd) = w2;
    }
    {
        const bf16_t* Uv = U + (size_t)1 * MT * 256;
        const u32x4 a = *(const u32x4*)(Uv + rb), b = *(const u32x4*)(Uv + rb + 32);
        const unsigned wa[4] = {a.x, a.y, a.z, a.w}, wb[4] = {b.x, b.y, b.z, b.w};
#pragma unroll
        for (int i = 0; i < 4; ++i) { VT[(8 * qd + 2 * i) * 136 + j] = (bf16_t)(wa[i] & 0xffffu); VT[(8 * qd + 2 * i + 1) * 136 + j] = (bf16_t)(wa[i] >> 16);
            VT[(32 + 8 * qd + 2 * i) * 136 + j] = (bf16_t)(wb[i] & 0xffffu); VT[(32 + 8 * qd + 2 * i + 1) * 136 + j] = (bf16_t)(wb[i] >> 16); }
    }
}

__device__ __forceinline__ void ret_dstate_unit(const Args& a, int L, int u, LAS unsigned char* lds, int tid, int lane, int wave) { asm volatile("" : "+v"(lane)); asm volatile("" : "+v"(tid));
    const bf16_t* U = (const bf16_t*)(a.ws + WS_U); const float* RR = (const float*)(a.ws + WS_ROPER);
    LAS bf16_t* KT = (LAS bf16_t*)lds; LAS bf16_t* VT = (LAS bf16_t*)(lds + 17408);
    int b, hd, n, row0, t0; float* dst0;
    if (u < 1024) { b = u >> 8; hd = (u >> 6) & 3; n = u & 63; row0 = b * SEQ + n * 128; t0 = n * 128; dst0 = (float*)(a.ws + WS_ST) + ((size_t)((b * 4 + hd) * 64 + n)) * 4096; }
    else { const int v = u - 1024; b = v >> 3; hd = (v >> 1) & 3; n = v & 1; row0 = ML + b * CTXL + n * 128; t0 = -1; dst0 = (float*)(a.ws + WS_STC) + ((size_t)((b * 4 + hd) * 2 + n)) * 4096; }
    ret_stage<false, false, true>(U, RR, row0, t0, hd, KT, KT, KT, VT, tid);
    __syncthreads();
    const int dir = wave >> 2, dkb = (wave >> 1) & 1, dvb = wave & 1, r = lane & 31, h = lane >> 5;
    const float lg2 = logsig2(a.in[dir ? I_DECB : I_DECF][L * 4 + hd]);
    f32x16 acc = zero16();
#pragma unroll
    for (int s = 0; s < 8; ++s) {
        const u32x4 kw = *(const LAS u32x4*)(KT + (dkb * 32 + r) * 136 + 16 * s + 8 * h);
        const int j0 = 16 * s + 8 * h;
        float w[8];
#pragma unroll
        for (int i = 0; i < 8; ++i) w[i] = fexp2(lg2 * (float)(dir ? (j0 + i) : (127 - j0 - i)));
        u32x4 ka; ka.x = pk2(bflo(kw.x) * w[0], bfhi(kw.x) * w[1]); ka.y = pk2(bflo(kw.y) * w[2], bfhi(kw.y) * w[3]);
        ka.z = pk2(bflo(kw.z) * w[4], bfhi(kw.z) * w[5]); ka.w = pk2(bflo(kw.w) * w[6], bfhi(kw.w) * w[7]);
        const bf16x8 vb = *(const LAS bf16x8*)(VT + (dvb * 32 + r) * 136 + 16 * s + 8 * h);
        acc = mfma32(as_bf16x8(ka), vb, acc);
    }
    float* dst = dst0 + (size_t)dir * (u < 1024 ? (size_t)16 * 64 * 4096 : (size_t)16 * 2 * 4096);
#pragma unroll
    for (int q = 0; q < 16; ++q) dst[(dkb * 32 + crow(q, h)) * 64 + dvb * 32 + r] = acc[q];
}

__device__ __forceinline__ void ret_scan_unit(const Args& a, int L, int u, int tid) { asm volatile("" : "+v"(tid));
    const int dir = u >> 7, bh = (u >> 3) & 15, e = (u & 7) * 512 + tid, hd = bh & 3;
    const float lg2 = logsig2(a.in[dir ? I_DECB : I_DECF][L * 4 + hd]); const float g128 = fexp2(lg2 * 128.f);
    float* st = (float*)(a.ws + WS_ST) + ((size_t)(dir * 16 + bh) * 64) * 4096 + e;
    const float* sc = (const float*)(a.ws + WS_STC) + ((size_t)(dir * 16 + bh) * 2) * 4096 + e;
    float S = dir == 0 ? g128 * sc[0] + sc[4096] : sc[0] + g128 * sc[4096];
    for (int n0 = 0; n0 < 64; n0 += 8) {
        float t[8];
#pragma unroll
        for (int i = 0; i < 8; ++i) { const int n = dir == 0 ? n0 + i : 63 - n0 - i; t[i] = st[(size_t)n * 4096]; }
#pragma unroll
        for (int i = 0; i < 8; ++i) { const int n = dir == 0 ? n0 + i : 63 - n0 - i; st[(size_t)n * 4096] = S; S = g128 * S + t[i]; }
    }
}

__device__ __forceinline__ void ret_out_unit(const Args& a, int L, int u, LAS unsigned char* lds, int tid, int lane, int wave) { asm volatile("" : "+v"(lane)); asm volatile("" : "+v"(tid));
    const bf16_t* U = (const bf16_t*)(a.ws + WS_U); const float* RR = (const float*)(a.ws + WS_ROPER);
    LAS bf16_t* Qs = (LAS bf16_t*)lds; LAS bf16_t* Ks = (LAS bf16_t*)(lds + 18432); LAS bf16_t* VT = (LAS bf16_t*)(lds + 36864);
    LAS bf16_t* SfT = (LAS bf16_t*)(lds + 54272); LAS bf16_t* SbT = (LAS bf16_t*)(lds + 63488); LAS float* Ob = (LAS float*)(lds + 72704);
    int b, hd, n, row0, t0; const float* sf; const float* sb;
    if (u < 1024) { b = u >> 8; hd = (u >> 6) & 3; n = u & 63; row0 = b * SEQ + n * 128; t0 = n * 128;
        sf = (const float*)(a.ws + WS_ST) + ((size_t)((b * 4 + hd) * 64 + n)) * 4096; sb = sf + (size_t)16 * 64 * 4096; }
    else { const int v = u - 1024; b = v >> 3; hd = (v >> 1) & 3; n = v & 1; row0 = ML + b * CTXL + n * 128; t0 = -1;
        const float* stc = (const float*)(a.ws + WS_STC) + ((size_t)((b * 4 + hd) * 2)) * 4096;
        sf = n == 1 ? stc : nullptr; sb = n == 0 ? stc + (size_t)16 * 2 * 4096 + 4096 : nullptr; }
    ret_stage<true, true, false>(U, RR, row0, t0, hd, Ks, Qs, Ks, VT, tid);
    {
        const int dk = tid >> 3, dv0 = (tid & 7) * 8;
#pragma unroll
        for (int i = 0; i < 8; ++i) { SfT[(dv0 + i) * 72 + dk] = (bf16_t)f2bf(sf ? sf[dk * 64 + dv0 + i] : 0.f); SbT[(dv0 + i) * 72 + dk] = (bf16_t)f2bf(sb ? sb[dk * 64 + dv0 + i] : 0.f); }
    }
    __syncthreads();
    const int dir = wave >> 2, it = wave & 3, r = lane & 31, h = lane >> 5;
    const float lg2 = logsig2(a.in[dir ? I_DECB : I_DECF][L * 4 + hd]);
    const int iq = it * 32 + r;
    bf16x8 qf[4];
#pragma unroll
    for (int s = 0; s < 4; ++s) qf[s] = *(const LAS bf16x8*)(Qs + iq * 72 + 16 * s + 8 * h);
    f32x16 o[2];
    {
        const LAS bf16_t* ST_ = dir ? SbT : SfT;
        const float fac = fexp2(lg2 * (float)(dir ? (128 - iq) : (iq + 1)));
#pragma unroll
        for (int dvb = 0; dvb < 2; ++dvb) { f32x16 c = zero16();
#pragma unroll
            for (int s = 0; s < 4; ++s) c = mfma32(*(const LAS bf16x8*)(ST_ + (dvb * 32 + r) * 72 + 16 * s + 8 * h), qf[s], c);
            o[dvb] = c * fac; }
    }
    const int jt0 = dir ? it : 0, jt1 = dir ? 3 : it;
    for (int jt = jt0; jt <= jt1; ++jt) {
        f32x16 sT = zero16();
#pragma unroll
        for (int s = 0; s < 4; ++s) sT = mfma32(*(const LAS bf16x8*)(Ks + (jt * 32 + r) * 72 + 16 * s + 8 * h), qf[s], sT);
        float p[16];
#pragma unroll
        for (int q = 0; q < 16; ++q) { const int j = jt * 32 + crow(q, h); const int d = dir ? (j - iq) : (iq - j); p[q] = d >= 0 ? sT[q] * fexp2(lg2 * (float)d) : 0.f; }
#pragma unroll
        for (int sp = 0; sp < 2; ++sp) {
            u32x4 pw; pw.x = pk2(p[8 * sp + 0], p[8 * sp + 1]); pw.y = pk2(p[8 * sp + 2], p[8 * sp + 3]); pw.z = pk2(p[8 * sp + 4], p[8 * sp + 5]); pw.w = pk2(p[8 * sp + 6], p[8 * sp + 7]);
#pragma unroll
            for (int dvb = 0; dvb < 2; ++dvb) {
                const LAS bf16_t* vp = VT + (dvb * 32 + r) * 136 + jt * 32 + 16 * sp + 4 * h;
                const u32x2 v0 = *(const LAS u32x2*)vp, v1 = *(const LAS u32x2*)(vp + 8);
                u32x4 vw; vw.x = v0.x; vw.y = v0.y; vw.z = v1.x; vw.w = v1.y;
                o[dvb] = mfma32(as_bf16x8(vw), as_bf16x8(pw), o[dvb]);
            }
        }
    }
    float ss = 0.f;
#pragma unroll
    for (int dvb = 0; dvb < 2; ++dvb)
#pragma unroll
        for (int q = 0; q < 16; ++q) ss += o[dvb][q] * o[dvb][q];
    ss += __shfl_xor(ss, 32);
    const float rn = 1.f / sqrtf(ss * (1.f / 64.f) + EPS);
    const bf16_t* Ug = U + (size_t)(dir ? 6 : 5) * MT * 256 + (size_t)(row0 + iq) * 256 + hd * 64;
#pragma unroll
    for (int dvb = 0; dvb < 2; ++dvb)
#pragma unroll
        for (int q4 = 0; q4 < 4; ++q4) { const int dv = dvb * 32 + 8 * q4 + 4 * h; const u32x2 gw = *(const u32x2*)(Ug + dv);
            o[dvb][4 * q4 + 0] *= rn * siluf(bflo(gw.x)); o[dvb][4 * q4 + 1] *= rn * siluf(bfhi(gw.x)); o[dvb][4 * q4 + 2] *= rn * siluf(bflo(gw.y)); o[dvb][4 * q4 + 3] *= rn * siluf(bfhi(gw.y)); }
    if (dir == 1) {
#pragma unroll
        for (int dvb = 0; dvb < 2; ++dvb)
#pragma unroll
            for (int q4 = 0; q4 < 4; ++q4) *(LAS f32x4*)(Ob + iq * 68 + dvb * 32 + 8 * q4 + 4 * h) = (f32x4){o[dvb][4 * q4], o[dvb][4 * q4 + 1], o[dvb][4 * q4 + 2], o[dvb][4 * q4 + 3]};
    }
    __syncthreads();
    if (dir == 0) {
        bf16_t* Y = (bf16_t*)(a.ws + WS_YBR) + (size_t)(row0 + iq) * 1024 + hd * 64;
#pragma unroll
        for (int dvb = 0; dvb < 2; ++dvb)
#pragma unroll
            for (int q4 = 0; q4 < 4; ++q4) { const int dv = dvb * 32 + 8 * q4 + 4 * h; const f32x4 ob = *(const LAS f32x4*)(Ob + iq * 68 + dv);
                u32x2 w; w.x = pk2(o[dvb][4 * q4] + ob[0], o[dvb][4 * q4 + 1] + ob[1]); w.y = pk2(o[dvb][4 * q4 + 2] + ob[2], o[dvb][4 * q4 + 3] + ob[3]);
                *(u32x2*)(Y + dv) = w; }
    }
}

__device__ __forceinline__ void mla_prep_wave(const Args& a, int L, int blk, int lane) { asm volatile("" : "+v"(lane));
    const unsigned char* ws = a.ws; const bf16_t* U = (const bf16_t*)(ws + WS_U);
    const int r = lane & 31, h = lane >> 5, row = blk * 32 + r; const bool isc = row >= ML;
    int b, key, t;
    if (!isc) { b = row >> 13; t = row & 8191; key = t; } else { const int rc = row - ML; b = rc >> 8; t = rc & 255; key = SEQ + t; }
    const float* RM = (const float*)(ws + WS_ROPEM);
    bf16_t* MK = (bf16_t*)(a.ws + WS_MK); bf16_t* MVT = (bf16_t*)(a.ws + WS_MVT);
    {
        const bf16_t* up = U + (size_t)9 * MT * 256 + (size_t)row * 256;
        u32x4 xs[8]; float ss = 0.f;
#pragma unroll
        for (int s = 0; s < 8; ++s) { xs[s] = *(const u32x4*)(up + 16 * s + 8 * h);
            const float v[8] = {bflo(xs[s].x), bfhi(xs[s].x), bflo(xs[s].y), bfhi(xs[s].y), bflo(xs[s].z), bfhi(xs[s].z), bflo(xs[s].w), bfhi(xs[s].w)};
#pragma unroll
            for (int i = 0; i < 8; ++i) ss += v[i] * v[i]; }
        ss += __shfl_xor(ss, 32);
        const float rstd = 1.f / sqrtf(ss * (1.f / 128.f) + EPS);
        const float* kvn = a.in[I_KVNORM] + L * 128;
#pragma unroll
        for (int s = 0; s < 8; ++s) { const f32x4 g0 = *(const f32x4*)(kvn + 16 * s + 8 * h), g1 = *(const f32x4*)(kvn + 16 * s + 8 * h + 4);
            u32x4 w; w.x = pk2(bflo(xs[s].x) * rstd * g0[0], bfhi(xs[s].x) * rstd * g0[1]); w.y = pk2(bflo(xs[s].y) * rstd * g0[2], bfhi(xs[s].y) * rstd * g0[3]);
            w.z = pk2(bflo(xs[s].z) * rstd * g1[0], bfhi(xs[s].z) * rstd * g1[1]); w.w = pk2(bflo(xs[s].w) * rstd * g1[2], bfhi(xs[s].w) * rstd * g1[3]); xs[s] = w;  asm volatile("" ::: "memory"); }
        const bf16_t* W = (const bf16_t*)(ws + WS_WUKV) + (size_t)L * 512 * 128;
        for (int ob = 0; ob < 16; ++ob) {
            f32x16 acc = zero16();
#pragma unroll
            for (int s = 0; s < 8; ++s) acc = mfma32(*(const bf16x8*)(W + (size_t)(ob * 32 + r) * 128 + 16 * s + 8 * h), as_bf16x8(xs[s]), acc);
            const int hh = ob >> 2, part = ob & 3;
            if (part < 2) {
                bf16_t* kp = MK + ((size_t)(b * 4 + hh) * 8448 + key) * 96 + part * 32 + 4 * h;
#pragma unroll
                for (int q4 = 0; q4 < 4; ++q4) { u32x2 w; w.x = pk2(acc[4 * q4], acc[4 * q4 + 1]); w.y = pk2(acc[4 * q4 + 2], acc[4 * q4 + 3]); *(u32x2*)(kp + 8 * q4) = w; }
            } else {
                bf16_t* vp = MVT + ((size_t)(b * 4 + hh) * 64 + (part - 2) * 32) * 8448 + key;
#pragma unroll
                for (int q = 0; q < 16; ++q) vp[(size_t)crow(q, h) * 8448] = (bf16_t)f2bf(acc[q]);
            }
        }
        const u32x4 a1 = *(const u32x4*)(up + 128 + 8 * h), a2 = *(const u32x4*)(up + 144 + 8 * h);
        float x1[8] = {bflo(a1.x), bfhi(a1.x), bflo(a1.y), bfhi(a1.y), bflo(a1.z), bfhi(a1.z), bflo(a1.w), bfhi(a1.w)};
        float x2[8] = {bflo(a2.x), bfhi(a2.x), bflo(a2.y), bfhi(a2.y), bflo(a2.z), bfhi(a2.z), bflo(a2.w), bfhi(a2.w)};
        float o1[8], o2[8];
#pragma unroll
        for (int i = 0; i < 8; ++i) { float c = 1.f, s = 0.f; if (!isc) { const f32x2 cs = *(const f32x2*)(RM + ((size_t)t * 16 + 8 * h + i) * 2); c = cs[0]; s = cs[1]; }
            o1[i] = x1[i] * c - x2[i] * s; o2[i] = x2[i] * c + x1[i] * s; }
        u32x4 w1, w2; w1.x = pk2(o1[0], o1[1]); w1.y = pk2(o1[2], o1[3]); w1.z = pk2(o1[4], o1[5]); w1.w = pk2(o1[6], o1[7]);
        w2.x = pk2(o2[0], o2[1]); w2.y = pk2(o2[2], o2[3]); w2.z = pk2(o2[4], o2[5]); w2.w = pk2(o2[6], o2[7]);
#pragma unroll
        for (int hh = 0; hh < 4; ++hh) { bf16_t* kp = MK + ((size_t)(b * 4 + hh) * 8448 + key) * 96 + 64; *(u32x4*)(kp + 8 * h) = w1; *(u32x4*)(kp + 16 + 8 * h) = w2; }
    }
    if (!isc || L == 0) {
        const bf16_t* up = U + (size_t)10 * MT * 256 + (size_t)row * 256;
        u32x4 xs[12]; float ss = 0.f;
#pragma unroll
        for (int s = 0; s < 12; ++s) { xs[s] = *(const u32x4*)(up + 16 * s + 8 * h);
            const float v[8] = {bflo(xs[s].x), bfhi(xs[s].x), bflo(xs[s].y), bfhi(xs[s].y), bflo(xs[s].z), bfhi(xs[s].z), bflo(xs[s].w), bfhi(xs[s].w)};
#pragma unroll
            for (int i = 0; i < 8; ++i) ss += v[i] * v[i]; }
        ss += __shfl_xor(ss, 32);
        const float rstd = 1.f / sqrtf(ss * (1.f / 192.f) + EPS);
        const float* qn = a.in[I_QNORM] + L * 192;
#pragma unroll
        for (int s = 0; s < 12; ++s) { const f32x4 g0 = *(const f32x4*)(qn + 16 * s + 8 * h), g1 = *(const f32x4*)(qn + 16 * s + 8 * h + 4);
            u32x4 w; w.x = pk2(bflo(xs[s].x) * rstd * g0[0], bfhi(xs[s].x) * rstd * g0[1]); w.y = pk2(bflo(xs[s].y) * rstd * g0[2], bfhi(xs[s].y) * rstd * g0[3]);
            w.z = pk2(bflo(xs[s].z) * rstd * g1[0], bfhi(xs[s].z) * rstd * g1[1]); w.w = pk2(bflo(xs[s].w) * rstd * g1[2], bfhi(xs[s].w) * rstd * g1[3]); xs[s] = w;  asm volatile("" ::: "memory"); }
        const bf16_t* W = (const bf16_t*)(ws + WS_WUQ) + (size_t)L * 384 * 192;
        const float qsc = 0.10206207261596577f * LOG2E;
        for (int ob = 0; ob < 12; ++ob) {
            f32x16 acc = zero16();
#pragma unroll
            for (int s = 0; s < 12; ++s) acc = mfma32(*(const bf16x8*)(W + (size_t)(ob * 32 + r) * 192 + 16 * s + 8 * h), as_bf16x8(xs[s]), acc);
            const int hh = ob / 3, part = ob % 3;
            if (part == 2 && !isc) {
#pragma unroll
                for (int q = 0; q < 8; ++q) { const f32x2 cs = *(const f32x2*)(RM + ((size_t)t * 16 + crow(q, h)) * 2); const float x1 = acc[q], x2 = acc[q + 8];
                    acc[q] = x1 * cs[0] - x2 * cs[1]; acc[q + 8] = x2 * cs[0] + x1 * cs[1]; }
            }
            bf16_t* qp = isc ? (bf16_t*)(a.ws + WS_MQC) + ((size_t)(b * 4 + hh) * 256 + t) * 96 : (bf16_t*)(a.ws + WS_MQ) + ((size_t)(b * 4 + hh) * 8192 + t) * 96;
            qp += part * 32 + 4 * h;
#pragma unroll
            for (int q4 = 0; q4 < 4; ++q4) { u32x2 w; w.x = pk2(acc[4 * q4] * qsc, acc[4 * q4 + 1] * qsc); w.y = pk2(acc[4 * q4 + 2] * qsc, acc[4 * q4 + 3] * qsc); *(u32x2*)(qp + 8 * q4) = w; }
        }
    }
}

__device__ __forceinline__ void four_stage1_unit(const Args& a, int u, int lane, int wave) { asm volatile("" : "+v"(lane));
    const unsigned char* ws = a.ws; const bf16_t* F = (const bf16_t*)(ws + WS_U) + (size_t)7 * MT * 256;
    const int b = u >> 6, t1 = u & 63, r = lane & 31, h = lane >> 5, c = wave * 32 + r;
    u32x4 fr[8];
#pragma unroll
    for (int s = 0; s < 8; ++s) { unsigned e[8];
#pragma unroll
        for (int j = 0; j < 8; ++j) e[j] = F[(size_t)(b * SEQ + t1 + 64 * (16 * s + 8 * h + j)) * 256 + c];
        fr[s].x = e[0] | (e[1] << 16); fr[s].y = e[2] | (e[3] << 16); fr[s].z = e[4] | (e[5] << 16); fr[s].w = e[6] | (e[7] << 16); }
    const bf16_t* M1 = (const bf16_t*)(ws + WS_M1); const float* TW = (const float*)(ws + WS_TW);
    unsigned* A2 = (unsigned*)(a.ws + WS_A2) + ((size_t)(b * 64 + t1) * 128) * 256 + c;
    for (int i = 0; i < 4; ++i) {
        f32x16 ar = zero16(), ai = zero16();
#pragma unroll
        for (int s = 0; s < 8; ++s) { ar = mfma32(*(const bf16x8*)(M1 + (size_t)(32 * i + r) * 128 + 16 * s + 8 * h), as_bf16x8(fr[s]), ar);
            ai = mfma32(*(const bf16x8*)(M1 + (size_t)(128 + 32 * i + r) * 128 + 16 * s + 8 * h), as_bf16x8(fr[s]), ai); }
#pragma unroll
        for (int q = 0; q < 16; ++q) { const int k2 = 32 * i + crow(q, h); const f32x2 w = *(const f32x2*)(TW + 2 * (k2 * t1));
            A2[(size_t)k2 * 256] = pk2(ar[q] * w[0] + ai[q] * w[1], ai[q] * w[0] - ar[q] * w[1]); }
    }
}
__device__ __forceinline__ void four_stage2_unit(const Args& a, int u, int lane, int wave) { asm volatile("" : "+v"(lane));
    const unsigned char* ws = a.ws;
    const int b = u >> 7, k2 = u & 127, r = lane & 31, h = lane >> 5, g = wave >> 1, kb = wave & 1;
    const unsigned* A2 = (const unsigned*)(ws + WS_A2) + ((size_t)(b * 64) * 128 + k2) * 256;
    const bf16_t* D2 = (const bf16_t*)(ws + WS_D2); const bf16_t* EP = (const bf16_t*)(ws + WS_EP);
    f32x16 acc[2][2];
#pragma unroll
    for (int ct = 0; ct < 2; ++ct)
#pragma unroll
        for (int ro = 0; ro < 2; ++ro) acc[ct][ro] = zero16();
#pragma unroll
    for (int s = 0; s < 8; ++s) {
        const bf16x8 d0 = *(const bf16x8*)(D2 + (size_t)(kb * 32 + r) * 128 + 16 * s + 8 * h), d1 = *(const bf16x8*)(D2 + (size_t)(64 + kb * 32 + r) * 128 + 16 * s + 8 * h);
#pragma unroll
        for (int ct = 0; ct < 2; ++ct) { const int c = g * 64 + ct * 32 + r; u32x4 f;
            f.x = A2[(size_t)(8 * s + 4 * h + 0) * 128 * 256 + c]; f.y = A2[(size_t)(8 * s + 4 * h + 1) * 128 * 256 + c];
            f.z = A2[(size_t)(8 * s + 4 * h + 2) * 128 * 256 + c]; f.w = A2[(size_t)(8 * s + 4 * h + 3) * 128 * 256 + c];
            acc[ct][0] = mfma32(as_bf16x8(f), d0, acc[ct][0]); acc[ct][1] = mfma32(as_bf16x8(f), d1, acc[ct][1]); }
    }
    f32x16 y[2] = {zero16(), zero16()};
#pragma unroll
    for (int ro = 0; ro < 2; ++ro)
#pragma unroll
        for (int ct = 0; ct < 2; ++ct)
#pragma unroll
            for (int sp = 0; sp < 2; ++sp) { const f32x16& x = acc[ct][ro];
                u32x4 xw; xw.x = pk2(x[8 * sp + 0], x[8 * sp + 1]); xw.y = pk2(x[8 * sp + 2], x[8 * sp + 3]); xw.z = pk2(x[8 * sp + 4], x[8 * sp + 5]); xw.w = pk2(x[8 * sp + 6], x[8 * sp + 7]);
#pragma unroll
                for (int lb = 0; lb < 2; ++lb) y[lb] = mfma32(*(const bf16x8*)(EP + (size_t)(lb * 32 + r) * 128 + ro * 64 + ct * 32 + sp * 16 + h * 8), as_bf16x8(xw), y[lb]); }
    const float sc = 0.0013810679320049757f;
    bf16_t* Y = (bf16_t*)(a.ws + WS_YBR) + ((size_t)(b * SEQ + 128 * (kb * 32 + r) + k2)) * 1024 + 256 + g * 64;
#pragma unroll
    for (int lb = 0; lb < 2; ++lb)
#pragma unroll
        for (int q4 = 0; q4 < 4; ++q4) { u32x2 w; w.x = pk2(y[lb][4 * q4] * sc, y[lb][4 * q4 + 1] * sc); w.y = pk2(y[lb][4 * q4 + 2] * sc, y[lb][4 * q4 + 3] * sc);
            *(u32x2*)(Y + lb * 32 + 8 * q4 + 4 * h) = w; }
}
__device__ __forceinline__ void cfour_step1_unit(const Args& a, int u, LAS unsigned char* lds, int tid) { asm volatile("" : "+v"(tid));
    LAS float* fl = (LAS float*)lds;
    LAS float* cs = (LAS float*)(lds + 2048);
    const bf16_t* F = (const bf16_t*)(a.ws + WS_U) + (size_t)7 * MT * 256;
    const int rr = tid >> 8, col = tid & 255, row = 2 * u + rr;
    fl[tid] = bf2f(F[(size_t)(ML + row) * 256 + col]);
    if (tid < 64) { const float ang = 6.283185307179586f * (float)tid / 64.f; cs[2 * tid] = cosf(ang); cs[2 * tid + 1] = sinf(ang); }
    __syncthreads();
    const int g = col >> 6, l = col & 63; float p = 0.f, q = 0.f;
    for (int c = 0; c < 64; ++c) { const float f = fl[rr * 256 + g * 64 + c]; const int m = (l * c) & 63; p += f * cs[2 * m]; q += f * cs[2 * m + 1]; }
    float* O = (float*)(a.ws + WS_CPQ) + (size_t)row * 512; O[col] = p; O[256 + col] = q;
}
__device__ __forceinline__ void cfour_step2_unit(const Args& a, int u, LAS unsigned char* lds, int tid) { asm volatile("" : "+v"(tid));
    LAS float* cs = (LAS float*)lds;
    if (tid < 256) { const float ang = 6.283185307179586f * (float)tid / 256.f; cs[2 * tid] = cosf(ang); cs[2 * tid + 1] = sinf(ang); }
    __syncthreads();
    const int b = u >> 7, k = (u & 127) * 2 + (tid >> 8), col = tid & 255;
    const float* P = (const float*)(a.ws + WS_CPQ) + (size_t)(b * 256) * 512 + col; float acc = 0.f;
    for (int t = 0; t < 256; ++t) { const int m = (k * t) & 255; acc += cs[2 * m] * P[(size_t)t * 512] - cs[2 * m + 1] * P[(size_t)t * 512 + 256]; }
    ((bf16_t*)(a.ws + WS_YBR))[(size_t)(ML + b * 256 + k) * 1024 + 256 + col] = (bf16_t)f2bf(acc * (1.f / 128.f));
}

__device__ __forceinline__ void osm_step(const f32x16& x, float& m, float& l, f32x16& o0, f32x16& o1, u32x4& p0, u32x4& p1) {
    float bm = fmaxf(fmaxf(x[0], x[1]), fmaxf(x[2], x[3]));
#pragma unroll
    for (int q = 4; q < 16; q += 4) bm = fmaxf(bm, fmaxf(fmaxf(x[q], x[q + 1]), fmaxf(x[q + 2], x[q + 3])));
    bm = fmaxf(bm, __shfl_xor(bm, 32));
    const float mn = fmaxf(m, bm);
    const float alpha = fexp2(m - mn);
    float p[16]; float ps = 0.f;
#pragma unroll
    for (int q = 0; q < 16; ++q) { p[q] = fexp2(x[q] - mn); ps += p[q]; }
    l = l * alpha + ps; m = mn;
    o0 = o0 * alpha; o1 = o1 * alpha;
    p0.x = pk2(p[0], p[1]); p0.y = pk2(p[2], p[3]); p0.z = pk2(p[4], p[5]); p0.w = pk2(p[6], p[7]);
    p1.x = pk2(p[8], p[9]); p1.y = pk2(p[10], p[11]); p1.z = pk2(p[12], p[13]); p1.w = pk2(p[14], p[15]);
}

__device__ __forceinline__ void na_unit(const Args& a, int L, int u, LAS unsigned char* lds, int tid, int lane, int wave) { asm volatile("" : "+v"(lane)); asm volatile("" : "+v"(tid));
    const bf16_t* U = (const bf16_t*)(a.ws + WS_U);
    const bf16_t* UK = U + (size_t)2 * MT * 256; const bf16_t* UV = U + (size_t)3 * MT * 256; const bf16_t* UQ = U + (size_t)8 * MT * 256;
    LAS float* rp = (LAS float*)lds;
    for (int i = tid; i < 4 * 465; i += 512) rp[i] = a.in[I_RPB][(size_t)L * 4 * 465 + i];
    __syncthreads();
    const int hd = wave >> 1, qh = wave & 1, r = lane & 31, h = lane >> 5;
    const bool isc = u >= 512; int b, gr = 0, rs = 0, qrow;
    if (!isc) { b = u >> 7; gr = u & 127; rs = gr - 4; rs = rs < 0 ? 0 : (rs > 120 ? 120 : rs); qrow = b * SEQ + gr * 64 + qh * 32 + r; }
    else { const int v = u - 512; b = v >> 2; qrow = ML + b * CTXL + (v & 3) * 64 + qh * 32 + r; }
    const int cq = qh * 32 + r; int cs = cq - 8; cs = cs < 0 ? 0 : (cs > 48 ? 48 : cs);
    bf16x8 qf[4];
#pragma unroll
    for (int s = 0; s < 4; ++s) qf[s] = *(const bf16x8*)(UQ + (size_t)qrow * 256 + hd * 64 + 16 * s + 8 * h);
    float m = -INFINITY, l = 0.f; f32x16 o0 = zero16(), o1 = zero16();
    const int nblk = isc ? 8 : 24;
    for (int kb = 0; kb < nblk; ++kb) {
        int krow0; int li = 0, cbk = 0;
        if (kb < 8) krow0 = ML + b * CTXL + kb * 32;
        else { li = (kb - 8) >> 1; cbk = (kb - 8) & 1; krow0 = b * SEQ + (rs + li) * 64 + cbk * 32; }
        f32x16 sT = zero16();
#pragma unroll
        for (int s = 0; s < 4; ++s) sT = mfma32(*(const bf16x8*)(UK + (size_t)(krow0 + r) * 256 + hd * 64 + 16 * s + 8 * h), qf[s], sT);
        f32x16 x;
        if (kb < 8) {
#pragma unroll
            for (int q = 0; q < 16; ++q) x[q] = sT[q] * (0.125f * LOG2E);
        } else {
            const LAS float* bp = rp + hd * 465 + (rs + li - gr + 7) * 31 + 15 - cq;
#pragma unroll
            for (int q = 0; q < 16; ++q) { const int ck = cbk * 32 + crow(q, h); const bool ok = (ck >= cs) && (ck < cs + 16);
                x[q] = ok ? (sT[q] * 0.125f + bp[ok ? ck : cq]) * LOG2E : -INFINITY; }
        }
        u32x4 p0, p1;
        osm_step(x, m, l, o0, o1, p0, p1);
#pragma unroll
        for (int sp = 0; sp < 2; ++sp) {
#pragma unroll
            for (int dvb = 0; dvb < 2; ++dvb) { unsigned e[8];
#pragma unroll
                for (int j = 0; j < 8; ++j) e[j] = UV[(size_t)(krow0 + 16 * sp + 8 * (j >> 2) + 4 * h + (j & 3)) * 256 + hd * 64 + dvb * 32 + r];
                u32x4 vw; vw.x = e[0] | (e[1] << 16); vw.y = e[2] | (e[3] << 16); vw.z = e[4] | (e[5] << 16); vw.w = e[6] | (e[7] << 16);
                if (dvb == 0) o0 = mfma32(as_bf16x8(vw), as_bf16x8(sp ? p1 : p0), o0); else o1 = mfma32(as_bf16x8(vw), as_bf16x8(sp ? p1 : p0), o1); }
        }
    }
    l += __shfl_xor(l, 32);
    const float il = 1.f / l;
    bf16_t* Y = (bf16_t*)(a.ws + WS_YBR) + (size_t)qrow * 1024 + 512 + hd * 64 + 4 * h;
#pragma unroll
    for (int q4 = 0; q4 < 4; ++q4) { u32x2 w; w.x = pk2(o0[4 * q4] * il, o0[4 * q4 + 1] * il); w.y = pk2(o0[4 * q4 + 2] * il, o0[4 * q4 + 3] * il); *(u32x2*)(Y + 8 * q4) = w;
        u32x2 w2; w2.x = pk2(o1[4 * q4] * il, o1[4 * q4 + 1] * il); w2.y = pk2(o1[4 * q4 + 2] * il, o1[4 * q4 + 3] * il); *(u32x2*)(Y + 32 + 8 * q4) = w2; }
}

__device__ __forceinline__ void mla_unit(const Args& a, int u, LAS unsigned char* lds, int tid, int lane, int wave) { asm volatile("" : "+v"(lane)); asm volatile("" : "+v"(tid));
    const bool isc = u >= 512; int bh, q0, key0, nt; size_t orow0;
    if (!isc) { bh = u >> 5; q0 = (u & 31) * 256; key0 = 0; nt = 132; orow0 = (size_t)(bh >> 2) * SEQ + q0; }
    else { bh = u - 512; q0 = 0; key0 = SEQ; nt = 4; orow0 = (size_t)ML + (size_t)(bh >> 2) * CTXL; }
    const int hd = bh & 3, r = lane & 31, h = lane >> 5;
    const bf16_t* Q = isc ? (const bf16_t*)(a.ws + WS_MQC) + (size_t)bh * 256 * 96 : (const bf16_t*)(a.ws + WS_MQ) + ((size_t)bh * 8192 + q0) * 96;
    const bf16_t* Kg = (const bf16_t*)(a.ws + WS_MK) + ((size_t)bh * 8448 + key0) * 96;
    const bf16_t* Vg = (const bf16_t*)(a.ws + WS_MVT) + (size_t)bh * 64 * 8448 + key0;
    LAS unsigned char* KB = lds; LAS unsigned char* VB = lds + 26624;
    bf16x8 qf[6];
#pragma unroll
    for (int s = 0; s < 6; ++s) qf[s] = *(const bf16x8*)(Q + (size_t)(wave * 32 + r) * 96 + 16 * s + 8 * h);
    const int p0k = tid, p1k = tid + 512; const int k0key = p0k / 12, k0part = p0k % 12, k1key = p1k / 12, k1part = p1k % 12; const int vdv = tid >> 3, vpart = tid & 7;
    u32x4 rk0, rk1, rv;
    rk0 = *(const u32x4*)(Kg + (size_t)k0key * 96 + k0part * 8); if (p1k < 768) rk1 = *(const u32x4*)(Kg + (size_t)k1key * 96 + k1part * 8);
    rv = *(const u32x4*)(Vg + (size_t)vdv * 8448 + vpart * 8);
    *(LAS u32x4*)(KB + k0key * 208 + k0part * 16) = rk0; if (p1k < 768) *(LAS u32x4*)(KB + k1key * 208 + k1part * 16) = rk1;
    *(LAS u32x4*)(VB + vdv * 144 + vpart * 16) = rv;
    __syncthreads();
    float m = -INFINITY, l = 0.f; f32x16 o0 = zero16(), o1 = zero16();
    for (int t = 0; t < nt; ++t) {
        const int cur = t & 1;
        if (t + 1 < nt) { const bf16_t* kg = Kg + (size_t)(t + 1) * 64 * 96; rk0 = *(const u32x4*)(kg + (size_t)k0key * 96 + k0part * 8); if (p1k < 768) rk1 = *(const u32x4*)(kg + (size_t)k1key * 96 + k1part * 8);
            rv = *(const u32x4*)(Vg + (size_t)vdv * 8448 + (t + 1) * 64 + vpart * 8); }
        const LAS unsigned char* kb_ = KB + cur * 13312; const LAS unsigned char* vb_ = VB + cur * 9216;
#pragma unroll
        for (int blk = 0; blk < 2; ++blk) {
            f32x16 sT = zero16();
#pragma unroll
            for (int s = 0; s < 6; ++s) sT = mfma32(*(const LAS bf16x8*)(kb_ + (blk * 32 + r) * 208 + 32 * s + 16 * h), qf[s], sT);
            u32x4 p0, p1;
            osm_step(sT, m, l, o0, o1, p0, p1);
#pragma unroll
            for (int sp = 0; sp < 2; ++sp) {
#pragma unroll
                for (int dvb = 0; dvb < 2; ++dvb) { const LAS unsigned char* vp = vb_ + (dvb * 32 + r) * 144 + (blk * 32 + 16 * sp + 4 * h) * 2;
                    const u32x2 v0 = *(const LAS u32x2*)vp, v1 = *(const LAS u32x2*)(vp + 16); u32x4 vw; vw.x = v0.x; vw.y = v0.y; vw.z = v1.x; vw.w = v1.y;
                    if (dvb == 0) o0 = mfma32(as_bf16x8(vw), as_bf16x8(sp ? p1 : p0), o0); else o1 = mfma32(as_bf16x8(vw), as_bf16x8(sp ? p1 : p0), o1); }
            }
        }
        if (t + 1 < nt) { LAS unsigned char* kn = KB + (cur ^ 1) * 13312; LAS unsigned char* vn = VB + (cur ^ 1) * 9216;
            *(LAS u32x4*)(kn + k0key * 208 + k0part * 16) = rk0; if (p1k < 768) *(LAS u32x4*)(kn + k1key * 208 + k1part * 16) = rk1;
            *(LAS u32x4*)(vn + vdv * 144 + vpart * 16) = rv; }
        __syncthreads();
    }
    l += __shfl_xor(l, 32);
    const float il = 1.f / l;
    bf16_t* Y = (bf16_t*)(a.ws + WS_YBR) + (orow0 + wave * 32 + r) * 1024 + 768 + hd * 64 + 4 * h;
#pragma unroll
    for (int q4 = 0; q4 < 4; ++q4) { u32x2 w; w.x = pk2(o0[4 * q4] * il, o0[4 * q4 + 1] * il); w.y = pk2(o0[4 * q4 + 2] * il, o0[4 * q4 + 3] * il); *(u32x2*)(Y + 8 * q4) = w;
        u32x2 w2; w2.x = pk2(o1[4 * q4] * il, o1[4 * q4 + 1] * il); w2.y = pk2(o1[4 * q4 + 2] * il, o1[4 * q4 + 3] * il); *(u32x2*)(Y + 32 + 8 * q4) = w2; }
}

__device__ __forceinline__ void moe_offsets(const unsigned* cnt, int (&pst)[NE], int& ntiles) {
    int acc = 0;
#pragma unroll
    for (int e = 0; e < NE; ++e) { pst[e] = acc; const int c = (int)__hip_atomic_load(cnt + e, __ATOMIC_RELAXED, __HIP_MEMORY_SCOPE_AGENT); acc += (c + 255) / 256 * 256; }
    ntiles = acc / 256;
}
__device__ __forceinline__ void ffn_norm_row(const float* xr, const f32x4 (&gn)[4], const float* mv, int lane, f32x4 (&y)[4]) {
    f32x4 v[4]; float ss = 0.f;
#pragma unroll
    for (int j = 0; j < 4; ++j) { v[j] = *(const f32x4*)(xr + 4 * lane + 256 * j); ss += (v[j][0] * v[j][0] + v[j][1] * v[j][1]) + (v[j][2] * v[j][2] + v[j][3] * v[j][3]); }
    const float rstd = 1.f / sqrtf(wave_sum(ss) * (1.f / 1024.f) + EPS);
#pragma unroll
    for (int j = 0; j < 4; ++j) { const f32x4 sc = *(const f32x4*)(mv + 4096 + 4 * lane + 256 * j), sh = *(const f32x4*)(mv + 3072 + 4 * lane + 256 * j);
        y[j] = v[j] * rstd * gn[j] * (sc + 1.f) + sh; }
}
__device__ __forceinline__ void ph_route(const Args& a, LAS unsigned char* lds, int tid, int lane, int wave, int bid, int G) { asm volatile("" : "+v"(lane)); asm volatile("" : "+v"(tid));
    unsigned char* ws = a.ws; unsigned* ctl = (unsigned*)(ws + WS_CTL);
    const int gt = bid * 512 + tid, NGT = G * 512, gw = bid * 8 + wave, NGW = G * 8;
    int* rowinfo = (int*)(ws + WS_ROWINFO);
    for (int i = gt; i < NRMAX; i += NGT) rowinfo[i] = -1;
    LAS float* rt = (LAS float*)lds;
    for (int i = tid; i < 8192; i += 512) rt[i] = a.in[I_ROUTER][i];
    __syncthreads();
    const float* modL = (const float*)(ws + WS_MOD) + (size_t)5 * 6144;
    f32x4 gn[4];
#pragma unroll
    for (int j = 0; j < 4; ++j) gn[j] = *(const f32x4*)(a.in[I_NFFN] + 1024 + 4 * lane + 256 * j);
    unsigned mycnt = 0;
    for (int row = gw; row < ML; row += NGW) {
        f32x4 y[4]; ffn_norm_row(a.out + (size_t)row * 1024, gn, modL + (size_t)(row >> 13) * 6144, lane, y);
        float lg[8] = {0.f, 0.f, 0.f, 0.f, 0.f, 0.f, 0.f, 0.f};
#pragma unroll
        for (int j = 0; j < 4; ++j)
#pragma unroll
            for (int i = 0; i < 4; ++i) { const int k = 4 * lane + 256 * j + i; const f32x4 r0 = *(const LAS f32x4*)(rt + k * 8), r1 = *(const LAS f32x4*)(rt + k * 8 + 4); const float hv = y[j][i];
                lg[0] += hv * r0[0]; lg[1] += hv * r0[1]; lg[2] += hv * r0[2]; lg[3] += hv * r0[3]; lg[4] += hv * r1[0]; lg[5] += hv * r1[1]; lg[6] += hv * r1[2]; lg[7] += hv * r1[3]; }
#pragma unroll
        for (int e = 0; e < 8; ++e) lg[e] = wave_sum(lg[e]);
        int e0 = 0; float l0 = lg[0];
#pragma unroll
        for (int e = 1; e < 8; ++e) if (lg[e] > l0) { l0 = lg[e]; e0 = e; }
        int e1 = -1; float l1 = -INFINITY;
#pragma unroll
        for (int e = 0; e < 8; ++e) if (e != e0 && lg[e] > l1) { l1 = lg[e]; e1 = e; }
        const float w0 = 1.f / (1.f + expf(l1 - l0)), w1 = 1.f - w0;
        if (lane == 0) { u32x4 t; t.x = (unsigned)e0; t.y = (unsigned)e1; t.z = __float_as_uint(w0); t.w = __float_as_uint(w1); *(u32x4*)(ws + WS_TOK + (size_t)row * 16) = t; }
        mycnt += (lane == e0 || lane == e1) ? 1u : 0u;
    }
    if (lane < 8 && mycnt) atomicAdd(ctl + CW_CNT + lane, mycnt);
    __syncthreads();
    LAS float* scr = (LAS float*)(lds + 32768 + wave * 8448);
    constexpr int IGU = 16 * 224, IDN = 56 * 32;
    for (int it = gw; it < NE * (IGU + IDN); it += NGW) {
        const int e = it / (IGU + IDN); int r = it % (IGU + IDN);
        if (r < IGU) { const int kb = r / 224, nb = r % 224, pn = nb >> 3, wi = nb & 7;
            cvt_block((wi < 4 ? a.in[I_MG] : a.in[I_MU]) + (size_t)e * 1024 * MF, MF, kb * 64, 128 * pn + 32 * (wi & 3), (bf16_t*)(ws + WS_MWGU) + (size_t)e * 7168 * 1024, nb * 32, 1024, scr, lane); }
        else { r -= IGU; const int kb = r / 32, nb = r % 32;
            cvt_block(a.in[I_MD] + (size_t)e * MF * 1024, 1024, kb * 64, nb * 32, (bf16_t*)(ws + WS_MWD) + (size_t)e * 1024 * MF, nb * 32, MF, scr, lane); }
    }
}
__device__ __forceinline__ void ph_place(const Args& a, int tid, int lane, int wave, int bid, int G) { asm volatile("" : "+v"(lane)); asm volatile("" : "+v"(tid));
    unsigned char* ws = a.ws; unsigned* ctl = (unsigned*)(ws + WS_CTL);
    int pst[NE], ntiles; moe_offsets(ctl + CW_CNT, pst, ntiles);
    if (bid == 0 && tid < 264) { int e = -1;
#pragma unroll
        for (int q = 0; q < NE; ++q) if (tid * 256 >= pst[q]) e = q;
        ((int*)(ws + WS_TILEE))[tid] = tid < ntiles ? e : -1; }
    const int gw = bid * 8 + wave, NGW = G * 8;
    const float* modL = (const float*)(ws + WS_MOD) + (size_t)5 * 6144;
    f32x4 gn[4];
#pragma unroll
    for (int j = 0; j < 4; ++j) gn[j] = *(const f32x4*)(a.in[I_NFFN] + 1024 + 4 * lane + 256 * j);
    int* rowinfo = (int*)(ws + WS_ROWINFO); float* roww = (float*)(ws + WS_ROWW); bf16_t* XG = (bf16_t*)(ws + WS_XG);
    for (int row = gw; row < ML; row += NGW) {
        f32x4 y[4]; ffn_norm_row(a.out + (size_t)row * 1024, gn, modL + (size_t)(row >> 13) * 6144, lane, y);
        u32x2 w[4];
#pragma unroll
        for (int j = 0; j < 4; ++j) { w[j].x = pk2(y[j][0], y[j][1]); w[j].y = pk2(y[j][2], y[j][3]); }
        const u32x4 tk = *(const u32x4*)(ws + WS_TOK + (size_t)row * 16);
#pragma unroll
        for (int k = 0; k < 2; ++k) { const int e = (int)(k ? tk.y : tk.x); const float wt = __uint_as_float(k ? tk.w : tk.z);
            int pe = 0;
#pragma unroll
            for (int q = 0; q < NE; ++q) pe = (q == e) ? pst[q] : pe;
            int slot = 0; if (lane == 0) slot = (int)atomicAdd(ctl + CW_CUR + e, 1u);
            slot = __builtin_amdgcn_readfirstlane(slot);
            const int dest = pe + slot;
            if (lane == 0) { rowinfo[dest] = row * 2 + k; roww[dest] = wt; }
            u32x2* o8 = (u32x2*)(XG + (size_t)dest * 1024) + lane;
#pragma unroll
            for (int j = 0; j < 4; ++j) o8[64 * j] = w[j]; }
    }
}
__device__ __forceinline__ void ph_final(const Args& a, int lane, int wave, int bid, int G) { asm volatile("" : "+v"(lane));
    unsigned char* ws = a.ws; const int gw = bid * 8 + wave, NGW = G * 8;
    const float* modL = (const float*)(ws + WS_MOD) + (size_t)5 * 6144;
    const bf16_t* Y0 = (const bf16_t*)(ws + WS_Y01); const bf16_t* Y1 = Y0 + (size_t)ML * 1024;
    f32x4 gn[4];
#pragma unroll
    for (int j = 0; j < 4; ++j) gn[j] = *(const f32x4*)(a.in[I_NFINAL] + 4 * lane + 256 * j);
    for (int row = gw; row < ML; row += NGW) {
        float* xr = a.out + (size_t)row * 1024; const float* g2 = modL + (size_t)(row >> 13) * 6144 + 5120;
        f32x4 v[4]; float ss = 0.f;
#pragma unroll
        for (int j = 0; j < 4; ++j) { const f32x4 x = *(const f32x4*)(xr + 4 * lane + 256 * j), gg = *(const f32x4*)(g2 + 4 * lane + 256 * j);
            const u32x2 ya = *(const u32x2*)(Y0 + (size_t)row * 1024 + 4 * lane + 256 * j), yb = *(const u32x2*)(Y1 + (size_t)row * 1024 + 4 * lane + 256 * j);
            f32x4 yy; yy[0] = bflo(ya.x) + bflo(yb.x); yy[1] = bfhi(ya.x) + bfhi(yb.x); yy[2] = bflo(ya.y) + bflo(yb.y); yy[3] = bfhi(ya.y) + bfhi(yb.y);
            v[j] = x + gg * yy; ss += (v[j][0] * v[j][0] + v[j][1] * v[j][1]) + (v[j][2] * v[j][2] + v[j][3] * v[j][3]); }
        const float rstd = 1.f / sqrtf(wave_sum(ss) * (1.f / 1024.f) + EPS);
#ifdef DBG_FINAL
        { float so = 0.f; bool nn = false;
#pragma unroll
          for (int j = 0; j < 4; ++j) { const f32x4 o = v[j] * rstd * gn[j];
#pragma unroll
            for (int i = 0; i < 4; ++i) { so += o[i] * o[i]; if (!(o[i] - o[i] == 0.f)) nn = true; } }
          const float sv = wave_sum(ss), so2 = wave_sum(so);
          if (lane == 0) { atomicAdd((float*)(ws + WS_CTL) + 9001, sv); atomicAdd((float*)(ws + WS_CTL) + 9002, so2); }
          if (nn) atomicMax((unsigned*)(ws + WS_CTL) + 9003, 1u); }
#endif
#pragma unroll
        for (int j = 0; j < 4; ++j) { f32x4 o = v[j] * rstd * gn[j];
#ifdef DBG_FINAL
            o = v[j];
#endif
#ifdef DBG_SANITIZE
#pragma unroll
            for (int i = 0; i < 4; ++i) o[i] = (o[i] - o[i] == 0.f) ? o[i] : 0.f;
#endif
            *(f32x4*)(xr + 4 * lane + 256 * j) = o; }
    }
}

#ifndef DIS
#define DIS 0
#endif
#ifndef PH_MASK
#define PH_MASK 0xFFFFFFFFu
#endif
#define IN(k) (((PH_MASK >> ((k) >= 25 ? ((k) == 35 ? 15 : 13 + (((k) - 25) & 1)) : (k) == 0 ? 0 : (((k) - 1) % 12) + 1)) & 1u) && lo <= (k) && (k) < hi)
#define SEAM() do { if (multi) xcd_barrier(bar, wave == 0 && my_lane() == 0); } while (0)
template <int L>
__device__ __forceinline__ void layer_phases(const Args& a, LAS unsigned char* lds, int wave, int bid, int G, int lo, int hi, bool multi, const XcdBarrier& bar, volatile LAS int* qslot) {
    unsigned char* ws = a.ws; unsigned* ctl = (unsigned*)(ws + WS_CTL);
    const int gw = bid * 8 + wave, NGW = G * 8;
    float* MOD = (float*)(ws + WS_MOD);
    bf16_t* Hb = (bf16_t*)(ws + WS_H); bf16_t* Ub = (bf16_t*)(ws + WS_U); bf16_t* YBR = (bf16_t*)(ws + WS_YBR); bf16_t* SG = (bf16_t*)(ws + WS_SG);
    float* XC = (float*)(ws + WS_XC);
        const int LB = 1 + 12 * L;
        const float* modL = MOD + (size_t)L * 5 * 6144;
        const float* xl = L == 0 ? a.in[I_X] : a.out; const float* xc = L == 0 ? a.in[I_CTX] : XC;
        if (IN(LB + 0)) { const int lane = my_lane(), tid = wave * 64 + lane; (void)tid; (void)lane; norm_rows(xl, xc, a.in[I_NMIX] + L * 1024, modL, 0, 1024, Hb, lane, gw, NGW); SEAM(); }
        if (IN(LB + 1)) { const int lane = my_lane(), tid = wave * 64 + lane; (void)tid; (void)lane;
            pg8::Gemm g{Hb, (const bf16_t*)(ws + WS_WNG) + (size_t)L * 2816 * 1024, 1024, 1024, 1024};
            pg8::StaticOrder S; S.init(MT / 256, UT, G, bid);
            pg8::EpiTileBf16 E{Ub, (size_t)MT * 256};
            pg8::gemm_phase(lds, g, S, E, wave); SEAM();
        }
        if (IN(LB + 2)) { const int lane = my_lane(), tid = wave * 64 + lane; (void)tid; (void)lane;
            unsigned* qw = ctl + CW_Q + 64 * (LB + 2);
            for (;;) { const int u = q_next(qw, qslot, tid == 0); if (u >= 256) break; if (!(DIS & 1)) four_stage1_unit(a, u, lane, wave); }
            for (;;) { const int u = q_next(qw + 16, qslot, tid == 0); if (u >= 1056) break; if (!(DIS & 2)) ret_dstate_unit(a, L, u, lds, tid, lane, wave); }
            for (;;) { const int u = q_next(qw + 32, qslot, tid == 0); if (u >= 132) break; if (!(DIS & 4)) mla_prep_wave(a, L, u * 8 + wave, lane); }
            if (L == 0) for (;;) { const int u = q_next(qw + 48, qslot, tid == 0); if (u >= 512) break; if (!(DIS & 8)) cfour_step1_unit(a, u, lds, tid); }
            SEAM();
        }
        if (IN(LB + 3)) { const int lane = my_lane(), tid = wave * 64 + lane; (void)tid; (void)lane; for (int u = bid; u < 256; u += G) ret_scan_unit(a, L, u, tid); SEAM(); }
        if (IN(LB + 4)) { const int lane = my_lane(), tid = wave * 64 + lane; (void)tid; (void)lane;
            unsigned* qw = ctl + CW_Q + 64 * (LB + 4);
            const int nc = L == 0 ? 16 : 0;
            for (;;) { const int u = q_next(qw, qslot, tid == 0); if (u >= 512 + nc) break; mla_unit(a, u, lds, tid, lane, wave); }
            for (;;) { const int u = q_next(qw + 16, qslot, tid == 0); if (u >= 512 + nc) break; na_unit(a, L, u, lds, tid, lane, wave); }
            for (;;) { const int u = q_next(qw + 32, qslot, tid == 0); if (u >= 1024 + 2 * nc) break; ret_out_unit(a, L, u, lds, tid, lane, wave); }
            for (;;) { const int u = q_next(qw + 48, qslot, tid == 0); if (u >= 512) break; four_stage2_unit(a, u, lane, wave); }
            if (L == 0) for (;;) { const int u = q_next(qw + 56, qslot, tid == 0); if (u >= 512) break; cfour_step2_unit(a, u, lds, tid); }
            SEAM();
        }
        const int nMm = L == 0 ? MT / 256 : ML / 256;
        if (IN(LB + 5)) { const int lane = my_lane(), tid = wave * 64 + lane; (void)tid; (void)lane;
            pg8::Gemm g{Hb, (const bf16_t*)(ws + WS_WG) + (size_t)L * 4096 * 1024, 1024, 1024, 1024};
            pg8::StaticOrder S; S.init(nMm, 16, G, bid);
            pg8::EpiSigmoid E{SG, 4096};
            pg8::gemm_phase(lds, g, S, E, wave); SEAM();
        }
        if (IN(LB + 6)) { const int lane = my_lane(), tid = wave * 64 + lane; (void)tid; (void)lane;
            pg8::Gemm g{YBR, (const bf16_t*)(ws + WS_WB) + (size_t)L * 4 * 1024 * 256, 1024, 256, 256};
            pg8::MergeOrder S; S.so.init(nMm, 4, G, bid);
            pg8::EpiMerge E{SG, Hb, (f32x4*)(ws + WS_MSCR) + (size_t)bid * 16384};
            pg8::gemm_phase(lds, g, S, E, wave); SEAM();
        }
        if (IN(LB + 7)) { const int lane = my_lane(), tid = wave * 64 + lane; (void)tid; (void)lane;
            pg8::Gemm g{Hb, (const bf16_t*)(ws + WS_WO) + (size_t)L * 1024 * 1024, 1024, 1024, 1024};
            pg8::StaticOrder S; S.init(nMm, 4, G, bid);
            pg8::EpiResid E{xl, xc, a.out, XC, modL + 2048};
            pg8::gemm_phase(lds, g, S, E, wave); SEAM();
        }
        if (L == 0) {
            if (IN(LB + 8)) { const int lane = my_lane(), tid = wave * 64 + lane; (void)tid; (void)lane; norm_rows(a.out, XC, a.in[I_NFFN], modL, 3072, 4096, Hb, lane, gw, NGW); SEAM(); }
            if (IN(LB + 9)) { const int lane = my_lane(), tid = wave * 64 + lane; (void)tid; (void)lane;
                pg8::Gemm g{Hb, (const bf16_t*)(ws + WS_WGU), 1024, 1024, 1024};
                pg8::StaticOrder S; S.init(MT / 256, 22, G, bid);
                pg8::EpiSwiGLU E{(bf16_t*)(ws + WS_HID), FF, 0};
                pg8::gemm_phase(lds, g, S, E, wave); SEAM();
            }
            if (IN(LB + 10)) { const int lane = my_lane(), tid = wave * 64 + lane; (void)tid; (void)lane;
                pg8::Gemm g{(const bf16_t*)(ws + WS_HID), (const bf16_t*)(ws + WS_WD), FF, FF, FF};
                pg8::StaticOrder S; S.init(MT / 256, 4, G, bid);
                pg8::EpiResid E{a.out, XC, a.out, XC, modL + 5120};
                pg8::gemm_phase(lds, g, S, E, wave); SEAM();
            }
        } else {
            if (IN(LB + 8)) { const int lane = my_lane(), tid = wave * 64 + lane; (void)tid; (void)lane; ph_route(a, lds, tid, lane, wave, bid, G); SEAM(); }
            if (IN(LB + 9)) { const int lane = my_lane(), tid = wave * 64 + lane; (void)tid; (void)lane; ph_place(a, tid, lane, wave, bid, G); SEAM(); }
        }
    }

constexpr int NPH = 36;
__global__ void __launch_bounds__(512, 2) mega(Args a) {
    extern __shared__ __attribute__((aligned(16))) unsigned char lds_raw[];
    LAS unsigned char* lds = (LAS unsigned char*)lds_raw;
    const int wave = __builtin_amdgcn_readfirstlane(threadIdx.x >> 6), bid = blockIdx.x, G = gridDim.x;
    unsigned char* ws = a.ws; unsigned* ctl = (unsigned*)(ws + WS_CTL);
    volatile LAS unsigned* misc = (volatile LAS unsigned*)(lds + LDS_MISC);
    volatile LAS int* qslot = (volatile LAS int*)(lds + LDS_MISC + 64);
    const int lo = a.ph_lo, hi = a.ph_hi; const bool multi = (hi - lo) > 1;
    if (threadIdx.x < 32) misc[threadIdx.x] = 0u;
    __syncthreads();
    XcdBarrier bar; bar.bar = ctl + CW_BAR; bar.x = 0; bar.st = misc;
    if (multi) bar = xcd_barrier_post(ctl + CW_BAR, misc, threadIdx.x == 0);

    const int gw = bid * 8 + wave, NGW = G * 8;
    float* MOD = (float*)(ws + WS_MOD);
    bf16_t* Hb = (bf16_t*)(ws + WS_H); bf16_t* Ub = (bf16_t*)(ws + WS_U); bf16_t* YBR = (bf16_t*)(ws + WS_YBR); bf16_t* SG = (bf16_t*)(ws + WS_SG);
    float* XC = (float*)(ws + WS_XC);

    if (IN(0)) { const int lane = my_lane(), tid = wave * 64 + lane; (void)tid; (void)lane; ph_prologue(a, lds, tid, lane, wave, bid, G); SEAM(); }

    layer_phases<0>(a, lds, wave, bid, G, lo, hi, multi, bar, qslot);
    layer_phases<1>(a, lds, wave, bid, G, lo, hi, multi, bar, qslot);
    for (int c = 0; c < 5; ++c) {
        if (IN(25 + 2 * c) || IN(26 + 2 * c)) {
            int pst[NE], ntiles; moe_offsets(ctl + CW_CNT, pst, ntiles);
            const int c0 = 64 * c; int ntc = ntiles - c0; ntc = ntc > 64 ? 64 : ntc;
            if (IN(25 + 2 * c)) { const int lane = my_lane(), tid = wave * 64 + lane; (void)tid; (void)lane;
                if (ntc > 0) {
                    pg8::Gemm g{(const bf16_t*)(ws + WS_XG), (const bf16_t*)(ws + WS_MWGU), 1024, 1024, 1024};
                    pg8::MoeOrder S{c0, ntc, 28, G, bid, (const int*)(ws + WS_TILEE), (long)7168 * 1024 * 2};
                    pg8::EpiSwiGLU E{(bf16_t*)(ws + WS_HIDM), MF, c0 * 256};
                    pg8::gemm_phase(lds, g, S, E, wave);
                }
                SEAM();
            }
            if (IN(26 + 2 * c)) { const int lane = my_lane(), tid = wave * 64 + lane; (void)tid; (void)lane;
                if (ntc > 0) {
                    pg8::Gemm g{(const bf16_t*)(ws + WS_HIDM) - (size_t)c0 * 256 * MF, (const bf16_t*)(ws + WS_MWD), MF, MF, MF};
                    pg8::MoeOrder S{c0, ntc, 4, G, bid, (const int*)(ws + WS_TILEE), (long)1024 * MF * 2};
                    pg8::EpiMoeDown E{(const int*)(ws + WS_ROWINFO), (const float*)(ws + WS_ROWW), (bf16_t*)(ws + WS_Y01)};
                    pg8::gemm_phase(lds, g, S, E, wave);
                }
                SEAM();
            }
        }
    }
    if (IN(35)) { const int lane = my_lane(); ph_final(a, lane, wave, bid, G); }
#undef IN
#undef SEAM
}


#ifdef DBG_SCAN
constexpr int CW_DBG = 9000;
__global__ void dbg_scan(const void* p, size_t n, int flags, int code, unsigned* ctl) { const int is_bf16 = flags & 1; const unsigned te = 127u + (unsigned)(flags >> 8);
    size_t i = (size_t)blockIdx.x * blockDim.x + threadIdx.x, st = (size_t)gridDim.x * blockDim.x; bool bad = false;
    if (is_bf16) { const unsigned short* q = (const unsigned short*)p; for (; i < n; i += st) { const unsigned v = q[i]; if (((v >> 7) & 0xffu) >= te) bad = true; } }
    else { const unsigned* q = (const unsigned*)p; for (; i < n; i += st) { const unsigned v = q[i]; if (((v >> 23) & 0xffu) >= te) bad = true; } }
    if (bad) atomicMax(ctl + CW_DBG, (unsigned)(1000 - code));
}
__global__ void dbg_scan2(const unsigned short* p, int rows, int ld, int c0, int nc, int code, unsigned* ctl) {
    size_t i = (size_t)blockIdx.x * blockDim.x + threadIdx.x, st = (size_t)gridDim.x * blockDim.x; bool bad = false;
    for (; i < (size_t)rows * nc; i += st) { const unsigned v = p[(i / nc) * ld + c0 + (i % nc)]; if (((v >> 7) & 0xffu) >= 127u + 6u) bad = true; }
    if (bad) atomicMax(ctl + CW_DBG, (unsigned)(1000 - code));
}
__global__ void dbg_delta(const float* a, const float* b, size_t n, int slot, unsigned* ctl) {
    size_t i = (size_t)blockIdx.x * blockDim.x + threadIdx.x, st = (size_t)gridDim.x * blockDim.x; float d = 0.f, r = 0.f;
    for (; i < n; i += st) { const float x = a[i], y = b[i]; d += (x - y) * (x - y); r += y * y; }
    for (int o = 32; o >= 1; o >>= 1) { d += __shfl_xor(d, o); r += __shfl_xor(r, o); }
    if ((threadIdx.x & 63) == 0) { atomicAdd((float*)ctl + 9010 + 2 * slot, d); atomicAdd((float*)ctl + 9011 + 2 * slot, r); }
}
__device__ int dbg_digit(float d, float r) { const float q = d / r; if (!(q == q)) return 9; int k = (int)rintf(-log2f(q)); return k < 0 ? 0 : (k > 8 ? 8 : k); }
__global__ void dbg_emit2(float* out, const unsigned* ctl, int s0, int s1) { const float* cf = (const float*)ctl;
    const int A = dbg_digit(cf[9010 + 2 * s0], cf[9011 + 2 * s0]), B = dbg_digit(cf[9010 + 2 * s1], cf[9011 + 2 * s1]); out[0] = sqrtf(33554432.f * (float)(10 * A + B)); }
__global__ void dbg_emit(float* out, const unsigned* ctl) { const float* cf = (const float*)ctl; const float msv = cf[9001] / 33554432.f, mso = cf[9002] / 33554432.f;
    int A = (int)rintf(log2f(msv)) + 4; A = A < 0 ? 0 : (A > 8 ? 8 : A); int B = (int)rintf(log2f(mso)) + 4; B = B < 0 ? 0 : (B > 8 ? 8 : B); if (ctl[9003]) B = 9;
    out[0] = sqrtf(33554432.f * (float)(10 * A + B)); }
#endif
extern "C" void kernel_launch(void* const* d_in, const int* in_sizes, int n_in, void* d_out, int out_size, void* d_ws, size_t ws_size, hipStream_t stream) {
    static int grid = 0;
    if (grid == 0) {
        if (n_in != 26 || in_sizes[0] != ML * DM || out_size != ML * DM || ws_size < WS_NEED) { fprintf(stderr, "kernel_launch: unexpected problem (n_in %d, ws %zu, need %zu)\n", n_in, ws_size, (size_t)WS_NEED); grid = -1; return; }
        int dev = 0, cus = 0, per_cu = 0;
        if (hipGetDevice(&dev) != hipSuccess || hipDeviceGetAttribute(&cus, hipDeviceAttributeMultiprocessorCount, dev) != hipSuccess) { grid = -1; return; }
        if (hipFuncSetAttribute((const void*)mega, hipFuncAttributeMaxDynamicSharedMemorySize, LDS_BYTES) != hipSuccess) { fprintf(stderr, "kernel_launch: hipFuncSetAttribute failed\n"); grid = -1; return; }
        if (hipOccupancyMaxActiveBlocksPerMultiprocessor(&per_cu, (const void*)mega, 512, LDS_BYTES) != hipSuccess || per_cu < 1) fprintf(stderr, "kernel_launch: occupancy query says %d\n", per_cu);
        (void)hipGetLastError();
        grid = cus;
    }
    if (grid < 0) return;
    if (hipMemsetAsync((char*)d_ws + WS_CTL, 0, 1 * MiB, stream) != hipSuccess) return;
    Args a{};
    for (int i = 0; i < 26; ++i) a.in[i] = (const float*)d_in[i];
    a.out = (float*)d_out; a.ws = (unsigned char*)d_ws;
#if N_LAUNCH_MODE == 1
    a.ph_lo = 0; a.ph_hi = NPH;
    hipLaunchKernelGGL(mega, dim3(grid), dim3(512), LDS_BYTES, stream, a);
#else
    for (int p = 0; p < NPH; ++p) {
        if (p == 12 || p == 23 || p == 24) continue;
        a.ph_lo = p; a.ph_hi = p + 1;
        hipLaunchKernelGGL(mega, dim3(grid), dim3(512), LDS_BYTES, stream, a);
#ifdef DBG_SCAN
        {
            unsigned char* ws = (unsigned char*)d_ws; unsigned* ctl = (unsigned*)(ws + WS_CTL);
#define SCAN(ptr, n, bf, code) SCANT(ptr, n, bf, code, 6)
#define SCANT(ptr, n, bf, code, TE) hipLaunchKernelGGL(dbg_scan, dim3(1024), dim3(256), 0, stream, (const void*)(ptr), (size_t)(n), (bf) | ((TE) << 8), code, ctl)
            const int L = p >= 13 ? 1 : 0, k = p == 0 ? -1 : (p - 1) % 12; const int cb = 1 + (p == 0 ? 0 : 4 + L * 40 + k * 3);
            const size_t nm = (L == 0 ? MT : ML);
            if (p == 0) { SCAN(ws + WS_MOD, 2 * 5 * 6144, 0, 1); SCAN(ws + WS_ROPER, 8192 * 64 + 8192 * 32, 0, 2); SCAN(ws + WS_WNG, (WS_RWEND - WS_WNG) / 2, 1, 3); SCAN(ws + WS_M1, 256 * 128, 1, 4); SCAN(ws + WS_WUQ, 2 * 384 * 192, 1, 4); SCAN(ws + WS_WUKV, 2 * 512 * 128, 1, 4); }
            else if (p < 25) {
                if (k == 0) SCAN(ws + WS_H, (size_t)MT * 1024, 1, cb);
                if (k == 1) SCAN(ws + WS_U, (size_t)UT * MT * 256, 1, cb);
                if (k == 2) { SCANT(ws + WS_A2, (size_t)4 * 64 * 128 * 256 * 2, 1, cb, 14); SCANT(ws + WS_ST, (size_t)2 * 16 * 66 * 4096, 0, cb + 1, 14); SCAN(ws + WS_MK, (size_t)16 * 8448 * 96 + (size_t)16 * 64 * 8448, 1, cb + 2); SCAN(ws + WS_MQ, (size_t)16 * 8192 * 96, 1, cb + 2); }
                if (k == 3) SCANT(ws + WS_ST, (size_t)2 * 16 * 64 * 4096, 0, cb, 14);
                if (k == 4) { for (int r4 = 0; r4 < 4; ++r4) { hipLaunchKernelGGL(dbg_scan2, dim3(1024), dim3(256), 0, stream, (const unsigned short*)(ws + WS_YBR), ML, 1024, r4 * 256, 256, (L == 0 ? 15 : 55) + r4, ctl); if (L == 0) hipLaunchKernelGGL(dbg_scan2, dim3(1024), dim3(256), 0, stream, (const unsigned short*)(ws + WS_YBR) + (size_t)ML * 1024, MC, 1024, r4 * 256, 256, 19, ctl); } }
                if (k == 5) SCAN(ws + WS_SG, nm * 4096, 1, cb);
                if (k == 6) SCAN(ws + WS_H, nm * 1024, 1, cb);
                if (k == 7) { SCAN(d_out, (size_t)ML * 1024, 0, cb); if (L == 0) SCAN(ws + WS_XC, (size_t)MC * 1024, 0, cb + 1); }
                if (k == 8 && L == 0) SCAN(ws + WS_H, (size_t)MT * 1024, 1, cb);
                if (k == 9 && L == 0) SCAN(ws + WS_HID, (size_t)MT * FF, 1, cb);
                if (k == 10 && L == 0) { SCAN(d_out, (size_t)ML * 1024, 0, cb); SCAN(ws + WS_XC, (size_t)MC * 1024, 0, cb + 1); }
            } else if (p == 34) SCAN(ws + WS_Y01, (size_t)2 * ML * 1024, 1, 95);
            if (p == 8) hipLaunchKernelGGL(dbg_delta, dim3(1024), dim3(256), 0, stream, (const float*)d_out, (const float*)d_in[0], (size_t)ML * 1024, 0, ctl);
            if (p == 11) hipLaunchKernelGGL(dbg_delta, dim3(1024), dim3(256), 0, stream, (const float*)d_out, (const float*)d_in[0], (size_t)ML * 1024, 1, ctl);
            if (p == 20) hipLaunchKernelGGL(dbg_delta, dim3(1024), dim3(256), 0, stream, (const float*)d_out, (const float*)d_in[0], (size_t)ML * 1024, 2, ctl);
            if (p == 35) { hipLaunchKernelGGL(dbg_delta, dim3(1024), dim3(256), 0, stream, (const float*)d_out, (const float*)d_in[0], (size_t)ML * 1024, 3, ctl); hipMemsetAsync(d_out, 0, (size_t)ML * 1024 * 4, stream); }
            if (p == 35) hipLaunchKernelGGL(dbg_emit2, dim3(1), dim3(1), 0, stream, (float*)d_out, (const unsigned*)ctl, DBG_S0, DBG_S1);
        }
#endif
    }
#endif
}
```

```cpp
#include <hip/hip_runtime.h>
#include <stdint.h>
#include <stdio.h>

#define LAS __attribute__((address_space(3)))
typedef unsigned short bf16_t;
typedef short bf16x8 __attribute__((ext_vector_type(8)));
typedef float f32x2 __attribute__((ext_vector_type(2)));
typedef float f32x4 __attribute__((ext_vector_type(4)));
typedef float f32x16 __attribute__((ext_vector_type(16)));
typedef unsigned u32x2 __attribute__((ext_vector_type(2)));
typedef unsigned u32x4 __attribute__((ext_vector_type(4)));

#define DBG_S0 2
#define DBG_S1 3
#ifndef DUP_UMASK
#define DUP_UMASK 0
#endif
#ifndef N_LAUNCH_MODE
#define N_LAUNCH_MODE 1
#endif

constexpr int NB = 4, SEQ = 8192, DM = 1024, CTXL = 256;
constexpr int ML = NB * SEQ, MC = NB * CTXL, MT = ML + MC;
constexpr int INC = 6752;
constexpr int UT = 11;
constexpr int FF = 2816, MF = 3584, NE = 8;
constexpr int NRMAX = 65536 + 2048;
constexpr float EPS = 1e-6f;
constexpr float LOG2E = 1.4426950408889634f;

constexpr size_t MiB = 1u << 20;
constexpr size_t WS_CTL = 0;
constexpr size_t WS_MOD = 1 * MiB;
constexpr size_t WS_ROPER = WS_MOD + 256 * 1024;
constexpr size_t WS_ROPEM = WS_ROPER + 2 * MiB;
constexpr size_t WS_M1 = WS_ROPEM + 1 * MiB;
constexpr size_t WS_TW = WS_M1 + 64 * 1024;
constexpr size_t WS_D2 = WS_TW + 64 * 1024;
constexpr size_t WS_EP = WS_D2 + 32 * 1024;
constexpr size_t WS_XC = WS_EP + 16 * 1024;
constexpr size_t WS_CPQ = WS_XC + 4 * MiB;
constexpr size_t WS_WUQ = WS_CPQ + 2 * MiB;
constexpr size_t WS_WUKV = WS_WUQ + 512 * 1024;
constexpr size_t WS_ROWINFO = WS_WUKV + 512 * 1024;
constexpr size_t WS_ROWW = WS_ROWINFO + 512 * 1024;
constexpr size_t WS_TOK = WS_ROWW + 512 * 1024;
constexpr size_t WS_TILEE = WS_TOK + 512 * 1024;
constexpr size_t WS_WGCNT = WS_TILEE + 4096;
constexpr size_t WS_R0END = 16 * MiB;
static_assert(WS_WGCNT + 16384 <= WS_R0END, "R0");
constexpr size_t WS_WNG = WS_R0END;
constexpr size_t WS_WG = WS_WNG + (size_t)2 * 2816 * 1024 * 2;
constexpr size_t WS_WB = WS_WG + (size_t)2 * 4096 * 1024 * 2;
constexpr size_t WS_WO = WS_WB + (size_t)2 * 4 * 1024 * 256 * 2;
constexpr size_t WS_WGU = WS_WO + (size_t)2 * 1024 * 1024 * 2;
constexpr size_t WS_WD = WS_WGU + (size_t)5632 * 1024 * 2;
constexpr size_t WS_RWEND = WS_WD + (size_t)1024 * 2816 * 2;
constexpr size_t WS_H = WS_RWEND;
constexpr size_t WS_YBR = WS_H + (size_t)MT * 1024 * 2;
constexpr size_t WS_MSCR = WS_YBR + (size_t)MT * 1024 * 2;
constexpr size_t WS_H8 = WS_MSCR;
constexpr size_t WS_WG8 = WS_H8 + (size_t)MT * 1024;
static_assert(WS_WG8 + (size_t)2 * 4096 * 1024 <= WS_MSCR + (size_t)256 * 262144, "fp8 region");
constexpr size_t WS_BIG = WS_MSCR + (size_t)256 * 262144;
constexpr size_t WS_U = WS_BIG;
constexpr size_t WS_ST = WS_U + (size_t)UT * MT * 256 * 2;
constexpr size_t WS_STC = WS_ST + (size_t)2 * 16 * 64 * 4096 * 4;
constexpr size_t WS_A2 = WS_STC + (size_t)2 * 16 * 2 * 4096 * 4;
constexpr size_t WS_MQ = WS_A2 + (size_t)4 * 64 * 128 * 256 * 4;
constexpr size_t WS_MQC = WS_MQ + (size_t)16 * 8192 * 96 * 2;
constexpr size_t WS_MK = WS_MQC + (size_t)16 * 256 * 96 * 2;
constexpr size_t WS_MVT = WS_MK + (size_t)16 * 8448 * 104 * 2;
constexpr size_t WS_NVT = WS_MVT + (size_t)16 * 132 * 64 * 72 * 2;
constexpr size_t WS_BIGEND = WS_NVT + (size_t)16 * 64 * 8448 * 2;
constexpr size_t WS_SG = WS_BIG;
constexpr size_t WS_HID = WS_BIG;
static_assert(WS_SG + (size_t)MT * 4096 * 2 <= WS_BIGEND, "SG overlay");
constexpr size_t WS_MWGU = WS_R0END;
constexpr size_t WS_MWD = WS_MWGU + (size_t)8 * 7168 * 1024 * 2;
constexpr size_t WS_XG = WS_MWD + (size_t)8 * 1024 * 3584 * 2;
constexpr size_t WS_HIDM = WS_XG + (size_t)NRMAX * 1024 * 2;
constexpr size_t WS_Y01 = WS_HIDM + (size_t)72 * 256 * 3584 * 2;
constexpr size_t WS_MOEEND = WS_Y01 + (size_t)2 * ML * 1024 * 2;
constexpr size_t WS_NEED = WS_BIGEND > WS_MOEEND ? WS_BIGEND : WS_MOEEND;

constexpr int CW_BAR = 0, CW_Q = 16384, CW_CNT = 8192, CW_CUR = 8256;

constexpr int LDS_BYTES = 147456;
constexpr int LDS_MISC = 143360;

__device__ __forceinline__ float bf2f(unsigned h) { return __uint_as_float(h << 16); }
__device__ __forceinline__ float bflo(unsigned w) { return __uint_as_float(w << 16); }
__device__ __forceinline__ float bfhi(unsigned w) { return __uint_as_float(w & 0xffff0000u); }
typedef __bf16 bf16x2_t __attribute__((ext_vector_type(2)));
__device__ __forceinline__ unsigned pk2(float lo, float hi) { f32x2 v = {lo, hi}; bf16x2_t b = __builtin_convertvector(v, bf16x2_t); return __builtin_bit_cast(unsigned, b); }
__device__ __forceinline__ unsigned f2bf(float f) { return pk2(f, 0.f) & 0xffffu; }
__device__ __forceinline__ unsigned pk4_fp8(float a, float b, float c, float d) { int w = __builtin_amdgcn_cvt_pk_fp8_f32(a, b, 0, false); w = __builtin_amdgcn_cvt_pk_fp8_f32(c, d, w, true); return (unsigned)w; }
template <int CTRL> __device__ __forceinline__ float dppf(float x) { return __builtin_bit_cast(float, __builtin_amdgcn_mov_dpp(__builtin_bit_cast(int, x), CTRL, 0xf, 0xf, true)); }
__device__ __forceinline__ float xhalf_sum(float x) { auto t = __builtin_amdgcn_permlane32_swap(__float_as_uint(x), __float_as_uint(x), false, false); return __uint_as_float(t[0]) + __uint_as_float(t[1]); }
__device__ __forceinline__ float xhalf_max(float x) { auto t = __builtin_amdgcn_permlane32_swap(__float_as_uint(x), __float_as_uint(x), false, false); return fmaxf(__uint_as_float(t[0]), __uint_as_float(t[1])); }
__device__ __forceinline__ float wave_sum(float v) {
    v += dppf<0xB1>(v); v += dppf<0x4E>(v);
    v += dppf<0x141>(v); v += dppf<0x128>(v);
    auto s = __builtin_amdgcn_permlane16_swap(__float_as_uint(v), __float_as_uint(v), false, false); v = __uint_as_float(s[0]) + __uint_as_float(s[1]);
    return xhalf_sum(v);
}
__device__ __forceinline__ float fexp2(float x) { return __builtin_amdgcn_exp2f(x); }
__device__ __forceinline__ float siluf(float x) { return x * __builtin_amdgcn_rcpf(1.f + __expf(-x)); }
__device__ __forceinline__ int crow(int r, int hi) { return (r & 3) + 8 * (r >> 2) + 4 * hi; }
__device__ __forceinline__ f32x16 mfma32(bf16x8 a, bf16x8 b, f32x16 c) { return __builtin_amdgcn_mfma_f32_32x32x16_bf16(a, b, c, 0, 0, 0); }
__device__ __forceinline__ f32x16 zero16() { f32x16 z;
#pragma unroll
    for (int i = 0; i < 16; ++i) z[i] = 0.f;
    return z; }
__device__ __forceinline__ bf16x8 as_bf16x8(u32x4 w) { return __builtin_bit_cast(bf16x8, w); }
#define LDS_WAIT() asm volatile("s_waitcnt lgkmcnt(0)" ::: "memory")
__device__ __forceinline__ int my_lane() { int l; asm volatile("v_mbcnt_lo_u32_b32 %0, -1, 0\n\tv_mbcnt_hi_u32_b32 %0, -1, %0" : "=v"(l)); return l; }

#define XB_TMO      128
#define XB_XCNT(j)  (256  + 64 * (j))
#define XB_XSUB(j)  (1280 + 64 * (j))
#define XB_XGEN(j)  (2304 + 64 * (j))
#define XB_TOP      3328
#define XB_TOPGEN   3392
#define XCD_BAR_WORDS 3456
#define XB_SPIN_CAP (1u << 22)
__device__ __forceinline__ unsigned xb_ld(unsigned* p)              { return __hip_atomic_load(p, __ATOMIC_RELAXED, __HIP_MEMORY_SCOPE_AGENT); }
__device__ __forceinline__ unsigned xb_add(unsigned* p, unsigned v) { return __hip_atomic_fetch_add(p, v, __ATOMIC_RELAXED, __HIP_MEMORY_SCOPE_AGENT); }
__device__ __forceinline__ unsigned xb_xcc_id() { return (unsigned)__builtin_amdgcn_s_getreg((3 << 11) | 20) & 0xFu; }
#define XB_SPIN(cond, bar) do { unsigned _sp = 0; while (cond) { __builtin_amdgcn_s_sleep(1); \
    if ((++_sp & 255u) == 0u) { if (xb_ld(&(bar)[XB_TMO])) break; if (_sp > XB_SPIN_CAP) { atomicAdd(&(bar)[XB_TMO], 1u); break; } } } } while (0)
struct XcdBarrier { unsigned* bar; unsigned x; volatile LAS unsigned* st; };
__device__ __forceinline__ XcdBarrier xcd_barrier_post(unsigned* bar, volatile LAS unsigned* st, bool leader) {
    XcdBarrier b; b.bar = bar; b.x = xb_xcc_id(); b.st = st;
    if (leader) (void)xb_add(&bar[XB_XCNT(b.x)], 1u);
    return b;
}
__device__ __forceinline__ void xcd_barrier_complete(unsigned* bar, unsigned x, unsigned& nloc, unsigned& nx) {
    const unsigned G = gridDim.x * gridDim.y * gridDim.z;
    unsigned sum, cnt, mine, sp = 0u;
    for (;;) {
        sum = 0u; cnt = 0u; mine = 0u;
#pragma unroll
        for (unsigned j = 0; j < 16; ++j) { const unsigned c = xb_ld(&bar[XB_XCNT(j)]); sum += c; cnt += (c > 0u) ? 1u : 0u; mine = (j == x) ? c : mine; }
        if (sum == G) break;
        __builtin_amdgcn_s_sleep(1);
        if ((++sp & 255u) == 0u) { if (xb_ld(&bar[XB_TMO])) break; if (sp > XB_SPIN_CAP) { atomicAdd(&bar[XB_TMO], 1u); break; } }
    }
    nloc = mine > 0u ? mine : 1u; nx = cnt > 0u ? cnt : 1u;
}
__device__ __forceinline__ void xcd_barrier(const XcdBarrier& b, bool leader) {
    asm volatile("s_waitcnt vmcnt(0)" ::: "memory");
    __syncthreads();
    if (leader) {
        unsigned* bar = b.bar;
        __builtin_amdgcn_s_waitcnt(0);
        unsigned nloc = b.st[0], nx = b.st[1];
        if (nloc == 0u) { xcd_barrier_complete(bar, b.x, nloc, nx); b.st[0] = nloc; b.st[1] = nx; }
        const unsigned old = xb_add(&bar[XB_XSUB(b.x)], 1u);
        const unsigned gen = old / nloc;
        if (old + 1u == (gen + 1u) * nloc) {
            __builtin_amdgcn_fence(__ATOMIC_RELEASE, "agent");
            asm volatile("s_waitcnt vmcnt(0)" ::: "memory");
            const unsigned og = xb_add(&bar[XB_TOP], 1u);
            const unsigned tg = og / nx;
            if (og + 1u == (tg + 1u) * nx) xb_add(&bar[XB_TOPGEN], 1u);
            else XB_SPIN(xb_ld(&bar[XB_TOPGEN]) == tg, bar);
            __builtin_amdgcn_fence(__ATOMIC_ACQUIRE, "agent");
            xb_add(&bar[XB_XGEN(b.x)], 1u);
            asm volatile("s_waitcnt vmcnt(0)" ::: "memory");
        } else {
            XB_SPIN(xb_ld(&bar[XB_XGEN(b.x)]) == gen, bar);
            __builtin_amdgcn_fence(__ATOMIC_ACQUIRE, "agent");
            asm volatile("s_waitcnt vmcnt(0)" ::: "memory");
        }
    }
    __syncthreads();
}

namespace pg8 {
constexpr int BM = 256, BK = 64, HALF = 128, HTB = HALF * BK * 2, STAGE_BYTES = 8 * HTB, NXCD = 8, WGM = 8;
__host__ __device__ __forceinline__ int lds_byte(int r, int c) { const int st = (r >> 4) * 2 + (c >> 5), rr = r & 15, cc = c & 31, ob = rr * 64 + cc * 2; return st * 1024 + (ob ^ (((ob >> 9) & 1) << 5)); }
__host__ __device__ __forceinline__ void stage_rc(int b, int& R, int& C) { const int st = b / 1024, sb = b % 1024, swz = sb ^ (((sb >> 9) & 1) << 5); R = (st >> 1) * 16 + swz / 64; C = (st & 1) * 32 + (swz % 64) / 2; }
__host__ __device__ __forceinline__ int perm32(int rho) { const int n = rho >> 4, i = rho & 15; return 8 * (i >> 2) + 4 * n + (i & 3); }

struct Unit { int pm, pn, aux; int aofs, bofs; };
struct Gemm { const bf16_t* A; const bf16_t* Bt; int lda, ldb, K; };

struct StaticOrder {
    int nM, nN, nwg, G, c;
    __device__ void init(int nM_, int nN_, int G_, int c_) { nM = nM_; nN = nN_; nwg = nM * nN; G = G_; c = c_; }
    __device__ bool next(int i, Unit& u) const {
        const long L = (long)i * G + c; if (L >= nwg) return false;
        int wgid = (int)L; { const int q = nwg / NXCD, r = nwg % NXCD, xcd = wgid % NXCD, off = wgid / NXCD; wgid = (xcd < r ? xcd * (q + 1) : r * (q + 1) + (xcd - r) * q) + off; }
        const int nig = WGM * nN, gid = wgid / nig, fm = gid * WGM, gsz = (nM - fm) < WGM ? (nM - fm) : WGM;
        u.pm = fm + ((wgid % nig) % gsz); u.pn = (wgid % nig) / gsz; u.aux = 0; u.aofs = 0; u.bofs = 0; return true;
    }
};
struct TableOrder {
    const LAS int* tab; int n;
    __device__ bool next(int i, Unit& u) const { if (i >= n) return false; u.pm = __builtin_amdgcn_readfirstlane(tab[2 * i]); u.pn = __builtin_amdgcn_readfirstlane(tab[2 * i + 1]); u.aux = 0; u.aofs = 0; u.bofs = 0; return true; }
};
struct MergeOrder {
    StaticOrder so;
    __device__ bool next(int i, Unit& u) const { if (!so.next(i >> 2, u)) return false; const int s = i & 3; u.aux = s; u.aofs = s * 256 * 2; u.bofs = s * 1024 * 256 * 2; return true; }
};
struct MoeOrder {
    int c0, lg, nN, G, c; const int* tile_e; int bstride;
    __device__ bool next(int i, Unit& u) const {
        const int L = i * G + c; if (L >= (nN << lg)) return false;
        u.pm = __builtin_amdgcn_readfirstlane(c0 + (L & ((1 << lg) - 1))); u.pn = __builtin_amdgcn_readfirstlane(L >> lg); u.aux = 0; u.aofs = 0;
        int e = __builtin_amdgcn_readfirstlane(tile_e[u.pm]); e = e < 0 ? 0 : e; u.bofs = e * bstride; return true;
    }
};

typedef int i32x8 __attribute__((ext_vector_type(8)));
template <class Epi, class Sched, bool F8 = false>
__device__ __forceinline__ void gemm_phase(LAS unsigned char* lds, const Gemm g, const Sched& S, const Epi& E, int wid) {
    const int lane = my_lane(), tid = wid * 64 + lane;
    const int wr = wid >> 2, wc = wid & 3, fr = lane & 15, fq = lane >> 4;
    const int K = g.K, nt = K / BK;
    unsigned v_offA, v_offB;
    { int R, C; stage_rc(tid * 16, R, C); const int Rb = Epi::PERM ? ((R & ~31) + perm32(R & 31)) : R;
        v_offA = (unsigned)(R * g.lda + C) * 2u; v_offB = (unsigned)(Rb * g.ldb + C) * 2u; }
    const unsigned rstep_offA = 64u * g.lda * 2u, rstep_offB = 64u * g.ldb * 2u;
    const unsigned kstep = (unsigned)(BK * 2);
    const unsigned hstepA = (unsigned)HALF * g.lda * 2u, hstepB = (unsigned)HALF * g.ldb * 2u;
    const unsigned tstepA = 2u * hstepA, tstepB = 2u * hstepB;
    const unsigned ldsw = (unsigned)wid * 1024u;
    const __amdgpu_buffer_rsrc_t rs_offA = __builtin_amdgcn_make_buffer_rsrc((void*)g.A, 0, 0x7fffffff, 0x00020000), rs_offB = __builtin_amdgcn_make_buffer_rsrc((void*)g.Bt, 0, 0x7fffffff, 0x00020000);
    const int aoff = lds_byte(wr * 64 + fr, F8 ? fq * 16 : fq * 8), boff = lds_byte(wc * 32 + fr, F8 ? fq * 16 : fq * 8);
#define PG8_SA(b, h) (((b) * 2 + (h)) * HTB)
#define PG8_SB(b, h) ((4 + (b) * 2 + (h)) * HTB)
#define PG8_STAGE(bufoff, gbase, voff) do { _Pragma("unroll") for (int _i = 0; _i < 2; ++_i) \
        __builtin_amdgcn_raw_ptr_buffer_load_lds(rs_##voff, (LAS void*)(lds + (bufoff) + ldsw + _i * 8192), 16, (int)(v_##voff), (int)((gbase) + _i * rstep_##voff), 0, 0); } while (0)
#define PG8_LD8(p) ({ const u32x4 lo_ = *(const LAS u32x4*)(p), hi_ = *(const LAS u32x4*)((p) + 16); (i32x8){(int)lo_.x, (int)lo_.y, (int)lo_.z, (int)lo_.w, (int)hi_.x, (int)hi_.y, (int)hi_.z, (int)hi_.w}; })
#define PG8_LDA(dst, b, h) do { if constexpr (F8) { _Pragma("unroll") for (int m = 0; m < 4; ++m) dst##8[m] = PG8_LD8(lds + PG8_SA(b, h) + aoff + m * 2048); } \
        else { _Pragma("unroll") for (int m = 0; m < 4; ++m) _Pragma("unroll") for (int k = 0; k < 2; ++k) dst[m][k] = *(const LAS bf16x8*)(lds + PG8_SA(b, h) + aoff + m * 2048 + k * 1024); } } while (0)
#define PG8_LDB(dst, b, h) do { if constexpr (F8) { _Pragma("unroll") for (int n = 0; n < 2; ++n) dst##8[n] = PG8_LD8(lds + PG8_SB(b, h) + boff + n * 2048); } \
        else { _Pragma("unroll") for (int n = 0; n < 2; ++n) _Pragma("unroll") for (int k = 0; k < 2; ++k) dst[n][k] = *(const LAS bf16x8*)(lds + PG8_SB(b, h) + boff + n * 2048 + k * 1024); } } while (0)
#define PG8_MMA_(ai, bj, At, Bt, ZC) do { \
        if constexpr (F8) { _Pragma("unroll") for (int m = 0; m < 4; ++m) _Pragma("unroll") for (int n = 0; n < 2; ++n) \
            acc[ai][bj][m][n] = __builtin_amdgcn_mfma_scale_f32_16x16x128_f8f6f4(Bt##8[n], At##8[m], (ZC) ? z4 : acc[ai][bj][m][n], 0, 0, 0, 0x7f7f7f7f, 0, 0x7f7f7f7f); } \
        else { _Pragma("unroll") for (int m = 0; m < 4; ++m) _Pragma("unroll") for (int n = 0; n < 2; ++n) _Pragma("unroll") for (int k = 0; k < 2; ++k) \
            acc[ai][bj][m][n] = __builtin_amdgcn_mfma_f32_16x16x32_bf16(Bt[n][k], At[m][k], ((ZC) && k == 0) ? z4 : acc[ai][bj][m][n], 0, 0, 0); } } while (0)
#define PG8_MMA(ai, bj, At, Bt) do { __builtin_amdgcn_s_setprio(1); PG8_MMA_(ai, bj, At, Bt, false); __builtin_amdgcn_s_setprio(0); } while (0)
#define PG8_MMA0(ai, bj, At, Bt, first) do { __builtin_amdgcn_s_setprio(1); if (first) PG8_MMA_(ai, bj, At, Bt, true); else PG8_MMA_(ai, bj, At, Bt, false); __builtin_amdgcn_s_setprio(0); } while (0)
#define PG8_WAIT_V(n) asm volatile("s_waitcnt vmcnt(" #n ")" ::: "memory")
#define PG8_WAIT_L(n) asm volatile("s_waitcnt lgkmcnt(" #n ")" ::: "memory")
#define PG8_BAR __builtin_amdgcn_s_barrier()
#define PG8_SCHED __builtin_amdgcn_sched_barrier(0)
    Unit cur, nxt; int ui = 0;
    if (!S.next(0, cur)) return;
    f32x4 acc[2][2][4][2]; const f32x4 z4 = {0.f, 0.f, 0.f, 0.f};
    bf16x8 At[4][2], B0[2][2], B1[2][2]; i32x8 At8[4], B08[2], B18[2];
    unsigned cA = (unsigned)cur.aofs + (unsigned)cur.pm * tstepA, cB = (unsigned)cur.bofs + (unsigned)cur.pn * tstepB;
    PG8_STAGE(PG8_SB(0, 0), cB, offB); PG8_STAGE(PG8_SB(0, 1), cB + hstepB, offB); PG8_STAGE(PG8_SA(0, 0), cA, offA); PG8_STAGE(PG8_SA(0, 1), cA + hstepA, offA);
    if (wr == 1) PG8_BAR;
    PG8_WAIT_V(2); PG8_BAR;
    PG8_STAGE(PG8_SB(1, 0), cB + kstep, offB); PG8_STAGE(PG8_SA(1, 0), cA + kstep, offA); PG8_STAGE(PG8_SB(1, 1), cB + hstepB + kstep, offB);
    PG8_WAIT_V(6); PG8_BAR;
    for (;;) {
        const bool has_next = S.next(ui + 1, nxt);
        const unsigned nA = has_next ? (unsigned)nxt.aofs + (unsigned)nxt.pm * tstepA : cA, nB = has_next ? (unsigned)nxt.bofs + (unsigned)nxt.pn * tstepB : cB;
#pragma nounroll
        for (int t = 0; t < nt; t += 2) {
            const bool last = (t == nt - 2);
            const unsigned a1 = cA + (unsigned)(t + 1) * kstep;
            const unsigned a2 = last ? nA : cA + (unsigned)(t + 2) * kstep, b2 = last ? nB : cB + (unsigned)(t + 2) * kstep;
            const unsigned a3 = a2 + kstep, b3 = b2 + kstep;
            if constexpr (Epi::MIDK) { if (t != 0 && (t & 3) == 0) E.mid(acc, cur, t >> 2, wr, wc, fr, fq); }
            PG8_LDB(B0, 0, 0); PG8_LDB(B1, 0, 1); PG8_SCHED; PG8_LDA(At, 0, 0); PG8_STAGE(PG8_SA(1, 1), a1 + hstepA, offA);
            PG8_WAIT_V(8); PG8_WAIT_L(0); PG8_BAR; PG8_MMA0(0, 0, At, B0, t == 0); PG8_MMA0(0, 1, At, B1, t == 0); PG8_BAR; PG8_SCHED;
            PG8_LDA(At, 0, 1); PG8_STAGE(PG8_SB(0, 0), b2, offB); PG8_STAGE(PG8_SB(0, 1), b2 + hstepB, offB); PG8_STAGE(PG8_SA(0, 0), a2, offA);
            PG8_WAIT_V(8); PG8_WAIT_L(0); PG8_BAR; PG8_MMA0(1, 0, At, B0, t == 0); PG8_MMA0(1, 1, At, B1, t == 0); PG8_BAR; PG8_SCHED;
            PG8_LDB(B0, 1, 0); PG8_LDB(B1, 1, 1); PG8_SCHED; PG8_LDA(At, 1, 0); PG8_STAGE(PG8_SA(0, 1), a2 + hstepA, offA);
            PG8_WAIT_V(8); PG8_WAIT_L(0); PG8_BAR; PG8_MMA(0, 0, At, B0); PG8_MMA(0, 1, At, B1); PG8_BAR; PG8_SCHED;
            PG8_LDA(At, 1, 1); PG8_STAGE(PG8_SB(1, 0), b3, offB); PG8_STAGE(PG8_SB(1, 1), b3 + hstepB, offB); PG8_STAGE(PG8_SA(1, 0), a3, offA);
            PG8_WAIT_V(8); PG8_WAIT_L(0); PG8_BAR; PG8_MMA(1, 0, At, B0); PG8_MMA(1, 1, At, B1); PG8_BAR; PG8_SCHED;
        }
        if (wr == 0) PG8_BAR;
        E(acc, cur, wr, wc, fr, fq);
        if (!has_next) break;
        cur = nxt; cA = nA; cB = nB; ++ui;
        if (wr == 1) PG8_BAR;
    }
    PG8_WAIT_V(0);
    PG8_BAR;
#undef PG8_SA
#undef PG8_SB
#undef PG8_STAGE
#undef PG8_LDA
#undef PG8_LDB
#undef PG8_MMA
#undef PG8_MMA_
#undef PG8_MMA0
#undef PG8_LD8
#undef PG8_WAIT_V
#undef PG8_WAIT_L
#undef PG8_BAR
#undef PG8_SCHED
}

struct EpiTileBf16 {
    static constexpr bool PERM = true, MIDK = false;
    bf16_t* O; size_t tstride;
    __device__ __forceinline__ void operator()(const f32x4 (&acc)[2][2][4][2], const Unit& u, int wr, int wc, int fr, int fq) const {
        const int row0 = u.pm * BM + wr * 64 + fr; bf16_t* base = O + (size_t)u.pn * tstride; const int col0 = wc * 32 + 8 * fq;
#pragma unroll
        for (int ai = 0; ai < 2; ++ai)
#pragma unroll
            for (int m = 0; m < 4; ++m) { bf16_t* rowp = base + (size_t)(row0 + ai * HALF + m * 16) * 256 + col0;
#pragma unroll
                for (int bj = 0; bj < 2; ++bj) { const f32x4 v0 = acc[ai][bj][m][0], v1 = acc[ai][bj][m][1];
                    u32x4 w; w.x = pk2(v0[0], v0[1]); w.y = pk2(v0[2], v0[3]); w.z = pk2(v1[0], v1[1]); w.w = pk2(v1[2], v1[3]);
                    *(u32x4*)(rowp + bj * HALF) = w; } }
    }
};
struct EpiGateRatio {
    static constexpr bool PERM = true, MIDK = false;
    bf16_t* O; float descale;
    __device__ __forceinline__ void operator()(const f32x4 (&acc)[2][2][4][2], const Unit& u, int wr, int wc, int, int) const {
        const int l2 = my_lane(); const int fr = l2 & 15, fq = l2 >> 4;
        bf16_t* tb = O + ((size_t)((u.pm * 4 + (u.pn >> 2)) * 4 + (fq >> 1)) << 16) + ((wr * 64 + fr) << 8) + (u.pn & 3) * 64 + wc * 16 + 8 * (fq & 1);
#pragma unroll
        for (int ai = 0; ai < 2; ++ai)
#pragma unroll
            for (int m = 0; m < 4; ++m) { bf16_t* rowp = tb + ((ai * HALF + m * 16) << 8);
                f32x4 g0 = acc[ai][0][m][0], g1 = acc[ai][0][m][1], g2 = acc[ai][1][m][0], g3 = acc[ai][1][m][1];
#pragma unroll
                for (int j = 0; j < 4; ++j) {
                    const float k = -descale * LOG2E;
                    const float d0 = 1.f + fexp2(__builtin_amdgcn_fmed3f(g0[j] * k, -86.f, 86.f)), d1 = 1.f + fexp2(__builtin_amdgcn_fmed3f(g1[j] * k, -86.f, 86.f));
                    const float d2 = 1.f + fexp2(__builtin_amdgcn_fmed3f(g2[j] * k, -86.f, 86.f)), d3 = 1.f + fexp2(__builtin_amdgcn_fmed3f(g3[j] * k, -86.f, 86.f));
                    g0[j] = d1 * __builtin_amdgcn_rcpf(d0); g1[j] = d2 * __builtin_amdgcn_rcpf(d1); g2[j] = d3 * __builtin_amdgcn_rcpf(d2); g3[j] = __builtin_amdgcn_rcpf(d3); }
                u32x2 w0, w1, w2, w3; w0.x = pk2(g0[0], g0[1]); w0.y = pk2(g0[2], g0[3]); w1.x = pk2(g1[0], g1[1]); w1.y = pk2(g1[2], g1[3]);
                w2.x = pk2(g2[0], g2[1]); w2.y = pk2(g2[2], g2[3]); w3.x = pk2(g3[0], g3[1]); w3.y = pk2(g3[2], g3[3]);
                { auto t = __builtin_amdgcn_permlane32_swap(w0.x, w1.x, false, false); w0.x = t[0]; w1.x = t[1]; t = __builtin_amdgcn_permlane32_swap(w0.y, w1.y, false, false); w0.y = t[0]; w1.y = t[1]; }
                { auto t = __builtin_amdgcn_permlane32_swap(w2.x, w3.x, false, false); w2.x = t[0]; w3.x = t[1]; t = __builtin_amdgcn_permlane32_swap(w2.y, w3.y, false, false); w2.y = t[0]; w3.y = t[1]; }
                *(u32x4*)(rowp) = (u32x4){w0.x, w0.y, w1.x, w1.y};
                *(u32x4*)(rowp + 131072) = (u32x4){w2.x, w2.y, w3.x, w3.y}; }
    }
};
struct EpiMerge {
    static constexpr bool PERM = true, MIDK = true;
    const bf16_t* SG; bf16_t* M;
    __device__ __forceinline__ void mid(f32x4 (&acc)[2][2][4][2], const Unit& u, int seg, int wr, int wc, int fr, int fq) const {
        int lo = ((wr * 64 + fr) << 8) + wc * 32 + 8 * fq; asm volatile("" : "+v"(lo));
        const bf16_t* sgp = SG + ((size_t)((u.pm * 4 + u.pn) * 4 + (seg - 1)) << 16) + lo;
#pragma unroll
        for (int ai = 0; ai < 2; ++ai) {
            u32x4 s[4][2];
#pragma unroll
            for (int m = 0; m < 4; ++m)
#pragma unroll
                for (int bj = 0; bj < 2; ++bj) s[m][bj] = *(const u32x4*)(sgp + ((ai * HALF + m * 16) << 8) + bj * HALF);
#pragma unroll
            for (int m = 0; m < 4; ++m)
#pragma unroll
                for (int bj = 0; bj < 2; ++bj) { const u32x4 r = s[m][bj];
                    f32x4& v0 = acc[ai][bj][m][0]; f32x4& v1 = acc[ai][bj][m][1];
                    v0[0] *= bflo(r.x); v0[1] *= bfhi(r.x); v0[2] *= bflo(r.y); v0[3] *= bfhi(r.y);
                    v1[0] *= bflo(r.z); v1[1] *= bfhi(r.z); v1[2] *= bflo(r.w); v1[3] *= bfhi(r.w); }
            asm volatile("" ::: "memory"); }
    }
    __device__ __forceinline__ void operator()(const f32x4 (&acc)[2][2][4][2], const Unit& u, int wr, int wc, int fr, int fq) const {
        const int row0 = u.pm * BM + wr * 64 + fr; const int col0 = u.pn * BM + wc * 32 + 8 * fq;
        const bf16_t* sgp = SG + ((size_t)((u.pm * 4 + u.pn) * 4 + 3) << 16) + ((wr * 64 + fr) << 8) + wc * 32 + 8 * fq; bf16_t* mp = M + (size_t)row0 * 1024 + col0;
#pragma unroll
        for (int ai = 0; ai < 2; ++ai) {
            u32x4 sq[4][2];
#pragma unroll
            for (int m = 0; m < 4; ++m)
#pragma unroll
                for (int bj = 0; bj < 2; ++bj) sq[m][bj] = *(const u32x4*)(sgp + ((ai * HALF + m * 16) << 8) + bj * HALF);
            asm volatile("" ::: "memory");
#pragma unroll
            for (int m = 0; m < 4; ++m)
#pragma unroll
                for (int bj = 0; bj < 2; ++bj) { const u32x4 s = sq[m][bj];
                    const f32x4 v0 = acc[ai][bj][m][0], v1 = acc[ai][bj][m][1];
                    u32x4 w; w.x = pk2(v0[0] * bflo(s.x), v0[1] * bfhi(s.x)); w.y = pk2(v0[2] * bflo(s.y), v0[3] * bfhi(s.y));
                    w.z = pk2(v1[0] * bflo(s.z), v1[1] * bfhi(s.z)); w.w = pk2(v1[2] * bflo(s.w), v1[3] * bfhi(s.w));
                    *(u32x4*)(mp + (size_t)(ai * HALF + m * 16) * 1024 + bj * HALF) = w; }
            asm volatile("" ::: "memory"); }
    }
};
struct EpiResid {
    static constexpr bool PERM = false, MIDK = false;
    const float* sl; const float* sc; float* dl; float* dc; const float* gate;
    __device__ __forceinline__ void operator()(const f32x4 (&acc)[2][2][4][2], const Unit& u, int wr, int wc, int fr, int fq) const {
        const int rt = u.pm * BM; const bool isc = rt >= ML;
        const float* src = isc ? sc + (size_t)(rt - ML) * 1024 : sl + (size_t)rt * 1024;
        float* dst = isc ? dc + (size_t)(rt - ML) * 1024 : dl + (size_t)rt * 1024;
        const float* gv = gate + (size_t)(isc ? 4 : (rt >> 13)) * 6144;
        const int col0 = u.pn * BM + wc * 32 + 4 * fq; const int r0 = wr * 64 + fr;
        f32x4 gg[2][2];
#pragma unroll
        for (int bj = 0; bj < 2; ++bj)
#pragma unroll
            for (int n = 0; n < 2; ++n) gg[bj][n] = *(const f32x4*)(gv + col0 + bj * HALF + n * 16);
#pragma unroll
        for (int ai = 0; ai < 2; ++ai) {
            f32x4 x[4][2][2];
#pragma unroll
            for (int m = 0; m < 4; ++m)
#pragma unroll
                for (int bj = 0; bj < 2; ++bj)
#pragma unroll
                    for (int n = 0; n < 2; ++n) x[m][bj][n] = *(const f32x4*)(src + (size_t)(r0 + ai * HALF + m * 16) * 1024 + col0 + bj * HALF + n * 16);
            asm volatile("" ::: "memory");
#pragma unroll
            for (int m = 0; m < 4; ++m)
#pragma unroll
                for (int bj = 0; bj < 2; ++bj)
#pragma unroll
                    for (int n = 0; n < 2; ++n) *(f32x4*)(dst + (size_t)(r0 + ai * HALF + m * 16) * 1024 + col0 + bj * HALF + n * 16) = x[m][bj][n] + gg[bj][n] * acc[ai][bj][m][n];
            asm volatile("" ::: "memory"); }
    }
};
struct EpiSwiGLU {
    static constexpr bool PERM = true, MIDK = false;
    bf16_t* Hd; int ldc; int rowsub; float descale;
    __device__ __forceinline__ void operator()(const f32x4 (&acc)[2][2][4][2], const Unit& u, int wr, int wc, int, int) const {
        const int l2 = my_lane(); const int fr = l2 & 15, fq = l2 >> 4;
        const int row0 = u.pm * BM - rowsub + wr * 64 + fr; const int col0 = u.pn * HALF + wc * 32 + 8 * fq;
#pragma unroll
        for (int ai = 0; ai < 2; ++ai)
#pragma unroll
            for (int m = 0; m < 4; ++m) { bf16_t* rowp = Hd + (size_t)(row0 + ai * HALF + m * 16) * ldc + col0;
                f32x4 v0, v1;
#pragma unroll
                for (int j = 0; j < 4; ++j) { const float kg = -descale * LOG2E, k2 = descale * descale; const float a0 = acc[ai][0][m][0][j], a1 = acc[ai][0][m][1][j];
                    v0[j] = a0 * acc[ai][1][m][0][j] * k2 * __builtin_amdgcn_rcpf(1.f + fexp2(a0 * kg)); v1[j] = a1 * acc[ai][1][m][1][j] * k2 * __builtin_amdgcn_rcpf(1.f + fexp2(a1 * kg)); }
                u32x4 w; w.x = pk2(v0[0], v0[1]); w.y = pk2(v0[2], v0[3]); w.z = pk2(v1[0], v1[1]); w.w = pk2(v1[2], v1[3]);
                *(u32x4*)rowp = w; }
    }
};
struct EpiSwiGLU8 {
    static constexpr bool PERM = true, MIDK = false;
    unsigned char* Hd; int ldc; int rowsub; float descale;
    __device__ __forceinline__ void operator()(const f32x4 (&acc)[2][2][4][2], const Unit& u, int wr, int wc, int, int) const {
        const int l2 = my_lane(); const int fr = l2 & 15, fq = l2 >> 4;
        const int row0 = u.pm * BM - rowsub + wr * 64 + fr; const int col0 = u.pn * HALF + wc * 32 + 8 * fq;
#pragma unroll
        for (int ai = 0; ai < 2; ++ai)
#pragma unroll
            for (int m = 0; m < 4; ++m) { unsigned char* rowp = Hd + (size_t)(row0 + ai * HALF + m * 16) * ldc + col0;
                f32x4 v0, v1;
#pragma unroll
                for (int j = 0; j < 4; ++j) { const float kg = -descale * LOG2E, k2 = descale * descale * 8.f; const float a0 = acc[ai][0][m][0][j], a1 = acc[ai][0][m][1][j];
                    v0[j] = a0 * acc[ai][1][m][0][j] * k2 * __builtin_amdgcn_rcpf(1.f + fexp2(a0 * kg)); v1[j] = a1 * acc[ai][1][m][1][j] * k2 * __builtin_amdgcn_rcpf(1.f + fexp2(a1 * kg)); }
                u32x2 w; w.x = pk4_fp8(v0[0], v0[1], v0[2], v0[3]); w.y = pk4_fp8(v1[0], v1[1], v1[2], v1[3]);
                *(u32x2*)rowp = w; }
    }
};
struct EpiMoeDown {
    static constexpr bool PERM = true, MIDK = false;
    const int* rowinfo; const float* roww; bf16_t* Y; float descale;
    __device__ __forceinline__ void operator()(const f32x4 (&acc)[2][2][4][2], const Unit& u, int wr, int wc, int, int) const {
        const int l2 = my_lane(); const int fr = l2 & 15, fq = l2 >> 4;
        const int row0 = u.pm * BM + wr * 64 + fr; const int col0 = u.pn * BM + wc * 32 + 8 * fq;
#pragma unroll
        for (int ai = 0; ai < 2; ++ai)
#pragma unroll
            for (int m = 0; m < 4; ++m) { const int row = row0 + ai * HALF + m * 16; const int info = rowinfo[row];
                if (info >= 0) { const float w8 = roww[row] * descale; bf16_t* rowp = Y + (size_t)(info & 1) * ML * 1024 + (size_t)(info >> 1) * 1024 + col0;
#pragma unroll
                    for (int bj = 0; bj < 2; ++bj) { const f32x4 v0 = acc[ai][bj][m][0] * w8, v1 = acc[ai][bj][m][1] * w8;
                        u32x4 w; w.x = pk2(v0[0], v0[1]); w.y = pk2(v0[2], v0[3]); w.z = pk2(v1[0], v1[1]); w.w = pk2(v1[2], v1[3]);
                        *(u32x4*)(rowp + bj * HALF) = w; } } }
    }
};
}

__device__ __forceinline__ pg8::TableOrder make_unit_table(const pg8::StaticOrder& S, LAS unsigned char* lds) {
    LAS int* tab = (LAS int*)(lds + 143360 + 2048);
    const int t = (int)threadIdx.x;
    __syncthreads();
    if (t < 16) { pg8::Unit u; const bool ok = S.next(t, u); tab[2 * t] = ok ? u.pm : 0; tab[2 * t + 1] = ok ? u.pn : 0; }
    __syncthreads();
    const int n = S.c < S.nwg ? (S.nwg - S.c + S.G - 1) / S.G : 0;
    return pg8::TableOrder{tab, n};
}

struct Args { const float* in[26]; float* out; unsigned char* ws; int ph_lo, ph_hi, qbank, umask; };
enum { I_X = 0, I_C, I_CTX, I_CCTX, I_ADAW, I_ADAB, I_NMIX, I_NFFN, I_WIN, I_DECF, I_DECB, I_QNORM, I_KVNORM, I_WUQ, I_WUKV, I_RPB, I_WBR, I_WOUT,
       I_FG, I_FU, I_FD, I_ROUTER, I_MG, I_MU, I_MD, I_NFINAL };

__device__ __forceinline__ int q_next(unsigned* qw, volatile LAS int* slot, int wave) {
    __syncthreads();
    if (wave == 0 && my_lane() == 0) *slot = (int)atomicAdd(qw, 1u);
    __syncthreads();
    return *slot;
}

__device__ __forceinline__ void cvt_block(const float* W, int ldw, int k0, int sc0, bf16_t* D, int drow0, int ldd, LAS float* scr, int lane) {
    float v[32];
    const float* wp = W + (size_t)(k0 + (lane >> 5)) * ldw + (sc0 >= 0 ? sc0 : 0) + (lane & 31);
#pragma unroll
    for (int i = 0; i < 32; ++i) v[i] = wp[(size_t)(2 * i) * ldw];
#pragma unroll
    for (int i = 0; i < 32; ++i) scr[(2 * i + (lane >> 5)) * 33 + (lane & 31)] = sc0 >= 0 ? v[i] : 0.f;
    LDS_WAIT();
    const int c = lane & 7;
#pragma unroll
    for (int j = 0; j < 4; ++j) { const int n = (lane >> 3) + 8 * j; const LAS float* s = scr + (8 * c) * 33 + n;
        u32x4 o; o.x = pk2(s[0 * 33], s[1 * 33]); o.y = pk2(s[2 * 33], s[3 * 33]); o.z = pk2(s[4 * 33], s[5 * 33]); o.w = pk2(s[6 * 33], s[7 * 33]);
        *(u32x4*)(D + (size_t)(drow0 + n) * ldd + k0 + 8 * c) = o; }
    LDS_WAIT();
}
template <bool SPREAD = false>
__device__ __forceinline__ void cvt_block8(const float* W, int ldw, int k0, int sc0, unsigned char* D, int drow0, int ldd, float scale, LAS float* scr, int lane) {
    float v[32];
    const float* wp = W + (size_t)(k0 + (lane >> 5)) * ldw + sc0 + (lane & 31);
#pragma unroll
    for (int i = 0; i < 32; ++i) v[i] = wp[(size_t)(2 * i) * ldw];
#pragma unroll
    for (int i = 0; i < 32; ++i) scr[(2 * i + (lane >> 5)) * 33 + (lane & 31)] = v[i] * scale;
    LDS_WAIT();
    const int c = lane & 7;
#pragma unroll
    for (int j = 0; j < 4; ++j) { const int n = (lane >> 3) + 8 * j; const LAS float* s = scr + (8 * c) * 33 + n;
        u32x2 o; o.x = pk4_fp8(s[0 * 33], s[1 * 33], s[2 * 33], s[3 * 33]); o.y = pk4_fp8(s[4 * 33], s[5 * 33], s[6 * 33], s[7 * 33]);
        *(u32x2*)(D + (size_t)(drow0 + (SPREAD ? 32 * (n >> 4) + 8 * (((n >> 3) & 1) | (((n >> 2) & 1) << 1)) + (n & 3) : n)) * ldd + k0 + 8 * c) = o; }
    LDS_WAIT();
}
__device__ __forceinline__ int map_ng(int j) {
    if (j < 1024) return j;
    if (j < 2304) return 1184 + (j - 1024);
    if (j < 2464) return 1024 + (j - 2304);
    if (j < 2560) return -1;
    if (j < 2752) return 2464 + (j - 2560);
    return -1;
}

__device__ __forceinline__ void ph_prologue(const Args& a, LAS unsigned char* lds, int tid, int lane, int wave, int bid, int G) { asm volatile("" : "+v"(lane)); asm volatile("" : "+v"(tid));
    unsigned char* ws = a.ws;
    LAS float* s = (LAS float*)lds;
    LAS float* red = (LAS float*)(lds + 20480);
    for (int i = tid; i < 5 * 1024; i += 512) { const int r = i >> 10, k = i & 1023; const float v = r < 4 ? a.in[I_C][r * 1024 + k] : a.in[I_CCTX][k]; s[i] = siluf(v); }
    __syncthreads();
    float* MOD = (float*)(ws + WS_MOD);
    for (int unit = bid; unit < 384; unit += G) {
        const int L = unit / 192, j0 = (unit % 192) * 32, jj = tid & 31, ks = tid >> 5;
        float acc[5] = {0.f, 0.f, 0.f, 0.f, 0.f};
        const float* W = a.in[I_ADAW] + (size_t)L * 1024 * 6144 + j0 + jj;
        for (int k0 = ks * 64; k0 < ks * 64 + 64; k0 += 16) { float w[16];
#pragma unroll
            for (int i = 0; i < 16; ++i) w[i] = W[(size_t)(k0 + i) * 6144];
#pragma unroll
            for (int i = 0; i < 16; ++i)
#pragma unroll
                for (int r = 0; r < 5; ++r) acc[r] += s[r * 1024 + k0 + i] * w[i]; }
#pragma unroll
        for (int r = 0; r < 5; ++r) red[(ks * 5 + r) * 32 + jj] = acc[r];
        __syncthreads();
        if (tid < 160) { const int r = tid >> 5; float t = 0.f;
            for (int q = 0; q < 16; ++q) t += red[(q * 5 + r) * 32 + jj];
            MOD[(size_t)(L * 5 + r) * 6144 + j0 + jj] = t + a.in[I_ADAB][L * 6144 + j0 + jj]; }
        __syncthreads();
    }
    LAS float* scr = (LAS float*)(lds + 32768 + wave * 8448);
    const int gw = bid * 8 + wave, NGW = G * 8;
    constexpr int IA = 16 * 88, IB = 16 * 128, IC = 4 * 4 * 32, ID = 16 * 32, IE = 3 * 12, IF = 2 * 16, IL = IA + IB + IC + ID + IE + IF, IG = 16 * 176, IH = 44 * 32;
    for (int it = gw; it < 2 * IL + IG + IH; it += NGW) {
        int r = it;
        if (r < 2 * IL) { const int L = r / IL; r -= L * IL;
            const float* win = a.in[I_WIN] + (size_t)L * 1024 * INC;
            if (r < IA) { const int kb = r / 88, nb = r % 88; cvt_block(win, INC, kb * 64, map_ng(nb * 32), (bf16_t*)(ws + WS_WNG) + (size_t)L * 2816 * 1024, nb * 32, 1024, scr, lane); continue; } r -= IA;
            if (r < IB) { const int kb = r / 128, nb = r % 128; const int br = nb >> 5, cb = nb & 31;
                cvt_block8<true>(win, INC, kb * 64, 2656 + nb * 32, ws + WS_WG8 + (size_t)L * 4096 * 1024, 256 * (cb >> 1) + 128 * (br >> 1) + 64 * (cb & 1) + 4 * (br & 1), 1024, 64.f, scr, lane); continue; } r -= IB;
            if (r < IC) { const int i = r / 128, q = r % 128, kb = q / 32, nb = q % 32;
                cvt_block(a.in[I_WBR] + (size_t)(L * 4 + i) * 256 * 1024, 1024, kb * 64, nb * 32, (bf16_t*)(ws + WS_WB) + (size_t)L * 1024 * 1024 + i * 256, nb * 32, 1024, scr, lane); continue; } r -= IC;
            if (r < ID) { const int kb = r / 32, nb = r % 32; cvt_block(a.in[I_WOUT] + (size_t)L * 1024 * 1024, 1024, kb * 64, nb * 32, (bf16_t*)(ws + WS_WO) + (size_t)L * 1024 * 1024, nb * 32, 1024, scr, lane); continue; } r -= ID;
            if (r < IE) { const int kb = r / 12, nb = r % 12; cvt_block(a.in[I_WUQ] + (size_t)L * 192 * 384, 384, kb * 64, nb * 32, (bf16_t*)(ws + WS_WUQ) + (size_t)L * 384 * 192, nb * 32, 192, scr, lane); continue; } r -= IE;
            { const int kb = r / 16, nb = r % 16; cvt_block(a.in[I_WUKV] + (size_t)L * 128 * 512, 512, kb * 64, nb * 32, (bf16_t*)(ws + WS_WUKV) + (size_t)L * 512 * 128, nb * 32, 128, scr, lane); continue; }
        }
        r -= 2 * IL;
        if (r < IG) { const int kb = r / 176, nb = r % 176, pn = nb >> 3, wi = nb & 7;
            cvt_block(wi < 4 ? a.in[I_FG] : a.in[I_FU], FF, kb * 64, 128 * pn + 32 * (wi & 3), (bf16_t*)(ws + WS_WGU), nb * 32, 1024, scr, lane); continue; } r -= IG;
        { const int kb = r / 32, nb = r % 32; cvt_block(a.in[I_FD], 1024, kb * 64, nb * 32, (bf16_t*)(ws + WS_WD), nb * 32, FF, scr, lane); }
    }
    const int gt = bid * 512 + tid, NGT = G * 512;
    float* RR = (float*)(ws + WS_ROPER); float* RM = (float*)(ws + WS_ROPEM);
    for (int i = gt; i < 8192 * 32; i += NGT) { const int t = i >> 5, f = i & 31; const float pos = (float)(f < 16 ? (t >> 6) : (t & 63));
        const float inv = powf(10000.f, -(float)(f & 15) / 16.f); const float ang = pos * inv; RR[2 * i] = cosf(ang); RR[2 * i + 1] = sinf(ang); }
    for (int i = gt; i < 8192 * 16; i += NGT) { const int t = i >> 4, f = i & 15; const float pos = (float)(f < 8 ? (t >> 6) : (t & 63));
        const float inv = powf(10000.f, -(float)(f & 7) / 8.f); const float ang = pos * inv; RM[2 * i] = cosf(ang); RM[2 * i + 1] = sinf(ang); }
    const float TWO_PI = 6.283185307179586f;
    bf16_t* M1 = (bf16_t*)(ws + WS_M1);
    for (int i = gt; i < 256 * 128; i += NGT) { const int r = i >> 7, t2 = i & 127; const int m = ((r & 127) * t2) & 127; const float ang = TWO_PI * (float)m / 128.f;
        M1[i] = (bf16_t)f2bf(r < 128 ? cosf(ang) : -sinf(ang)); }
    float* TW = (float*)(ws + WS_TW);
    for (int i = gt; i < 8192; i += NGT) { const float ang = TWO_PI * (float)i / 8192.f; TW[2 * i] = cosf(ang); TW[2 * i + 1] = sinf(ang); }
    bf16_t* D2 = (bf16_t*)(ws + WS_D2);
    for (int i = gt; i < 128 * 128; i += NGT) { const int row = i >> 7, k = i & 127; const int ro = row >> 6, k1 = row & 63, t1 = k >> 1, ri = k & 1;
        const float ang = TWO_PI * (float)((k1 * t1) & 63) / 64.f; const float cs = cosf(ang), sn = sinf(ang);
        D2[i] = (bf16_t)f2bf(ro == 0 ? (ri == 0 ? cs : sn) : (ri == 0 ? -sn : cs)); }
    bf16_t* EP = (bf16_t*)(ws + WS_EP);
    for (int i = gt; i < 64 * 128; i += NGT) { const int l = i >> 7, q = i & 127, part = q >> 6, p = q & 63; const int ct = p >> 5, sp = (p >> 4) & 1, hh = (p >> 3) & 1, j = p & 7;
        const int c = ct * 32 + 16 * sp + 8 * (j >> 2) + 4 * hh + (j & 3); const float ang = TWO_PI * (float)((l * c) & 63) / 64.f;
        EP[i] = (bf16_t)f2bf(part == 0 ? cosf(ang) : sinf(ang)); }
}

__device__ __forceinline__ void norm_rows(const float* xl, const float* xc, const float* gain, const float* modL, int sh_off, int sc_off, bf16_t* O, unsigned char* O8, int lane, int gw, int NGW) { asm volatile("" : "+v"(lane));
    f32x4 gn[4];
#pragma unroll
    for (int j = 0; j < 4; ++j) gn[j] = *(const f32x4*)(gain + 4 * lane + 256 * j);
    for (int row = gw; row < MT; row += NGW) {
        const bool isc = row >= ML; const float* xr = isc ? xc + (size_t)(row - ML) * 1024 : xl + (size_t)row * 1024;
        const float* mv = modL + (size_t)(isc ? 4 : (row >> 13)) * 6144;
        f32x4 v[4]; float ss = 0.f;
#pragma unroll
        for (int j = 0; j < 4; ++j) { v[j] = *(const f32x4*)(xr + 4 * lane + 256 * j); ss += (v[j][0] * v[j][0] + v[j][1] * v[j][1]) + (v[j][2] * v[j][2] + v[j][3] * v[j][3]); }
        const float rstd = 1.f / sqrtf(wave_sum(ss) * (1.f / 1024.f) + EPS);
        u32x2* o8 = (u32x2*)(O + (size_t)row * 1024) + lane;
#pragma unroll
        for (int j = 0; j < 4; ++j) { const f32x4 sc = *(const f32x4*)(mv + sc_off + 4 * lane + 256 * j), sh = *(const f32x4*)(mv + sh_off + 4 * lane + 256 * j);
            const f32x4 y = v[j] * rstd * gn[j] * (sc + 1.f) + sh; u32x2 w; w.x = pk2(y[0], y[1]); w.y = pk2(y[2], y[3]); o8[64 * j] = w;
            if (O8) *(unsigned*)(O8 + (size_t)row * 1024 + 4 * lane + 256 * j) = pk4_fp8(y[0] * 8.f, y[1] * 8.f, y[2] * 8.f, y[3] * 8.f); }
    }
}

__device__ __forceinline__ float logsig2(float x) { return -log1pf(expf(-x)) * LOG2E; }

template <bool DO_KS, bool DO_QS, bool DO_KT>
__device__ __forceinline__ void ret_stage(const bf16_t* U, const float* RR, int row0, int t0, int hd, LAS bf16_t* Ks, LAS bf16_t* Qs, LAS bf16_t* KT, LAS bf16_t* VT, int tid) {
    const int j = tid >> 2, qd = tid & 3; const size_t rb = (size_t)(row0 + j) * 256 + hd * 64 + 8 * qd;
    float c[8], s[8];
    if (t0 >= 0) { const float* rr = RR + ((size_t)(t0 + j) * 32 + 8 * qd) * 2;
#pragma unroll
        for (int i = 0; i < 8; i += 2) { const f32x4 v = *(const f32x4*)(rr + 2 * i); c[i] = v[0]; s[i] = v[1]; c[i + 1] = v[2]; s[i + 1] = v[3]; } }
    else {
#pragma unroll
        for (int i = 0; i < 8; ++i) { c[i] = 1.f; s[i] = 0.f; } }
    {
        const u32x4 a = *(const u32x4*)(U + rb), b = *(const u32x4*)(U + rb + 32);
        float x1[8] = {bflo(a.x), bfhi(a.x), bflo(a.y), bfhi(a.y), bflo(a.z), bfhi(a.z), bflo(a.w), bfhi(a.w)};
        float x2[8] = {bflo(b.x), bfhi(b.x), bflo(b.y), bfhi(b.y), bflo(b.z), bfhi(b.z), bflo(b.w), bfhi(b.w)};
        float o1[8], o2[8];
#pragma unroll
        for (int i = 0; i < 8; ++i) { o1[i] = (x1[i] * c[i] - x2[i] * s[i]) * 0.125f; o2[i] = (x2[i] * c[i] + x1[i] * s[i]) * 0.125f; }
        if (DO_KS) { u32x4 w1, w2; w1.x = pk2(o1[0], o1[1]); w1.y = pk2(o1[2], o1[3]); w1.z = pk2(o1[4], o1[5]); w1.w = pk2(o1[6], o1[7]);
            w2.x = pk2(o2[0], o2[1]); w2.y = pk2(o2[2], o2[3]); w2.z = pk2(o2[4], o2[5]); w2.w = pk2(o2[6], o2[7]);
            *(LAS u32x4*)(Ks + j * 72 + 8 * qd) = w1; *(LAS u32x4*)(Ks + j * 72 + 32 + 8 * qd) = w2; }
        if (DO_KT) {
#pragma unroll
            for (int i = 0; i < 8; ++i) { KT[(8 * qd + i) * 136 + j] = (bf16_t)f2bf(o1[i]); KT[(32 + 8 * qd + i) * 136 + j] = (bf16_t)f2bf(o2[i]); } }
    }
    if (DO_QS) {
        const bf16_t* Uq = U + (size_t)4 * MT * 256;
        const u32x4 a = *(const u32x4*)(Uq + rb), b = *(const u32x4*)(Uq + rb + 32);
        float x1[8] = {bflo(a.x), bfhi(a.x), bflo(a.y), bfhi(a.y), bflo(a.z), bfhi(a.z), bflo(a.w), bfhi(a.w)};
        float x2[8] = {bflo(b.x), bfhi(b.x), bflo(b.y), bfhi(b.y), bflo(b.z), bfhi(b.z), bflo(b.w), bfhi(b.w)};
        float o1[8], o2[8];
#pragma unroll
        for (int i = 0; i < 8; ++i) { o1[i] = x1[i] * c[i] - x2[i] * s[i]; o2[i] = x2[i] * c[i] + x1[i] * s[i]; }
        u32x4 w1, w2; w1.x = pk2(o1[0], o1[1]); w1.y = pk2(o1[2], o1[3]); w1.z = pk2(o1[4], o1[5]); w1.w = pk2(o1[6], o1[7]);
        w2.x = pk2(o2[0], o2[1]); w2.y = pk2(o2[2], o2[3]); w2.z = pk2(o2[4], o2[5]); w2.w = pk2(o2[6], o2[7]);
        *(LAS u32x4*)(Qs + j * 72 + 8 * qd) = w1; *(LAS u32x4*)(Qs + j * 72 + 32 + 8 * qd) = w2;
    }
    {
        const bf16_t* Uv = U + (size_t)1 * MT * 256;
        const u32x4 a = *(const u32x4*)(Uv + rb), b = *(const u32x4*)(Uv + rb + 32);
        const unsigned wa[4] = {a.x, a.y, a.z, a.w}, wb[4] = {b.x, b.y, b.z, b.w};
#pragma unroll
        for (int i = 0; i < 4; ++i) { VT[(8 * qd + 2 * i) * 136 + j] = (bf16_t)(wa[i] & 0xffffu); VT[(8 * qd + 2 * i + 1) * 136 + j] = (bf16_t)(wa[i] >> 16);
            VT[(32 + 8 * qd + 2 * i) * 136 + j] = (bf16_t)(wb[i] & 0xffffu); VT[(32 + 8 * qd + 2 * i + 1) * 136 + j] = (bf16_t)(wb[i] >> 16); }
    }
}

__device__ __forceinline__ void ret_dstate_unit(const Args& a, int L, int u, LAS unsigned char* lds, int tid, int lane, int wave) { asm volatile("" : "+v"(lane)); asm volatile("" : "+v"(tid));
    const bf16_t* U = (const bf16_t*)(a.ws + WS_U); const float* RR = (const float*)(a.ws + WS_ROPER);
    LAS bf16_t* KT = (LAS bf16_t*)lds; LAS bf16_t* VT = (LAS bf16_t*)(lds + 17408);
    int b, hd, n, row0, t0; float* dst0;
    if (u < 1024) { b = u >> 8; hd = (u >> 6) & 3; n = u & 63; row0 = b * SEQ + n * 128; t0 = n * 128; dst0 = (float*)(a.ws + WS_ST) + ((size_t)((b * 4 + hd) * 64 + n)) * 4096; }
    else { const int v = u - 1024; b = v >> 3; hd = (v >> 1) & 3; n = v & 1; row0 = ML + b * CTXL + n * 128; t0 = -1; dst0 = (float*)(a.ws + WS_STC) + ((size_t)((b * 4 + hd) * 2 + n)) * 4096; }
    ret_stage<false, false, true>(U, RR, row0, t0, hd, KT, KT, KT, VT, tid);
    __syncthreads();
    const int dir = wave >> 2, dkb = (wave >> 1) & 1, dvb = wave & 1, r = lane & 31, h = lane >> 5;
    const float lg2 = logsig2(a.in[dir ? I_DECB : I_DECF][L * 4 + hd]);
    f32x16 acc = zero16();
#pragma unroll
    for (int s = 0; s < 8; ++s) {
        const u32x4 kw = *(const LAS u32x4*)(KT + (dkb * 32 + r) * 136 + 16 * s + 8 * h);
        const int j0 = 16 * s + 8 * h;
        float w[8];
#pragma unroll
        for (int i = 0; i < 8; ++i) w[i] = fexp2(lg2 * (float)(dir ? (j0 + i) : (127 - j0 - i)));
        u32x4 ka; ka.x = pk2(bflo(kw.x) * w[0], bfhi(kw.x) * w[1]); ka.y = pk2(bflo(kw.y) * w[2], bfhi(kw.y) * w[3]);
        ka.z = pk2(bflo(kw.z) * w[4], bfhi(kw.z) * w[5]); ka.w = pk2(bflo(kw.w) * w[6], bfhi(kw.w) * w[7]);
        const bf16x8 vb = *(const LAS bf16x8*)(VT + (dvb * 32 + r) * 136 + 16 * s + 8 * h);
        acc = mfma32(as_bf16x8(ka), vb, acc);
    }
    float* dst = dst0 + (size_t)dir * (u < 1024 ? (size_t)16 * 64 * 4096 : (size_t)16 * 2 * 4096);
#pragma unroll
    for (int q = 0; q < 16; ++q) dst[(dkb * 32 + crow(q, h)) * 64 + dvb * 32 + r] = acc[q];
}

__device__ __forceinline__ void ret_scan_unit(const Args& a, int L, int u, int tid) { asm volatile("" : "+v"(tid));
    const int dir = u >> 7, bh = (u >> 3) & 15, e = (u & 7) * 512 + tid, hd = bh & 3;
    const float lg2 = logsig2(a.in[dir ? I_DECB : I_DECF][L * 4 + hd]); const float g128 = fexp2(lg2 * 128.f);
    float* st = (float*)(a.ws + WS_ST) + ((size_t)(dir * 16 + bh) * 64) * 4096 + e;
    const float* sc = (const float*)(a.ws + WS_STC) + ((size_t)(dir * 16 + bh) * 2) * 4096 + e;
    float S = dir == 0 ? g128 * sc[0] + sc[4096] : sc[0] + g128 * sc[4096];
    long step = dir == 0 ? 4096 : -4096; asm volatile("" : "+v"(step));
    float* p = st + (dir == 0 ? 0 : (size_t)63 * 4096);
#pragma nounroll
    for (int n0 = 0; n0 < 64; n0 += 8) {
        float t[8];
#pragma unroll
        for (int i = 0; i < 8; ++i) t[i] = p[i * step];
#pragma unroll
        for (int i = 0; i < 8; ++i) { p[i * step] = S; S = g128 * S + t[i]; }
        p += 8 * step;
    }
}

__device__ __forceinline__ void ret_out_unit(const Args& a, int L, int u, LAS unsigned char* lds, int tid, int lane, int wave) { asm volatile("" : "+v"(lane)); asm volatile("" : "+v"(tid));
    const bf16_t* U = (const bf16_t*)(a.ws + WS_U); const float* RR = (const float*)(a.ws + WS_ROPER);
    LAS bf16_t* Qs = (LAS bf16_t*)lds; LAS bf16_t* Ks = (LAS bf16_t*)(lds + 18432); LAS bf16_t* VT = (LAS bf16_t*)(lds + 36864);
    LAS bf16_t* SfT = (LAS bf16_t*)(lds + 54272); LAS bf16_t* SbT = (LAS bf16_t*)(lds + 63488); LAS float* Ob = (LAS float*)(lds + 72704);
    int b, hd, n, row0, t0; const float* sf; const float* sb;
    if (u < 1024) { b = u >> 8; hd = (u >> 6) & 3; n = u & 63; row0 = b * SEQ + n * 128; t0 = n * 128;
        sf = (const float*)(a.ws + WS_ST) + ((size_t)((b * 4 + hd) * 64 + n)) * 4096; sb = sf + (size_t)16 * 64 * 4096; }
    else { const int v = u - 1024; b = v >> 3; hd = (v >> 1) & 3; n = v & 1; row0 = ML + b * CTXL + n * 128; t0 = -1;
        const float* stc = (const float*)(a.ws + WS_STC) + ((size_t)((b * 4 + hd) * 2)) * 4096;
        sf = n == 1 ? stc : nullptr; sb = n == 0 ? stc + (size_t)16 * 2 * 4096 + 4096 : nullptr; }
    ret_stage<true, true, false>(U, RR, row0, t0, hd, Ks, Qs, Ks, VT, tid);
    {
        const int dk = tid >> 3, dv0 = (tid & 7) * 8;
#pragma unroll
        for (int i = 0; i < 8; ++i) { SfT[(dv0 + i) * 72 + dk] = (bf16_t)f2bf(sf ? sf[dk * 64 + dv0 + i] : 0.f); SbT[(dv0 + i) * 72 + dk] = (bf16_t)f2bf(sb ? sb[dk * 64 + dv0 + i] : 0.f); }
    }
    __syncthreads();
    const int dir = wave >> 2, it = wave & 3, r = lane & 31, h = lane >> 5;
    const float lg2 = logsig2(a.in[dir ? I_DECB : I_DECF][L * 4 + hd]);
    const int iq = it * 32 + r;
    bf16x8 qf[4];
#pragma unroll
    for (int s = 0; s < 4; ++s) qf[s] = *(const LAS bf16x8*)(Qs + iq * 72 + 16 * s + 8 * h);
    f32x16 o[2];
    {
        const LAS bf16_t* ST_ = dir ? SbT : SfT;
        const float fac = fexp2(lg2 * (float)(dir ? (128 - iq) : (iq + 1)));
#pragma unroll
        for (int dvb = 0; dvb < 2; ++dvb) { f32x16 c = zero16();
#pragma unroll
            for (int s = 0; s < 4; ++s) c = mfma32(*(const LAS bf16x8*)(ST_ + (dvb * 32 + r) * 72 + 16 * s + 8 * h), qf[s], c);
            o[dvb] = c * fac; }
    }
    const int jt0 = dir ? it : 0, jt1 = dir ? 3 : it;
    for (int jt = jt0; jt <= jt1; ++jt) {
        f32x16 sT = zero16();
#pragma unroll
        for (int s = 0; s < 4; ++s) sT = mfma32(*(const LAS bf16x8*)(Ks + (jt * 32 + r) * 72 + 16 * s + 8 * h), qf[s], sT);
        float p[16];
#pragma unroll
        for (int q = 0; q < 16; ++q) { const int j = jt * 32 + crow(q, h); const int d = dir ? (j - iq) : (iq - j); p[q] = d >= 0 ? sT[q] * fexp2(lg2 * (float)d) : 0.f; }
#pragma unroll
        for (int sp = 0; sp < 2; ++sp) {
            u32x4 pw; pw.x = pk2(p[8 * sp + 0], p[8 * sp + 1]); pw.y = pk2(p[8 * sp + 2], p[8 * sp + 3]); pw.z = pk2(p[8 * sp + 4], p[8 * sp + 5]); pw.w = pk2(p[8 * sp + 6], p[8 * sp + 7]);
#pragma unroll
            for (int dvb = 0; dvb < 2; ++dvb) {
                const LAS bf16_t* vp = VT + (dvb * 32 + r) * 136 + jt * 32 + 16 * sp + 4 * h;
                const u32x2 v0 = *(const LAS u32x2*)vp, v1 = *(const LAS u32x2*)(vp + 8);
                u32x4 vw; vw.x = v0.x; vw.y = v0.y; vw.z = v1.x; vw.w = v1.y;
                o[dvb] = mfma32(as_bf16x8(vw), as_bf16x8(pw), o[dvb]);
            }
        }
    }
    float ss = 0.f;
#pragma unroll
    for (int dvb = 0; dvb < 2; ++dvb)
#pragma unroll
        for (int q = 0; q < 16; ++q) ss += o[dvb][q] * o[dvb][q];
    ss = xhalf_sum(ss);
    const float rn = 1.f / sqrtf(ss * (1.f / 64.f) + EPS);
    const bf16_t* Ug = U + (size_t)(dir ? 6 : 5) * MT * 256 + (size_t)(row0 + iq) * 256 + hd * 64;
#pragma unroll
    for (int dvb = 0; dvb < 2; ++dvb)
#pragma unroll
        for (int q4 = 0; q4 < 4; ++q4) { const int dv = dvb * 32 + 8 * q4 + 4 * h; const u32x2 gw = *(const u32x2*)(Ug + dv);
            o[dvb][4 * q4 + 0] *= rn * siluf(bflo(gw.x)); o[dvb][4 * q4 + 1] *= rn * siluf(bfhi(gw.x)); o[dvb][4 * q4 + 2] *= rn * siluf(bflo(gw.y)); o[dvb][4 * q4 + 3] *= rn * siluf(bfhi(gw.y)); }
    if (dir == 1) {
#pragma unroll
        for (int dvb = 0; dvb < 2; ++dvb)
#pragma unroll
            for (int q4 = 0; q4 < 4; ++q4) *(LAS f32x4*)(Ob + iq * 68 + dvb * 32 + 8 * q4 + 4 * h) = (f32x4){o[dvb][4 * q4], o[dvb][4 * q4 + 1], o[dvb][4 * q4 + 2], o[dvb][4 * q4 + 3]};
    }
    __syncthreads();
    if (dir == 0) {
        bf16_t* Y = (bf16_t*)(a.ws + WS_YBR) + (size_t)(row0 + iq) * 1024 + hd * 64;
#pragma unroll
        for (int dvb = 0; dvb < 2; ++dvb)
#pragma unroll
            for (int q4 = 0; q4 < 4; ++q4) { const int dv = dvb * 32 + 8 * q4 + 4 * h; const f32x4 ob = *(const LAS f32x4*)(Ob + iq * 68 + dv);
                u32x2 w; w.x = pk2(o[dvb][4 * q4] + ob[0], o[dvb][4 * q4 + 1] + ob[1]); w.y = pk2(o[dvb][4 * q4 + 2] + ob[2], o[dvb][4 * q4 + 3] + ob[3]);
                *(u32x2*)(Y + dv) = w; }
    }
}

__device__ __forceinline__ void mla_prep_wave(const Args& a, int L, int blk, int half, int lane) { asm volatile("" : "+v"(lane));
    const unsigned char* ws = a.ws; const bf16_t* U = (const bf16_t*)(ws + WS_U);
    const int r = lane & 31, h = lane >> 5, row = blk * 32 + r; const bool isc = row >= ML;
    int b, key, t;
    if (!isc) { b = row >> 13; t = row & 8191; key = t; } else { const int rc = row - ML; b = rc >> 8; t = rc & 255; key = SEQ + t; }
    const float* RM = (const float*)(ws + WS_ROPEM);
    bf16_t* MK = (bf16_t*)(a.ws + WS_MK); bf16_t* MVT = (bf16_t*)(a.ws + WS_MVT);
    {
        const bf16_t* up = U + (size_t)9 * MT * 256 + (size_t)row * 256;
        u32x4 xs[8]; float ss = 0.f;
#pragma unroll
        for (int s = 0; s < 8; ++s) { xs[s] = *(const u32x4*)(up + 16 * s + 8 * h);
            const float v[8] = {bflo(xs[s].x), bfhi(xs[s].x), bflo(xs[s].y), bfhi(xs[s].y), bflo(xs[s].z), bfhi(xs[s].z), bflo(xs[s].w), bfhi(xs[s].w)};
#pragma unroll
            for (int i = 0; i < 8; ++i) ss += v[i] * v[i]; }
        ss = xhalf_sum(ss);
        const float rstd = 1.f / sqrtf(ss * (1.f / 128.f) + EPS);
        const float* kvn = a.in[I_KVNORM] + L * 128;
#pragma unroll
        for (int s = 0; s < 8; ++s) { const f32x4 g0 = *(const f32x4*)(kvn + 16 * s + 8 * h), g1 = *(const f32x4*)(kvn + 16 * s + 8 * h + 4);
            u32x4 w; w.x = pk2(bflo(xs[s].x) * rstd * g0[0], bfhi(xs[s].x) * rstd * g0[1]); w.y = pk2(bflo(xs[s].y) * rstd * g0[2], bfhi(xs[s].y) * rstd * g0[3]);
            w.z = pk2(bflo(xs[s].z) * rstd * g1[0], bfhi(xs[s].z) * rstd * g1[1]); w.w = pk2(bflo(xs[s].w) * rstd * g1[2], bfhi(xs[s].w) * rstd * g1[3]); xs[s] = w;  asm volatile("" ::: "memory"); }
        const bf16_t* W = (const bf16_t*)(ws + WS_WUKV) + (size_t)L * 512 * 128;
#pragma unroll 2
        for (int ob = 8 * half; ob < 8 * half + 8; ++ob) {
            f32x16 acc = zero16();
#pragma unroll
            for (int s = 0; s < 8; ++s) acc = mfma32(*(const bf16x8*)(W + (size_t)(ob * 32 + r) * 128 + 16 * s + 8 * h), as_bf16x8(xs[s]), acc);
            const int hh = ob >> 2, part = ob & 3;
            if (part < 2) {
                bf16_t* kp = MK + ((size_t)(b * 4 + hh) * 8448 + key) * 104 + part * 32 + 4 * h;
#pragma unroll
                for (int q4 = 0; q4 < 4; ++q4) { u32x2 w; w.x = pk2(acc[4 * q4], acc[4 * q4 + 1]); w.y = pk2(acc[4 * q4 + 2], acc[4 * q4 + 3]); *(u32x2*)(kp + 8 * q4) = w; }
            } else {
                const int k16 = key & 15;
                bf16_t* vp = MVT + (((size_t)(b * 4 + hh) * 132 + (key >> 6)) * 64 + (part - 2) * 32) * 72 + 16 * ((key >> 4) & 3) + (((k16 & 4) << 1) | ((k16 & 8) >> 1) | (k16 & 3));
#pragma unroll
                for (int q = 0; q < 16; ++q) vp[crow(q, h) * 72] = (bf16_t)f2bf(acc[q]);
            }
        }
        if (half == 0) {
        const u32x4 a1 = *(const u32x4*)(up + 128 + 8 * h), a2 = *(const u32x4*)(up + 144 + 8 * h);
        float x1[8] = {bflo(a1.x), bfhi(a1.x), bflo(a1.y), bfhi(a1.y), bflo(a1.z), bfhi(a1.z), bflo(a1.w), bfhi(a1.w)};
        float x2[8] = {bflo(a2.x), bfhi(a2.x), bflo(a2.y), bfhi(a2.y), bflo(a2.z), bfhi(a2.z), bflo(a2.w), bfhi(a2.w)};
        float o1[8], o2[8];
#pragma unroll
        for (int i = 0; i < 8; ++i) { float c = 1.f, s = 0.f; if (!isc) { const f32x2 cs = *(const f32x2*)(RM + ((size_t)t * 16 + 8 * h + i) * 2); c = cs[0]; s = cs[1]; }
            o1[i] = x1[i] * c - x2[i] * s; o2[i] = x2[i] * c + x1[i] * s; }
        u32x4 w1, w2; w1.x = pk2(o1[0], o1[1]); w1.y = pk2(o1[2], o1[3]); w1.z = pk2(o1[4], o1[5]); w1.w = pk2(o1[6], o1[7]);
        w2.x = pk2(o2[0], o2[1]); w2.y = pk2(o2[2], o2[3]); w2.z = pk2(o2[4], o2[5]); w2.w = pk2(o2[6], o2[7]);
#pragma unroll
        for (int hh = 0; hh < 4; ++hh) { bf16_t* kp = MK + ((size_t)(b * 4 + hh) * 8448 + key) * 104 + 64; *(u32x4*)(kp + 8 * h) = w1; *(u32x4*)(kp + 16 + 8 * h) = w2; }
        }
    }
    if (!isc || L == 0) {
        const bf16_t* up = U + (size_t)10 * MT * 256 + (size_t)row * 256;
        u32x4 xs[12]; float ss = 0.f;
#pragma unroll
        for (int s = 0; s < 12; ++s) { xs[s] = *(const u32x4*)(up + 16 * s + 8 * h);
            const float v[8] = {bflo(xs[s].x), bfhi(xs[s].x), bflo(xs[s].y), bfhi(xs[s].y), bflo(xs[s].z), bfhi(xs[s].z), bflo(xs[s].w), bfhi(xs[s].w)};
#pragma unroll
            for (int i = 0; i < 8; ++i) ss += v[i] * v[i]; }
        ss = xhalf_sum(ss);
        const float rstd = 1.f / sqrtf(ss * (1.f / 192.f) + EPS);
        const float* qn = a.in[I_QNORM] + L * 192;
#pragma unroll
        for (int s = 0; s < 12; ++s) { const f32x4 g0 = *(const f32x4*)(qn + 16 * s + 8 * h), g1 = *(const f32x4*)(qn + 16 * s + 8 * h + 4);
            u32x4 w; w.x = pk2(bflo(xs[s].x) * rstd * g0[0], bfhi(xs[s].x) * rstd * g0[1]); w.y = pk2(bflo(xs[s].y) * rstd * g0[2], bfhi(xs[s].y) * rstd * g0[3]);
            w.z = pk2(bflo(xs[s].z) * rstd * g1[0], bfhi(xs[s].z) * rstd * g1[1]); w.w = pk2(bflo(xs[s].w) * rstd * g1[2], bfhi(xs[s].w) * rstd * g1[3]); xs[s] = w;  asm volatile("" ::: "memory"); }
        const bf16_t* W = (const bf16_t*)(ws + WS_WUQ) + (size_t)L * 384 * 192;
        const float qsc = 0.10206207261596577f * LOG2E;
#pragma unroll 2
        for (int ob = 6 * half; ob < 6 * half + 6; ++ob) {
            f32x16 acc = zero16();
#pragma unroll
            for (int s = 0; s < 12; ++s) acc = mfma32(*(const bf16x8*)(W + (size_t)(ob * 32 + r) * 192 + 16 * s + 8 * h), as_bf16x8(xs[s]), acc);
            const int hh = ob / 3, part = ob % 3;
            if (part == 2 && !isc) {
#pragma unroll
                for (int q = 0; q < 8; ++q) { const f32x2 cs = *(const f32x2*)(RM + ((size_t)t * 16 + crow(q, h)) * 2); const float x1 = acc[q], x2 = acc[q + 8];
                    acc[q] = x1 * cs[0] - x2 * cs[1]; acc[q + 8] = x2 * cs[0] + x1 * cs[1]; }
            }
            bf16_t* qp = isc ? (bf16_t*)(a.ws + WS_MQC) + ((size_t)(b * 4 + hh) * 256 + t) * 96 : (bf16_t*)(a.ws + WS_MQ) + ((size_t)(b * 4 + hh) * 8192 + t) * 96;
            qp += part * 32 + 4 * h;
#pragma unroll
            for (int q4 = 0; q4 < 4; ++q4) { u32x2 w; w.x = pk2(acc[4 * q4] * qsc, acc[4 * q4 + 1] * qsc); w.y = pk2(acc[4 * q4 + 2] * qsc, acc[4 * q4 + 3] * qsc); *(u32x2*)(qp + 8 * q4) = w; }
        }
    }
}

__device__ __forceinline__ void four_stage1_unit(const Args& a, int u, int lane, int wave) { asm volatile("" : "+v"(lane));
    const unsigned char* ws = a.ws; const bf16_t* F = (const bf16_t*)(ws + WS_U) + (size_t)7 * MT * 256;
    const int b = u >> 6, t1 = u & 63, r = lane & 31, h = lane >> 5, c = wave * 32 + r;
    u32x4 fr[8];
#pragma unroll
    for (int s = 0; s < 8; ++s) { unsigned e[8];
#pragma unroll
        for (int j = 0; j < 8; ++j) e[j] = F[(size_t)(b * SEQ + t1 + 64 * (16 * s + 8 * h + j)) * 256 + c];
        fr[s].x = e[0] | (e[1] << 16); fr[s].y = e[2] | (e[3] << 16); fr[s].z = e[4] | (e[5] << 16); fr[s].w = e[6] | (e[7] << 16); }
    const bf16_t* M1 = (const bf16_t*)(ws + WS_M1); const float* TW = (const float*)(ws + WS_TW);
    unsigned* A2 = (unsigned*)(a.ws + WS_A2) + ((size_t)(b * 64 + t1) * 128) * 256 + c;
    for (int i = 0; i < 4; ++i) {
        f32x16 ar = zero16(), ai = zero16();
#pragma unroll
        for (int s = 0; s < 8; ++s) { ar = mfma32(*(const bf16x8*)(M1 + (size_t)(32 * i + r) * 128 + 16 * s + 8 * h), as_bf16x8(fr[s]), ar);
            ai = mfma32(*(const bf16x8*)(M1 + (size_t)(128 + 32 * i + r) * 128 + 16 * s + 8 * h), as_bf16x8(fr[s]), ai); }
#pragma unroll
        for (int q = 0; q < 16; ++q) { const int k2 = 32 * i + crow(q, h); const f32x2 w = *(const f32x2*)(TW + 2 * (k2 * t1));
            A2[(size_t)k2 * 256] = pk2(ar[q] * w[0] + ai[q] * w[1], ai[q] * w[0] - ar[q] * w[1]); }
    }
}
__device__ __forceinline__ void four_stage2_unit(const Args& a, int u, int lane, int wave) { asm volatile("" : "+v"(lane));
    const unsigned char* ws = a.ws;
    const int b = u >> 7, k2 = u & 127, r = lane & 31, h = lane >> 5, g = wave >> 1, kb = wave & 1;
    const unsigned* A2 = (const unsigned*)(ws + WS_A2) + ((size_t)(b * 64) * 128 + k2) * 256;
    const bf16_t* D2 = (const bf16_t*)(ws + WS_D2); const bf16_t* EP = (const bf16_t*)(ws + WS_EP);
    f32x16 acc[2][2];
#pragma unroll
    for (int ct = 0; ct < 2; ++ct)
#pragma unroll
        for (int ro = 0; ro < 2; ++ro) acc[ct][ro] = zero16();
#pragma unroll
    for (int s = 0; s < 8; ++s) {
        const bf16x8 d0 = *(const bf16x8*)(D2 + (size_t)(kb * 32 + r) * 128 + 16 * s + 8 * h), d1 = *(const bf16x8*)(D2 + (size_t)(64 + kb * 32 + r) * 128 + 16 * s + 8 * h);
#pragma unroll
        for (int ct = 0; ct < 2; ++ct) { const int c = g * 64 + ct * 32 + r; u32x4 f;
            f.x = A2[(size_t)(8 * s + 4 * h + 0) * 128 * 256 + c]; f.y = A2[(size_t)(8 * s + 4 * h + 1) * 128 * 256 + c];
            f.z = A2[(size_t)(8 * s + 4 * h + 2) * 128 * 256 + c]; f.w = A2[(size_t)(8 * s + 4 * h + 3) * 128 * 256 + c];
            acc[ct][0] = mfma32(as_bf16x8(f), d0, acc[ct][0]); acc[ct][1] = mfma32(as_bf16x8(f), d1, acc[ct][1]); }
    }
    f32x16 y[2] = {zero16(), zero16()};
#pragma unroll
    for (int ro = 0; ro < 2; ++ro)
#pragma unroll
        for (int ct = 0; ct < 2; ++ct)
#pragma unroll
            for (int sp = 0; sp < 2; ++sp) { const f32x16& x = acc[ct][ro];
                u32x4 xw; xw.x = pk2(x[8 * sp + 0], x[8 * sp + 1]); xw.y = pk2(x[8 * sp + 2], x[8 * sp + 3]); xw.z = pk2(x[8 * sp + 4], x[8 * sp + 5]); xw.w = pk2(x[8 * sp + 6], x[8 * sp + 7]);
#pragma unroll
                for (int lb = 0; lb < 2; ++lb) y[lb] = mfma32(*(const bf16x8*)(EP + (size_t)(lb * 32 + r) * 128 + ro * 64 + ct * 32 + sp * 16 + h * 8), as_bf16x8(xw), y[lb]); }
    const float sc = 0.0013810679320049757f;
    bf16_t* Y = (bf16_t*)(a.ws + WS_YBR) + ((size_t)(b * SEQ + 128 * (kb * 32 + r) + k2)) * 1024 + 256 + g * 64;
#pragma unroll
    for (int lb = 0; lb < 2; ++lb)
#pragma unroll
        for (int q4 = 0; q4 < 4; ++q4) { u32x2 w; w.x = pk2(y[lb][4 * q4] * sc, y[lb][4 * q4 + 1] * sc); w.y = pk2(y[lb][4 * q4 + 2] * sc, y[lb][4 * q4 + 3] * sc);
            *(u32x2*)(Y + lb * 32 + 8 * q4 + 4 * h) = w; }
}
__device__ __forceinline__ void cfour_step1_unit(const Args& a, int u, LAS unsigned char* lds, int tid) { asm volatile("" : "+v"(tid));
    LAS float* fl = (LAS float*)lds;
    LAS float* cs = (LAS float*)(lds + 2048);
    const bf16_t* F = (const bf16_t*)(a.ws + WS_U) + (size_t)7 * MT * 256;
    const int rr = tid >> 8, col = tid & 255, row = 2 * u + rr;
    fl[tid] = bf2f(F[(size_t)(ML + row) * 256 + col]);
    if (tid < 64) { const float ang = 6.283185307179586f * (float)tid / 64.f; cs[2 * tid] = cosf(ang); cs[2 * tid + 1] = sinf(ang); }
    __syncthreads();
    const int g = col >> 6, l = col & 63; float p = 0.f, q = 0.f;
    for (int c = 0; c < 64; ++c) { const float f = fl[rr * 256 + g * 64 + c]; const int m = (l * c) & 63; p += f * cs[2 * m]; q += f * cs[2 * m + 1]; }
    float* O = (float*)(a.ws + WS_CPQ) + (size_t)row * 512; O[col] = p; O[256 + col] = q;
}
__device__ __forceinline__ void cfour_step2_unit(const Args& a, int u, LAS unsigned char* lds, int tid) { asm volatile("" : "+v"(tid));
    LAS float* cs = (LAS float*)lds;
    if (tid < 256) { const float ang = 6.283185307179586f * (float)tid / 256.f; cs[2 * tid] = cosf(ang); cs[2 * tid + 1] = sinf(ang); }
    __syncthreads();
    const int b = u >> 6, k0 = (u & 63) * 4 + (tid >> 8) * 2, col = tid & 255;
    const float* P = (const float*)(a.ws + WS_CPQ) + (size_t)(b * 256) * 512 + col; float acc0 = 0.f, acc1 = 0.f;
    for (int t0 = 0; t0 < 256; t0 += 8) { float p[8], q[8];
#pragma unroll
        for (int i = 0; i < 8; ++i) { p[i] = P[(size_t)(t0 + i) * 512]; q[i] = P[(size_t)(t0 + i) * 512 + 256]; }
#pragma unroll
        for (int i = 0; i < 8; ++i) { const int m0 = (k0 * (t0 + i)) & 255, m1 = ((k0 + 1) * (t0 + i)) & 255;
            acc0 += cs[2 * m0] * p[i] - cs[2 * m0 + 1] * q[i]; acc1 += cs[2 * m1] * p[i] - cs[2 * m1 + 1] * q[i]; } }
    bf16_t* Y = (bf16_t*)(a.ws + WS_YBR) + (size_t)(ML + b * 256 + k0) * 1024 + 256 + col;
    Y[0] = (bf16_t)f2bf(acc0 * (1.f / 128.f)); Y[1024] = (bf16_t)f2bf(acc1 * (1.f / 128.f));
}

__device__ __forceinline__ void osm_step(const f32x16& x, float& m, float& l, f32x16& o0, f32x16& o1, u32x4& p0, u32x4& p1) {
    float bm = fmaxf(fmaxf(x[0], x[1]), fmaxf(x[2], x[3]));
#pragma unroll
    for (int q = 4; q < 16; q += 4) bm = fmaxf(bm, fmaxf(fmaxf(x[q], x[q + 1]), fmaxf(x[q + 2], x[q + 3])));
    bm = xhalf_max(bm);
    const float mn = fmaxf(m, bm);
    const float alpha = fexp2(m - mn);
    float p[16]; float ps = 0.f;
#pragma unroll
    for (int q = 0; q < 16; ++q) { p[q] = fexp2(x[q] - mn); ps += p[q]; }
    l = l * alpha + ps; m = mn;
    o0 = o0 * alpha; o1 = o1 * alpha;
    p0.x = pk2(p[0], p[1]); p0.y = pk2(p[2], p[3]); p0.z = pk2(p[4], p[5]); p0.w = pk2(p[6], p[7]);
    p1.x = pk2(p[8], p[9]); p1.y = pk2(p[10], p[11]); p1.z = pk2(p[12], p[13]); p1.w = pk2(p[14], p[15]);
}

__device__ __forceinline__ void na_vt_unit(const Args& a, int u, LAS unsigned char* lds, int tid) { asm volatile("" : "+v"(tid));
    const bf16_t* UV = (const bf16_t*)(a.ws + WS_U) + (size_t)3 * MT * 256;
    LAS bf16_t* T = (LAS bf16_t*)lds;
    const int row0 = u * 64; int b, key0; if (row0 < ML) { b = row0 >> 13; key0 = row0 & 8191; } else { b = (row0 - ML) >> 8; key0 = SEQ + ((row0 - ML) & 255); }
    { const int j = tid >> 3, part = tid & 7; const int q = (j >> 2) & 3, nq = q == 1 ? 2 : (q == 2 ? 1 : q), pos = (j & ~15) + nq * 4 + (j & 3);
#pragma unroll
      for (int c4 = 0; c4 < 4; ++c4) { const u32x4 v = *(const u32x4*)(UV + (size_t)(row0 + j) * 256 + part * 32 + c4 * 8); const unsigned w[4] = {v.x, v.y, v.z, v.w};
#pragma unroll
        for (int i = 0; i < 4; ++i) { T[(part * 32 + c4 * 8 + 2 * i) * 72 + pos] = (bf16_t)(w[i] & 0xffffu); T[(part * 32 + c4 * 8 + 2 * i + 1) * 72 + pos] = (bf16_t)(w[i] >> 16); } } }
    __syncthreads();
    { const int rr = tid >> 1, half = tid & 1; bf16_t* dst = (bf16_t*)(a.ws + WS_NVT) + ((size_t)(b * 4 + (rr >> 6)) * 64 + (rr & 63)) * 8448 + key0 + half * 32;
#pragma unroll
      for (int c = 0; c < 4; ++c) *(u32x4*)(dst + c * 8) = *(const LAS u32x4*)(T + rr * 72 + half * 32 + c * 8); }
}
__device__ __forceinline__ void na_unit(const Args& a, int L, int u, LAS unsigned char* lds, int tid, int lane, int wave) { asm volatile("" : "+v"(lane)); asm volatile("" : "+v"(tid));
    const bf16_t* U = (const bf16_t*)(a.ws + WS_U);
    const bf16_t* UK = U + (size_t)2 * MT * 256; const bf16_t* UQ = U + (size_t)8 * MT * 256;
    LAS float* rp = (LAS float*)lds;
    for (int i = tid; i < 4 * 465; i += 512) rp[i] = a.in[I_RPB][(size_t)L * 4 * 465 + i];
    __syncthreads();
    const int hd = wave >> 1, qh = wave & 1, r = lane & 31, h = lane >> 5;
    const bool isc = u >= 512; int b, gr = 0, rs = 0, qrow;
    if (!isc) { b = u >> 7; gr = u & 127; rs = gr - 4; rs = rs < 0 ? 0 : (rs > 120 ? 120 : rs); qrow = b * SEQ + gr * 64 + qh * 32 + r; }
    else { const int v = u - 512; b = v >> 2; qrow = ML + b * CTXL + (v & 3) * 64 + qh * 32 + r; }
    const int cq = qh * 32 + r; int cs = cq - 8; cs = cs < 0 ? 0 : (cs > 48 ? 48 : cs);
    const bf16_t* VT = (const bf16_t*)(a.ws + WS_NVT) + ((size_t)(b * 4 + hd) * 64 + r) * 8448 + 8 * h;
    const bf16_t* KB = UK + hd * 64 + 8 * h;
    bf16x8 qf[4];
#pragma unroll
    for (int s = 0; s < 4; ++s) qf[s] = *(const bf16x8*)(UQ + (size_t)qrow * 256 + hd * 64 + 16 * s + 8 * h);
    float m = -INFINITY, l = 0.f; f32x16 o0 = zero16(), o1 = zero16();
    const int nblk = isc ? 8 : 24;
    bf16x8 kfA[4], vfA[4], kfB[4], vfB[4];
#define NA_ADDR(kb, krow0, key0) do { if ((kb) < 8) { krow0 = ML + b * CTXL + (kb) * 32; key0 = SEQ + (kb) * 32; } else { const int t0_ = (rs + (((kb) - 8) >> 1)) * 64 + (((kb) - 8) & 1) * 32; krow0 = b * SEQ + t0_; key0 = t0_; } } while (0)
#define NA_LOAD(kb, kf, vf) do { int krow0_, key0_; NA_ADDR(kb, krow0_, key0_); \
        _Pragma("unroll") for (int s = 0; s < 4; ++s) kf[s] = *(const bf16x8*)(KB + (size_t)(krow0_ + r) * 256 + 16 * s); \
        _Pragma("unroll") for (int sp = 0; sp < 2; ++sp) { vf[sp * 2] = *(const bf16x8*)(VT + key0_ + 16 * sp); vf[sp * 2 + 1] = *(const bf16x8*)(VT + (size_t)32 * 8448 + key0_ + 16 * sp); } } while (0)
#define NA_BLOCK(kb, kf, vf) do { f32x16 sT = zero16(); \
        _Pragma("unroll") for (int s = 0; s < 4; ++s) sT = mfma32(kf[s], qf[s], sT); \
        f32x16 x; \
        if ((kb) < 8) { _Pragma("unroll") for (int q = 0; q < 16; ++q) x[q] = sT[q] * (0.125f * LOG2E); } \
        else { const int li_ = ((kb) - 8) >> 1, cbk_ = ((kb) - 8) & 1; const LAS float* bp = rp + hd * 465 + (rs + li_ - gr + 7) * 31 + 15 - cq; \
            _Pragma("unroll") for (int q = 0; q < 16; ++q) { const int ck = cbk_ * 32 + crow(q, h); const bool ok = (ck >= cs) && (ck < cs + 16); \
                x[q] = ok ? (sT[q] * 0.125f + bp[ok ? ck : cq]) * LOG2E : -INFINITY; } } \
        u32x4 p0, p1; osm_step(x, m, l, o0, o1, p0, p1); \
        o0 = mfma32(vf[0], as_bf16x8(p0), o0); o1 = mfma32(vf[1], as_bf16x8(p0), o1); o0 = mfma32(vf[2], as_bf16x8(p1), o0); o1 = mfma32(vf[3], as_bf16x8(p1), o1); } while (0)
    NA_LOAD(0, kfA, vfA);
    for (int kb = 0; kb < nblk; kb += 2) {
        NA_LOAD(kb + 1, kfB, vfB);
        NA_BLOCK(kb, kfA, vfA);
        if (kb + 2 < nblk) NA_LOAD(kb + 2, kfA, vfA);
        NA_BLOCK(kb + 1, kfB, vfB);
    }
#undef NA_ADDR
#undef NA_LOAD
#undef NA_BLOCK
    l = xhalf_sum(l);
    const float il = 1.f / l;
    bf16_t* Y = (bf16_t*)(a.ws + WS_YBR) + (size_t)qrow * 1024 + 512 + hd * 64 + 4 * h;
#pragma unroll
    for (int q4 = 0; q4 < 4; ++q4) { u32x2 w; w.x = pk2(o0[4 * q4] * il, o0[4 * q4 + 1] * il); w.y = pk2(o0[4 * q4 + 2] * il, o0[4 * q4 + 3] * il); *(u32x2*)(Y + 8 * q4) = w;
        u32x2 w2; w2.x = pk2(o1[4 * q4] * il, o1[4 * q4 + 1] * il); w2.y = pk2(o1[4 * q4 + 2] * il, o1[4 * q4 + 3] * il); *(u32x2*)(Y + 32 + 8 * q4) = w2; }
}

__device__ __forceinline__ float max3f(float a, float b, float c) { return fmaxf(fmaxf(a, b), c); }
__device__ __forceinline__ f32x16 splat16(float v) { f32x16 z;
#pragma unroll
    for (int i = 0; i < 16; ++i) z[i] = v;
    return z; }
__device__ __forceinline__ float rowmax32(const f32x16& a, const f32x16& b) {
    float bm = max3f(a[0], a[1], b[0]);
#pragma unroll
    for (int q = 2; q < 16; q += 2) bm = max3f(bm, a[q], a[q + 1]);
#pragma unroll
    for (int q = 1; q < 15; q += 2) bm = max3f(bm, b[q], b[q + 1]);
    bm = fmaxf(bm, b[15]);
    return xhalf_max(bm);
}
__device__ __forceinline__ void mla_step(f32x16& x0, f32x16& x1, f32x16& y0, f32x16& y1, const LAS unsigned char* kb_, const LAS unsigned char* vb_, const bf16x8 (&qf)[6],
                                         f32x16& negm, float& l, f32x16& o0, f32x16& o1, int r, int h, bool check) {
    y0 = mfma32(*(const LAS bf16x8*)(kb_ + r * 208 + 16 * h), qf[0], negm); y1 = mfma32(*(const LAS bf16x8*)(kb_ + (32 + r) * 208 + 16 * h), qf[0], negm);
#pragma unroll
    for (int s = 1; s < 6; ++s) { y0 = mfma32(*(const LAS bf16x8*)(kb_ + r * 208 + 32 * s + 16 * h), qf[s], y0); y1 = mfma32(*(const LAS bf16x8*)(kb_ + (32 + r) * 208 + 32 * s + 16 * h), qf[s], y1); }
    float ps = 0.f;
#pragma unroll
    for (int q = 0; q < 16; ++q) { x0[q] = fexp2(x0[q]); x1[q] = fexp2(x1[q]); ps += x0[q]; ps += x1[q]; }
    u32x4 pf[4];
    pf[0].x = pk2(x0[0], x0[1]); pf[0].y = pk2(x0[2], x0[3]); pf[0].z = pk2(x0[4], x0[5]); pf[0].w = pk2(x0[6], x0[7]);
    pf[1].x = pk2(x0[8], x0[9]); pf[1].y = pk2(x0[10], x0[11]); pf[1].z = pk2(x0[12], x0[13]); pf[1].w = pk2(x0[14], x0[15]);
    pf[2].x = pk2(x1[0], x1[1]); pf[2].y = pk2(x1[2], x1[3]); pf[2].z = pk2(x1[4], x1[5]); pf[2].w = pk2(x1[6], x1[7]);
    pf[3].x = pk2(x1[8], x1[9]); pf[3].y = pk2(x1[10], x1[11]); pf[3].z = pk2(x1[12], x1[13]); pf[3].w = pk2(x1[14], x1[15]);
    float bm = max3f(y0[0], y0[1], y1[0]);
#pragma unroll
    for (int kq = 0; kq < 4; ++kq) {
        o0 = mfma32(*(const LAS bf16x8*)(vb_ + r * 144 + (16 * kq + 8 * h) * 2), as_bf16x8(pf[kq]), o0);
        bm = max3f(bm, y0[2 + 4 * kq], y0[3 + 4 * kq]); bm = max3f(bm, y0[4 + 4 * kq > 15 ? 15 : 4 + 4 * kq], y0[5 + 4 * kq > 15 ? 15 : 5 + 4 * kq]);
        __builtin_amdgcn_sched_barrier(0);
        o1 = mfma32(*(const LAS bf16x8*)(vb_ + (32 + r) * 144 + (16 * kq + 8 * h) * 2), as_bf16x8(pf[kq]), o1);
        bm = max3f(bm, y1[1 + 4 * kq], y1[2 + 4 * kq]); bm = max3f(bm, y1[3 + 4 * kq], y1[4 + 4 * kq > 15 ? 15 : 4 + 4 * kq]);
        __builtin_amdgcn_sched_barrier(0);
    }
    l += ps;
    bm = xhalf_max(bm);
    if (check && __builtin_amdgcn_ballot_w64(bm > 8.f) != 0ull) { const float d = fmaxf(bm, 0.f); const float alpha = fexp2(-d); negm = negm - d; l *= alpha; o0 = o0 * alpha; o1 = o1 * alpha; y0 = y0 - d; y1 = y1 - d; }
}
__device__ __forceinline__ void mla_unit(const Args& a, int u, LAS unsigned char* lds, int tid, int lane, int wave) { asm volatile("" : "+v"(lane)); asm volatile("" : "+v"(tid));
    const bool isc = u >= 512; int bh, q0, key0, nt; size_t orow0;
    if (!isc) { bh = u >> 5; q0 = (u & 31) * 256; key0 = 0; nt = 132; orow0 = (size_t)(bh >> 2) * SEQ + q0; }
    else { bh = u - 512; q0 = 0; key0 = SEQ; nt = 4; orow0 = (size_t)ML + (size_t)(bh >> 2) * CTXL; }
    const int hd = bh & 3, r = lane & 31, h = lane >> 5;
    const bf16_t* Q = isc ? (const bf16_t*)(a.ws + WS_MQC) + (size_t)bh * 256 * 96 : (const bf16_t*)(a.ws + WS_MQ) + ((size_t)bh * 8192 + q0) * 96;
    const __amdgpu_buffer_rsrc_t rsK = __builtin_amdgcn_make_buffer_rsrc((void*)(a.ws + WS_MK + ((size_t)bh * 8448 + key0) * 208), 0, 0x7fffffff, 0x00020000);
    const __amdgpu_buffer_rsrc_t rsV = __builtin_amdgcn_make_buffer_rsrc((void*)(a.ws + WS_MVT + ((size_t)bh * 132 + (key0 >> 6)) * 9216), 0, 0x7fffffff, 0x00020000);
    const int dvo = lane * 16;
#define MLA_STAGE(tk_, sk_, tv_, sv_) do { _Pragma("unroll") for (int i_ = 0; i_ < 3; ++i_) { const int p_ = wave + 8 * i_; \
        if (p_ < 13) { if ((tk_) < nt) __builtin_amdgcn_raw_ptr_buffer_load_lds(rsK, (LAS void*)(KB + (sk_) * 13312 + p_ * 1024), 16, dvo, (tk_) * 13312 + p_ * 1024, 0, 0); } \
        else if (p_ < 22) { if ((tv_) < nt) __builtin_amdgcn_raw_ptr_buffer_load_lds(rsV, (LAS void*)(VB + (sv_) * 9216 + (p_ - 13) * 1024), 16, dvo, (tv_) * 9216 + (p_ - 13) * 1024, 0, 0); } } } while (0)
    LAS unsigned char* KB = lds; LAS unsigned char* VB = lds + 26624;
    bf16x8 qf[6];
#pragma unroll
    for (int s = 0; s < 6; ++s) qf[s] = *(const bf16x8*)(Q + (size_t)(wave * 32 + r) * 96 + 16 * s + 8 * h);
    MLA_STAGE(0, 0, 0, 0);
    asm volatile("s_waitcnt vmcnt(0)" ::: "memory");
    __syncthreads();
    MLA_STAGE(1, 1, nt, 0);
    f32x16 negm, sA0, sA1, sB0, sB1;
    {
        f32x16 c0 = zero16(), c1 = zero16();
#pragma unroll
        for (int s = 0; s < 6; ++s) { c0 = mfma32(*(const LAS bf16x8*)(KB + r * 208 + 32 * s + 16 * h), qf[s], c0); c1 = mfma32(*(const LAS bf16x8*)(KB + (32 + r) * 208 + 32 * s + 16 * h), qf[s], c1); }
        const float m = rowmax32(c0, c1); negm = splat16(-m); sA0 = c0 - m; sA1 = c1 - m;
    }
    asm volatile("s_waitcnt vmcnt(0)" ::: "memory");
    __syncthreads();
    if (wave >= 4) __builtin_amdgcn_s_setprio(1);
    float l = 0.f; f32x16 o0 = zero16(), o1 = zero16();
    for (int t = 0; t < nt; t += 2) {
        MLA_STAGE(t + 2, 0, t + 1, 1);
        mla_step(sA0, sA1, sB0, sB1, KB + 13312, VB, qf, negm, l, o0, o1, r, h, true);
        asm volatile("s_waitcnt vmcnt(0)" ::: "memory");
        __syncthreads();
        MLA_STAGE(t + 3, 1, t + 2, 0);
        mla_step(sB0, sB1, sA0, sA1, KB, VB + 9216, qf, negm, l, o0, o1, r, h, t + 2 < nt);
        asm volatile("s_waitcnt vmcnt(0)" ::: "memory");
        __syncthreads();
    }
    if (wave >= 4) __builtin_amdgcn_s_setprio(0);
#undef MLA_STAGE
    l = xhalf_sum(l);
    const float il = 1.f / l;
    bf16_t* Y = (bf16_t*)(a.ws + WS_YBR) + (orow0 + wave * 32 + r) * 1024 + 768 + hd * 64 + 4 * h;
#pragma unroll
    for (int q4 = 0; q4 < 4; ++q4) { u32x2 w; w.x = pk2(o0[4 * q4] * il, o0[4 * q4 + 1] * il); w.y = pk2(o0[4 * q4 + 2] * il, o0[4 * q4 + 3] * il); *(u32x2*)(Y + 8 * q4) = w;
        u32x2 w2; w2.x = pk2(o1[4 * q4] * il, o1[4 * q4 + 1] * il); w2.y = pk2(o1[4 * q4 + 2] * il, o1[4 * q4 + 3] * il); *(u32x2*)(Y + 32 + 8 * q4) = w2; }
}

__device__ __forceinline__ void moe_offsets(const unsigned* cnt, int (&pst)[NE], int& ntiles) {
    int acc = 0;
#pragma unroll
    for (int e = 0; e < NE; ++e) { pst[e] = acc; const int c = (int)__hip_atomic_load(cnt + e, __ATOMIC_RELAXED, __HIP_MEMORY_SCOPE_AGENT); acc += (c + 255) / 256 * 256; }
    ntiles = acc / 256;
}
__device__ __forceinline__ void ffn_row_load(const float* xr, int lane, f32x4 (&v)[4]) {
#pragma unroll
    for (int j = 0; j < 4; ++j) v[j] = *(const f32x4*)(xr + 4 * lane + 256 * j);
}
__device__ __forceinline__ void ffn_row_finish(const f32x4 (&v)[4], const f32x4 (&gn)[4], const float* mv, int lane, f32x4 (&y)[4]) {
    float ss = 0.f;
#pragma unroll
    for (int j = 0; j < 4; ++j) ss += (v[j][0] * v[j][0] + v[j][1] * v[j][1]) + (v[j][2] * v[j][2] + v[j][3] * v[j][3]);
    const float rstd = 1.f / sqrtf(wave_sum(ss) * (1.f / 1024.f) + EPS);
#pragma unroll
    for (int j = 0; j < 4; ++j) { const f32x4 sc = *(const f32x4*)(mv + 4096 + 4 * lane + 256 * j), sh = *(const f32x4*)(mv + 3072 + 4 * lane + 256 * j);
        y[j] = v[j] * rstd * gn[j] * (sc + 1.f) + sh; }
}
__device__ __forceinline__ void ph_route(const Args& a, LAS unsigned char* lds, int tid, int lane, int wave, int bid, int G) { asm volatile("" : "+v"(lane)); asm volatile("" : "+v"(tid));
    unsigned char* ws = a.ws; unsigned* ctl = (unsigned*)(ws + WS_CTL);
    const int gt = bid * 512 + tid, NGT = G * 512, gw = bid * 8 + wave, NGW = G * 8;
    int* rowinfo = (int*)(ws + WS_ROWINFO);
    for (int i = gt; i < NRMAX; i += NGT) rowinfo[i] = -1;
    LAS float* rt = (LAS float*)lds;
    for (int i = tid; i < 8192; i += 512) rt[i] = a.in[I_ROUTER][i];
    __syncthreads();
    const float* modL = (const float*)(ws + WS_MOD) + (size_t)5 * 6144;
    f32x4 gn[4];
#pragma unroll
    for (int j = 0; j < 4; ++j) gn[j] = *(const f32x4*)(a.in[I_NFFN] + 1024 + 4 * lane + 256 * j);
    unsigned mycnt = 0;
    for (int row0 = gw; row0 < ML; row0 += 2 * NGW) {
        f32x4 vv[2][4];
#pragma unroll
        for (int q = 0; q < 2; ++q) if (row0 + q * NGW < ML) ffn_row_load(a.out + (size_t)(row0 + q * NGW) * 1024, lane, vv[q]);
#pragma unroll
        for (int q = 0; q < 2; ++q) { const int row = row0 + q * NGW; if (row >= ML) continue;
        f32x4 y[4]; ffn_row_finish(vv[q], gn, modL + (size_t)(row >> 13) * 6144, lane, y);
        float lg[8] = {0.f, 0.f, 0.f, 0.f, 0.f, 0.f, 0.f, 0.f};
#pragma unroll
        for (int j = 0; j < 4; ++j)
#pragma unroll
            for (int i = 0; i < 4; ++i) { const int k = 4 * lane + 256 * j + i; const f32x4 r0 = *(const LAS f32x4*)(rt + k * 8), r1 = *(const LAS f32x4*)(rt + k * 8 + 4); const float hv = y[j][i];
                lg[0] += hv * r0[0]; lg[1] += hv * r0[1]; lg[2] += hv * r0[2]; lg[3] += hv * r0[3]; lg[4] += hv * r1[0]; lg[5] += hv * r1[1]; lg[6] += hv * r1[2]; lg[7] += hv * r1[3]; }
#pragma unroll
        for (int e = 0; e < 8; ++e) lg[e] = wave_sum(lg[e]);
        int e0 = 0; float l0 = lg[0];
#pragma unroll
        for (int e = 1; e < 8; ++e) if (lg[e] > l0) { l0 = lg[e]; e0 = e; }
        int e1 = -1; float l1 = -INFINITY;
#pragma unroll
        for (int e = 0; e < 8; ++e) if (e != e0 && lg[e] > l1) { l1 = lg[e]; e1 = e; }
        const float w0 = 1.f / (1.f + expf(l1 - l0)), w1 = 1.f - w0;
        if (lane == 0) { u32x4 t; t.x = (unsigned)e0; t.y = (unsigned)e1; t.z = __float_as_uint(w0); t.w = __float_as_uint(w1); *(u32x4*)(ws + WS_TOK + (size_t)row * 16) = t; }
        mycnt += (lane == e0 || lane == e1) ? 1u : 0u;
        }
    }
    {
        LAS unsigned* lc = (LAS unsigned*)(lds + LDS_MISC + 512);
        __syncthreads();
        if (tid < 8) lc[tid] = 0u;
        __syncthreads();
        if (lane < 8 && mycnt) atomicAdd((unsigned*)(lc + lane), mycnt);
        __syncthreads();
        if (tid < 8) ((unsigned*)(ws + WS_WGCNT))[bid * 8 + tid] = lc[tid];
    }
    __syncthreads();
    LAS float* scr = (LAS float*)(lds + 32768 + wave * 8448);
    constexpr int IGU = 16 * 224, IDN = 56 * 32;
    for (int it = gw; it < NE * (IGU + IDN); it += NGW) {
        const int e = it / (IGU + IDN); int r = it % (IGU + IDN);
        if (r < IGU) { const int kb = r / 224, nb = r % 224, pn = nb >> 3, wi = nb & 7;
            cvt_block8((wi < 4 ? a.in[I_MG] : a.in[I_MU]) + (size_t)e * 1024 * MF, MF, kb * 64, 128 * pn + 32 * (wi & 3), ws + WS_MWGU + (size_t)e * 7168 * 1024, nb * 32, 1024, 64.f, scr, lane); }
        else { r -= IGU; const int kb = r / 32, nb = r % 32;
            cvt_block8(a.in[I_MD] + (size_t)e * MF * 1024, 1024, kb * 64, nb * 32, ws + WS_MWD + (size_t)e * 1024 * MF, nb * 32, MF, 64.f, scr, lane); }
    }
}
__device__ __forceinline__ void ph_place(const Args& a, LAS unsigned char* lds, int tid, int lane, int wave, int bid, int G) { asm volatile("" : "+v"(lane)); asm volatile("" : "+v"(tid));
    unsigned char* ws = a.ws; unsigned* ctl = (unsigned*)(ws + WS_CTL);
    LAS int* tot = (LAS int*)(lds + LDS_MISC + 512); LAS int* bas = tot + 8; LAS int* cur = tot + 16;
    if (tid < 8) { const unsigned* wc = (const unsigned*)(ws + WS_WGCNT) + tid; int t = 0, bsum = 0;
        for (int w = 0; w < G; ++w) { const int c = (int)__hip_atomic_load(wc + w * 8, __ATOMIC_RELAXED, __HIP_MEMORY_SCOPE_AGENT); if (w < bid) bsum += c; t += c; }
        tot[tid] = t; bas[tid] = bsum; cur[tid] = 0; if (bid == 0) __hip_atomic_store(ctl + CW_CNT + tid, (unsigned)t, __ATOMIC_RELAXED, __HIP_MEMORY_SCOPE_AGENT); }
    __syncthreads();
    int pst[NE], ntiles = 0; { int acc = 0;
#pragma unroll
        for (int e = 0; e < NE; ++e) { pst[e] = acc + bas[e]; acc += (tot[e] + 255) / 256 * 256; }
        ntiles = acc / 256; }
    if (bid == 0 && tid < 264) { int e = -1, acc = 0;
#pragma unroll
        for (int q = 0; q < NE; ++q) { if (tid * 256 >= acc) e = q; acc += (tot[q] + 255) / 256 * 256; }
        ((int*)(ws + WS_TILEE))[tid] = tid < ntiles ? e : -1; }
    const int gw = bid * 8 + wave, NGW = G * 8;
    const float* modL = (const float*)(ws + WS_MOD) + (size_t)5 * 6144;
    f32x4 gn[4];
#pragma unroll
    for (int j = 0; j < 4; ++j) gn[j] = *(const f32x4*)(a.in[I_NFFN] + 1024 + 4 * lane + 256 * j);
    int* rowinfo = (int*)(ws + WS_ROWINFO); float* roww = (float*)(ws + WS_ROWW); bf16_t* XG = (bf16_t*)(ws + WS_XG);
    for (int row0 = gw; row0 < ML; row0 += 2 * NGW) {
        f32x4 vv[2][4];
#pragma unroll
        for (int q = 0; q < 2; ++q) if (row0 + q * NGW < ML) ffn_row_load(a.out + (size_t)(row0 + q * NGW) * 1024, lane, vv[q]);
#pragma unroll
        for (int q = 0; q < 2; ++q) { const int row = row0 + q * NGW; if (row >= ML) continue;
        f32x4 y[4]; ffn_row_finish(vv[q], gn, modL + (size_t)(row >> 13) * 6144, lane, y);
        unsigned w[4];
#pragma unroll
        for (int j = 0; j < 4; ++j) w[j] = pk4_fp8(y[j][0] * 8.f, y[j][1] * 8.f, y[j][2] * 8.f, y[j][3] * 8.f);
        const u32x4 tk = *(const u32x4*)(ws + WS_TOK + (size_t)row * 16);
#pragma unroll
        for (int k = 0; k < 2; ++k) { const int e = (int)(k ? tk.y : tk.x); const float wt = __uint_as_float(k ? tk.w : tk.z);
            int pe = 0;
#pragma unroll
            for (int q = 0; q < NE; ++q) pe = (q == e) ? pst[q] : pe;
            int slot = 0; if (lane == 0) slot = atomicAdd((int*)(cur + e), 1);
            slot = __builtin_amdgcn_readfirstlane(slot);
            const int dest = pe + slot;
            if (lane == 0) { rowinfo[dest] = row * 2 + k; roww[dest] = wt; }
            unsigned* o8 = (unsigned*)((unsigned char*)XG + (size_t)dest * 1024) + lane;
#pragma unroll
            for (int j = 0; j < 4; ++j) o8[64 * j] = w[j]; }
        }
    }
}
__device__ __forceinline__ void ph_final(const Args& a, int lane, int wave, int bid, int G) { asm volatile("" : "+v"(lane));
    unsigned char* ws = a.ws; const int gw = bid * 8 + wave, NGW = G * 8;
    const float* modL = (const float*)(ws + WS_MOD) + (size_t)5 * 6144;
    const bf16_t* Y0 = (const bf16_t*)(ws + WS_Y01); const bf16_t* Y1 = Y0 + (size_t)ML * 1024;
    f32x4 gn[4];
#pragma unroll
    for (int j = 0; j < 4; ++j) gn[j] = *(const f32x4*)(a.in[I_NFINAL] + 4 * lane + 256 * j);
    for (int row = gw; row < ML; row += NGW) {
        float* xr = a.out + (size_t)row * 1024; const float* g2 = modL + (size_t)(row >> 13) * 6144 + 5120;
        f32x4 v[4]; float ss = 0.f;
#pragma unroll
        for (int j = 0; j < 4; ++j) { const f32x4 x = *(const f32x4*)(xr + 4 * lane + 256 * j), gg = *(const f32x4*)(g2 + 4 * lane + 256 * j);
            const u32x2 ya = *(const u32x2*)(Y0 + (size_t)row * 1024 + 4 * lane + 256 * j), yb = *(const u32x2*)(Y1 + (size_t)row * 1024 + 4 * lane + 256 * j);
            f32x4 yy; yy[0] = bflo(ya.x) + bflo(yb.x); yy[1] = bfhi(ya.x) + bfhi(yb.x); yy[2] = bflo(ya.y) + bflo(yb.y); yy[3] = bfhi(ya.y) + bfhi(yb.y);
            v[j] = x + gg * yy; ss += (v[j][0] * v[j][0] + v[j][1] * v[j][1]) + (v[j][2] * v[j][2] + v[j][3] * v[j][3]); }
        const float rstd = 1.f / sqrtf(wave_sum(ss) * (1.f / 1024.f) + EPS);
#ifdef DBG_FINAL
        { float so = 0.f; bool nn = false;
#pragma unroll
          for (int j = 0; j < 4; ++j) { const f32x4 o = v[j] * rstd * gn[j];
#pragma unroll
            for (int i = 0; i < 4; ++i) { so += o[i] * o[i]; if (!(o[i] - o[i] == 0.f)) nn = true; } }
          const float sv = wave_sum(ss), so2 = wave_sum(so);
          if (lane == 0) { atomicAdd((float*)(ws + WS_CTL) + 9001, sv); atomicAdd((float*)(ws + WS_CTL) + 9002, so2); }
          if (nn) atomicMax((unsigned*)(ws + WS_CTL) + 9003, 1u); }
#endif
#pragma unroll
        for (int j = 0; j < 4; ++j) { f32x4 o = v[j] * rstd * gn[j];
#ifdef DBG_FINAL
            o = v[j];
#endif
#ifdef DBG_SANITIZE
#pragma unroll
            for (int i = 0; i < 4; ++i) o[i] = (o[i] - o[i] == 0.f) ? o[i] : 0.f;
#endif
            *(f32x4*)(xr + 4 * lane + 256 * j) = o; }
    }
}

#ifdef DBG_STAMP
#define DSTAMP(k) do { if (bid == 0 && tid == 0) ((unsigned long long*)(a.ws + WS_CTL + 40960))[(k)] = wall_clock64(); } while (0)
#else
#define DSTAMP(k) do { } while (0)
#endif
#ifndef DIS
#define DIS 0
#endif
#ifndef PH_MASK
#define PH_MASK 0xFFFFFFFFu
#endif
#define IN(k) (((PH_MASK >> ((k) >= 25 ? ((k) == 35 ? 15 : 13 + (((k) - 25) & 1)) : (k) == 0 ? 0 : (((k) - 1) % 12) + 1)) & 1u) && lo <= (k) && (k) < hi)
#define SEAM() do { if (multi) xcd_barrier(bar, wave == 0 && my_lane() == 0); } while (0)
template <int L>
__device__ __forceinline__ void layer_phases(const Args& a, LAS unsigned char* lds, int wave, int bid, int G, int lo, int hi, bool multi, const XcdBarrier& bar, volatile LAS int* qslot) {
    unsigned char* ws = a.ws; unsigned* ctl = (unsigned*)(ws + WS_CTL);
    const int gw = bid * 8 + wave, NGW = G * 8;
    float* MOD = (float*)(ws + WS_MOD);
    bf16_t* Hb = (bf16_t*)(ws + WS_H); bf16_t* Ub = (bf16_t*)(ws + WS_U); bf16_t* YBR = (bf16_t*)(ws + WS_YBR); bf16_t* SG = (bf16_t*)(ws + WS_SG);
    float* XC = (float*)(ws + WS_XC);
        const int LB = 1 + 12 * L;
        const float* modL = MOD + (size_t)L * 5 * 6144;
        const float* xl = L == 0 ? a.in[I_X] : a.out; const float* xc = L == 0 ? a.in[I_CTX] : XC;
        if (IN(LB + 0)) { const int lane = my_lane(), tid = wave * 64 + lane; (void)tid; (void)lane; DSTAMP(LB + 0); norm_rows(xl, xc, a.in[I_NMIX] + L * 1024, modL, 0, 1024, Hb, ws + WS_H8, lane, gw, NGW); SEAM(); }
        if (IN(LB + 1)) { const int lane = my_lane(), tid = wave * 64 + lane; (void)tid; (void)lane; DSTAMP(LB + 1);
            pg8::Gemm g{Hb, (const bf16_t*)(ws + WS_WNG) + (size_t)L * 2816 * 1024, 1024, 1024, 1024};
            pg8::StaticOrder S0; S0.init(MT / 256, UT, G, bid); const pg8::TableOrder S = make_unit_table(S0, lds);
            pg8::EpiTileBf16 E{Ub, (size_t)MT * 256};
            pg8::gemm_phase(lds, g, S, E, wave); SEAM();
        }
        if (IN(LB + 2)) { const int lane = my_lane(), tid = wave * 64 + lane; (void)tid; (void)lane; DSTAMP(LB + 2);
            unsigned* qw = ctl + CW_Q + 64 * (LB + 2) + a.qbank * 4096;
            if (!(a.umask & 1)) for (;;) { const int u = q_next(qw, qslot, wave); if (u >= 256) break; four_stage1_unit(a, u, my_lane(), wave); }
            if (!(a.umask & 2)) for (;;) { const int u = q_next(qw + 16, qslot, wave); if (u >= 1056) break; { const int l2 = my_lane(); ret_dstate_unit(a, L, u, lds, wave * 64 + l2, l2, wave); } }
            if (!(a.umask & 4)) for (;;) { const int u = q_next(qw + 32, qslot, wave); if (u >= 264) break; mla_prep_wave(a, L, (u >> 1) * 8 + wave, u & 1, my_lane()); }
            if (!(a.umask & 8)) for (;;) { const int u = q_next(qw + 40, qslot, wave); if (u >= 528) break; na_vt_unit(a, u, lds, wave * 64 + my_lane()); }
            if (L == 0) for (;;) { const int u = q_next(qw + 48, qslot, wave); if (u >= 512) break; if (!(DIS & 8)) cfour_step1_unit(a, u, lds, wave * 64 + my_lane()); }
            SEAM();
        }
        if (IN(LB + 3)) { const int lane = my_lane(), tid = wave * 64 + lane; (void)tid; (void)lane; DSTAMP(LB + 3); for (int u = bid; u < 256; u += G) ret_scan_unit(a, L, u, tid); SEAM(); }
        if (IN(LB + 4)) { const int lane = my_lane(), tid = wave * 64 + lane; (void)tid; (void)lane; DSTAMP(LB + 4);
            unsigned* qw = ctl + CW_Q + 64 * (LB + 4) + a.qbank * 4096;
            const int nc = L == 0 ? 16 : 0;
            if (!(a.umask & 1)) for (;;) { const int u = q_next(qw, qslot, wave); if (u >= 512 + nc) break; { const int l2 = my_lane(); mla_unit(a, u, lds, wave * 64 + l2, l2, wave); } }
            if (!(a.umask & 2)) for (;;) { const int u = q_next(qw + 16, qslot, wave); if (u >= 512 + nc) break; { const int l2 = my_lane(); na_unit(a, L, u, lds, wave * 64 + l2, l2, wave); } }
            if (!(a.umask & 4)) for (;;) { const int u = q_next(qw + 32, qslot, wave); if (u >= 1024 + 2 * nc) break; { const int l2 = my_lane(); ret_out_unit(a, L, u, lds, wave * 64 + l2, l2, wave); } }
            if (!(a.umask & 8)) for (;;) { const int u = q_next(qw + 48, qslot, wave); if (u >= 512) break; four_stage2_unit(a, u, my_lane(), wave); }
            if (L == 0) for (;;) { const int u = q_next(qw + 56, qslot, wave); if (u >= 256) break; cfour_step2_unit(a, u, lds, wave * 64 + my_lane()); }
            SEAM();
        }
        const int nMm = L == 0 ? MT / 256 : ML / 256;
        if (IN(LB + 5)) { const int lane = my_lane(), tid = wave * 64 + lane; (void)tid; (void)lane; DSTAMP(LB + 5);
            pg8::Gemm g{(const bf16_t*)(ws + WS_H8), (const bf16_t*)(ws + WS_WG8 + (size_t)L * 4096 * 1024), 512, 512, 512};
            pg8::StaticOrder S0; S0.init(nMm, 16, G, bid); const pg8::TableOrder S = make_unit_table(S0, lds);
            pg8::EpiGateRatio E{SG, 1.f / 512.f};
            pg8::gemm_phase<pg8::EpiGateRatio, pg8::TableOrder, true>(lds, g, S, E, wave); SEAM();
        }
        if (IN(LB + 6)) { const int lane = my_lane(), tid = wave * 64 + lane; (void)tid; (void)lane; DSTAMP(LB + 6);
            pg8::Gemm g{YBR, (const bf16_t*)(ws + WS_WB) + (size_t)L * 1024 * 1024, 1024, 1024, 1024};
            pg8::StaticOrder S0; S0.init(nMm, 4, G, bid); const pg8::TableOrder S = make_unit_table(S0, lds);
            pg8::EpiMerge E{SG, Hb};
            pg8::gemm_phase(lds, g, S, E, wave); SEAM();
        }
        if (IN(LB + 7)) { const int lane = my_lane(), tid = wave * 64 + lane; (void)tid; (void)lane; DSTAMP(LB + 7);
            pg8::Gemm g{Hb, (const bf16_t*)(ws + WS_WO) + (size_t)L * 1024 * 1024, 1024, 1024, 1024};
            pg8::StaticOrder S0; S0.init(nMm, 4, G, bid); const pg8::TableOrder S = make_unit_table(S0, lds);
            pg8::EpiResid E{xl, xc, a.out, XC, modL + 2048};
            pg8::gemm_phase(lds, g, S, E, wave); SEAM();
        }
        if (L == 0) {
            if (IN(LB + 8)) { const int lane = my_lane(), tid = wave * 64 + lane; (void)tid; (void)lane; DSTAMP(LB + 8); norm_rows(a.out, XC, a.in[I_NFFN], modL, 3072, 4096, Hb, nullptr, lane, gw, NGW); SEAM(); }
            if (IN(LB + 9)) { const int lane = my_lane(), tid = wave * 64 + lane; (void)tid; (void)lane; DSTAMP(LB + 9);
                pg8::Gemm g{Hb, (const bf16_t*)(ws + WS_WGU), 1024, 1024, 1024};
                pg8::StaticOrder S0; S0.init(MT / 256, 22, G, bid); const pg8::TableOrder S = make_unit_table(S0, lds);
                pg8::EpiSwiGLU E{(bf16_t*)(ws + WS_HID), FF, 0, 1.f};
                pg8::gemm_phase(lds, g, S, E, wave); SEAM();
            }
            if (IN(LB + 10)) { const int lane = my_lane(), tid = wave * 64 + lane; (void)tid; (void)lane; DSTAMP(LB + 10);
                pg8::Gemm g{(const bf16_t*)(ws + WS_HID), (const bf16_t*)(ws + WS_WD), FF, FF, FF};
                pg8::StaticOrder S0; S0.init(MT / 256, 4, G, bid); const pg8::TableOrder S = make_unit_table(S0, lds);
                pg8::EpiResid E{a.out, XC, a.out, XC, modL + 5120};
                pg8::gemm_phase(lds, g, S, E, wave); SEAM();
            }
        } else {
            if (IN(LB + 8)) { const int lane = my_lane(), tid = wave * 64 + lane; (void)tid; (void)lane; DSTAMP(LB + 8); ph_route(a, lds, tid, lane, wave, bid, G); SEAM(); }
            if (IN(LB + 9)) { const int lane = my_lane(), tid = wave * 64 + lane; (void)tid; (void)lane; DSTAMP(LB + 9); ph_place(a, lds, tid, lane, wave, bid, G); SEAM(); }
        }
    }

constexpr int NPH = 32;
__global__ void __launch_bounds__(512, 2) mega(Args a) {
    extern __shared__ __attribute__((aligned(16))) unsigned char lds_raw[];
    LAS unsigned char* lds = (LAS unsigned char*)lds_raw;
    const int wave = __builtin_amdgcn_readfirstlane(threadIdx.x >> 6), bid = blockIdx.x, G = gridDim.x;
    unsigned char* ws = a.ws; unsigned* ctl = (unsigned*)(ws + WS_CTL);
    volatile LAS unsigned* misc = (volatile LAS unsigned*)(lds + LDS_MISC);
    volatile LAS int* qslot = (volatile LAS int*)(lds + LDS_MISC + 64);
    const int lo = a.ph_lo, hi = a.ph_hi; const bool multi = (hi - lo) > 1;
    if (threadIdx.x < 32) misc[threadIdx.x] = 0u;
    __syncthreads();
    XcdBarrier bar; bar.bar = ctl + CW_BAR; bar.x = 0; bar.st = misc;
    if (multi) bar = xcd_barrier_post(ctl + CW_BAR, misc, threadIdx.x == 0);

    const int gw = bid * 8 + wave, NGW = G * 8;
    float* MOD = (float*)(ws + WS_MOD);
    bf16_t* Hb = (bf16_t*)(ws + WS_H); bf16_t* Ub = (bf16_t*)(ws + WS_U); bf16_t* YBR = (bf16_t*)(ws + WS_YBR); bf16_t* SG = (bf16_t*)(ws + WS_SG);
    float* XC = (float*)(ws + WS_XC);

    if (IN(0)) { const int lane = my_lane(), tid = wave * 64 + lane; (void)tid; (void)lane; DSTAMP(0); ph_prologue(a, lds, tid, lane, wave, bid, G); SEAM(); }

    layer_phases<0>(a, lds, wave, bid, G, lo, hi, multi, bar, qslot);
    layer_phases<1>(a, lds, wave, bid, G, lo, hi, multi, bar, qslot);
    for (int k = 0; k < 6; ++k) {
        if (IN(25 + k)) { const int lane = my_lane(), tid = wave * 64 + lane; (void)tid; (void)lane; DSTAMP(25 + k);
            constexpr size_t HIDB = (size_t)72 * 256 * MF;
            if (k >= 1) { const int c = k - 1; const int c0 = 64 * c, lg = c < 4 ? 6 : 3;
                pg8::Gemm g{(const bf16_t*)(ws + WS_HIDM + (size_t)(c & 1) * HIDB - (size_t)c0 * 256 * MF), (const bf16_t*)(ws + WS_MWD), MF / 2, MF / 2, MF / 2};
                pg8::MoeOrder S{c0, lg, 4, G, bid, (const int*)(ws + WS_TILEE), 1024 * MF};
                pg8::EpiMoeDown E{(const int*)(ws + WS_ROWINFO), (const float*)(ws + WS_ROWW), (bf16_t*)(ws + WS_Y01), 1.f / 512.f};
                pg8::gemm_phase<pg8::EpiMoeDown, pg8::MoeOrder, true>(lds, g, S, E, wave);
            }
            if (k <= 4) { const int c = k; const int c0 = 64 * c, lg = c < 4 ? 6 : 3;
                pg8::Gemm g{(const bf16_t*)(ws + WS_XG), (const bf16_t*)(ws + WS_MWGU), 512, 512, 512};
                pg8::MoeOrder S{c0, lg, 28, G, bid, (const int*)(ws + WS_TILEE), 7168 * 1024};
                pg8::EpiSwiGLU8 E{ws + WS_HIDM + (size_t)(c & 1) * HIDB, MF, c0 * 256, 1.f / 512.f};
                pg8::gemm_phase<pg8::EpiSwiGLU8, pg8::MoeOrder, true>(lds, g, S, E, wave);
            }
            SEAM();
        }
    }
    if (IN(31)) { const int lane = my_lane(); const int tid = wave * 64 + lane; DSTAMP(31); ph_final(a, lane, wave, bid, G); DSTAMP(32); }
#undef IN
#undef SEAM
}


#ifdef DBG_SCAN
constexpr int CW_DBG = 9000;
__global__ void dbg_scan(const void* p, size_t n, int flags, int code, unsigned* ctl) { const int is_bf16 = flags & 1; const unsigned te = 127u + (unsigned)(flags >> 8);
    size_t i = (size_t)blockIdx.x * blockDim.x + threadIdx.x, st = (size_t)gridDim.x * blockDim.x; bool bad = false;
    if (is_bf16) { const unsigned short* q = (const unsigned short*)p; for (; i < n; i += st) { const unsigned v = q[i]; if (((v >> 7) & 0xffu) >= te) bad = true; } }
    else { const unsigned* q = (const unsigned*)p; for (; i < n; i += st) { const unsigned v = q[i]; if (((v >> 23) & 0xffu) >= te) bad = true; } }
    if (bad) atomicMax(ctl + CW_DBG, (unsigned)(1000 - code));
}
__global__ void dbg_scan2(const unsigned short* p, int rows, int ld, int c0, int nc, int code, unsigned* ctl) {
    size_t i = (size_t)blockIdx.x * blockDim.x + threadIdx.x, st = (size_t)gridDim.x * blockDim.x; bool bad = false;
    for (; i < (size_t)rows * nc; i += st) { const unsigned v = p[(i / nc) * ld + c0 + (i % nc)]; if (((v >> 7) & 0xffu) >= 127u + 6u) bad = true; }
    if (bad) atomicMax(ctl + CW_DBG, (unsigned)(1000 - code));
}
__global__ void dbg_delta(const float* a, const float* b, size_t n, int slot, unsigned* ctl) {
    size_t i = (size_t)blockIdx.x * blockDim.x + threadIdx.x, st = (size_t)gridDim.x * blockDim.x; float d = 0.f, r = 0.f;
    for (; i < n; i += st) { const float x = a[i], y = b[i]; d += (x - y) * (x - y); r += y * y; }
    for (int o = 32; o >= 1; o >>= 1) { d += __shfl_xor(d, o); r += __shfl_xor(r, o); }
    if ((threadIdx.x & 63) == 0) { atomicAdd((float*)ctl + 9010 + 2 * slot, d); atomicAdd((float*)ctl + 9011 + 2 * slot, r); }
}
__device__ int dbg_digit(float d, float r) { const float q = d / r; if (!(q == q)) return 9; int k = (int)rintf(-log2f(q)); return k < 0 ? 0 : (k > 8 ? 8 : k); }
__global__ void dbg_emit2(float* out, const unsigned* ctl, int s0, int s1) { const float* cf = (const float*)ctl;
    const int A = dbg_digit(cf[9010 + 2 * s0], cf[9011 + 2 * s0]), B = dbg_digit(cf[9010 + 2 * s1], cf[9011 + 2 * s1]); out[0] = sqrtf(33554432.f * (float)(10 * A + B)); }
__global__ void dbg_emit(float* out, const unsigned* ctl) { const float* cf = (const float*)ctl; const float msv = cf[9001] / 33554432.f, mso = cf[9002] / 33554432.f;
    int A = (int)rintf(log2f(msv)) + 4; A = A < 0 ? 0 : (A > 8 ? 8 : A); int B = (int)rintf(log2f(mso)) + 4; B = B < 0 ? 0 : (B > 8 ? 8 : B); if (ctl[9003]) B = 9;
    out[0] = sqrtf(33554432.f * (float)(10 * A + B)); }
#endif
#ifdef DBG_STAMP
__global__ void dbg_emit_t(float* out, const unsigned long long* st, int a0, int a1, int b0, int b1, float ua, float ub) {
    const size_t i = (size_t)blockIdx.x * blockDim.x + threadIdx.x;
    const float ta = (float)(st[a1] - st[a0]) * 0.01f, tb = (float)(st[b1] - st[b0]) * 0.01f;
    const float A = (10.f + fminf(89.f, fmaxf(0.f, rintf(2.f * log2f(ta / 10.f))))) * 100.f, B = (10.f + fminf(89.f, fmaxf(0.f, rintf(2.f * log2f(tb / 10.f))))) * 10.f;
    if (i == 0) out[0] = A; else if (i <= 4000000) out[i] = B; else if (i < 33554432) out[i] = 0.f;
}
#endif
extern "C" void kernel_launch(void* const* d_in, const int* in_sizes, int n_in, void* d_out, int out_size, void* d_ws, size_t ws_size, hipStream_t stream) {
    static int grid = 0;
    if (grid == 0) {
        if (n_in != 26 || in_sizes[0] != ML * DM || out_size != ML * DM || ws_size < WS_NEED) { fprintf(stderr, "kernel_launch: unexpected problem (n_in %d, ws %zu, need %zu)\n", n_in, ws_size, (size_t)WS_NEED); grid = -1; return; }
        int dev = 0, cus = 0, per_cu = 0;
        if (hipGetDevice(&dev) != hipSuccess || hipDeviceGetAttribute(&cus, hipDeviceAttributeMultiprocessorCount, dev) != hipSuccess) { grid = -1; return; }
        if (hipFuncSetAttribute((const void*)mega, hipFuncAttributeMaxDynamicSharedMemorySize, LDS_BYTES) != hipSuccess) { fprintf(stderr, "kernel_launch: hipFuncSetAttribute failed\n"); grid = -1; return; }
        if (hipOccupancyMaxActiveBlocksPerMultiprocessor(&per_cu, (const void*)mega, 512, LDS_BYTES) != hipSuccess || per_cu < 1) fprintf(stderr, "kernel_launch: occupancy query says %d\n", per_cu);
        (void)hipGetLastError();
        grid = cus;
    }
    if (grid < 0) return;
    if (hipMemsetAsync((char*)d_ws + WS_CTL, 0, 1 * MiB, stream) != hipSuccess) return;
    Args a{};
    for (int i = 0; i < 26; ++i) a.in[i] = (const float*)d_in[i];
    a.out = (float*)d_out; a.ws = (unsigned char*)d_ws;
#if N_LAUNCH_MODE == 1
    a.ph_lo = 0; a.ph_hi = NPH;
    hipLaunchKernelGGL(mega, dim3(grid), dim3(512), LDS_BYTES, stream, a);
#ifdef DBG_STAMP
    hipLaunchKernelGGL(dbg_emit_t, dim3(32768), dim3(1024), 0, stream, (float*)d_out, (const unsigned long long*)((char*)d_ws + WS_CTL + 40960), ST_A0, ST_A1, ST_B0, ST_B1, ST_UA, ST_UB);
#endif
#else
    for (int p = 0; p < NPH; ++p) {
        if (p == 12 || p == 23 || p == 24) continue;
        a.ph_lo = p; a.ph_hi = p + 1; a.qbank = 0;
        hipLaunchKernelGGL(mega, dim3(grid), dim3(512), LDS_BYTES, stream, a);
#ifdef DUP_LIST
        { const int dl[] = DUP_LIST; for (int q = 0; q < (int)(sizeof(dl) / sizeof(int)); ++q) if (dl[q] == p) { a.qbank = 1; a.umask = DUP_UMASK; hipLaunchKernelGGL(mega, dim3(grid), dim3(512), LDS_BYTES, stream, a); a.qbank = 0; a.umask = 0; } }
#endif
#ifdef DBG_SCAN
        {
            unsigned char* ws = (unsigned char*)d_ws; unsigned* ctl = (unsigned*)(ws + WS_CTL);
#define SCAN(ptr, n, bf, code) SCANT(ptr, n, bf, code, 6)
#define SCANT(ptr, n, bf, code, TE) hipLaunchKernelGGL(dbg_scan, dim3(1024), dim3(256), 0, stream, (const void*)(ptr), (size_t)(n), (bf) | ((TE) << 8), code, ctl)
            const int L = p >= 13 ? 1 : 0, k = p == 0 ? -1 : (p - 1) % 12; const int cb = 1 + (p == 0 ? 0 : 4 + L * 40 + k * 3);
            const size_t nm = (L == 0 ? MT : ML);
            if (p == 0) { SCAN(ws + WS_MOD, 2 * 5 * 6144, 0, 1); SCAN(ws + WS_ROPER, 8192 * 64 + 8192 * 32, 0, 2); SCAN(ws + WS_WNG, (WS_RWEND - WS_WNG) / 2, 1, 3); SCAN(ws + WS_M1, 256 * 128, 1, 4); SCAN(ws + WS_WUQ, 2 * 384 * 192, 1, 4); SCAN(ws + WS_WUKV, 2 * 512 * 128, 1, 4); }
            else if (p < 25) {
                if (k == 0) SCAN(ws + WS_H, (size_t)MT * 1024, 1, cb);
                if (k == 1) SCAN(ws + WS_U, (size_t)UT * MT * 256, 1, cb);
                if (k == 2) { SCANT(ws + WS_A2, (size_t)4 * 64 * 128 * 256 * 2, 1, cb, 14); SCANT(ws + WS_ST, (size_t)2 * 16 * 66 * 4096, 0, cb + 1, 14); SCAN(ws + WS_MK, (size_t)16 * 8448 * 96 + (size_t)16 * 64 * 8448, 1, cb + 2); SCAN(ws + WS_MQ, (size_t)16 * 8192 * 96, 1, cb + 2); }
                if (k == 3) SCANT(ws + WS_ST, (size_t)2 * 16 * 64 * 4096, 0, cb, 14);
                if (k == 4) { for (int r4 = 0; r4 < 4; ++r4) { hipLaunchKernelGGL(dbg_scan2, dim3(1024), dim3(256), 0, stream, (const unsigned short*)(ws + WS_YBR), ML, 1024, r4 * 256, 256, (L == 0 ? 15 : 55) + r4, ctl); if (L == 0) hipLaunchKernelGGL(dbg_scan2, dim3(1024), dim3(256), 0, stream, (const unsigned short*)(ws + WS_YBR) + (size_t)ML * 1024, MC, 1024, r4 * 256, 256, 19, ctl); } }
                if (k == 5) SCAN(ws + WS_SG, nm * 4096, 1, cb);
                if (k == 6) SCAN(ws + WS_H, nm * 1024, 1, cb);
                if (k == 7) { SCAN(d_out, (size_t)ML * 1024, 0, cb); if (L == 0) SCAN(ws + WS_XC, (size_t)MC * 1024, 0, cb + 1); }
                if (k == 8 && L == 0) SCAN(ws + WS_H, (size_t)MT * 1024, 1, cb);
                if (k == 9 && L == 0) SCAN(ws + WS_HID, (size_t)MT * FF, 1, cb);
                if (k == 10 && L == 0) { SCAN(d_out, (size_t)ML * 1024, 0, cb); SCAN(ws + WS_XC, (size_t)MC * 1024, 0, cb + 1); }
            } else if (p == 34) SCAN(ws + WS_Y01, (size_t)2 * ML * 1024, 1, 95);
            if (p == 8) hipLaunchKernelGGL(dbg_delta, dim3(1024), dim3(256), 0, stream, (const float*)d_out, (const float*)d_in[0], (size_t)ML * 1024, 0, ctl);
            if (p == 11) hipLaunchKernelGGL(dbg_delta, dim3(1024), dim3(256), 0, stream, (const float*)d_out, (const float*)d_in[0], (size_t)ML * 1024, 1, ctl);
            if (p == 20) hipLaunchKernelGGL(dbg_delta, dim3(1024), dim3(256), 0, stream, (const float*)d_out, (const float*)d_in[0], (size_t)ML * 1024, 2, ctl);
            if (p == 35) { hipLaunchKernelGGL(dbg_delta, dim3(1024), dim3(256), 0, stream, (const float*)d_out, (const float*)d_in[0], (size_t)ML * 1024, 3, ctl); hipMemsetAsync(d_out, 0, (size_t)ML * 1024 * 4, stream); }
            if (p == 35) hipLaunchKernelGGL(dbg_emit2, dim3(1), dim3(1), 0, stream, (float*)d_out, (const unsigned*)ctl, DBG_S0, DBG_S1);
        }
#endif
    }
#endif
}
```

```cpp
#include <hip/hip_runtime.h>
#include <stdint.h>
#include <stdio.h>

#define LAS __attribute__((address_space(3)))
typedef unsigned short bf16_t;
typedef short bf16x8 __attribute__((ext_vector_type(8)));
typedef float f32x2 __attribute__((ext_vector_type(2)));
typedef float f32x4 __attribute__((ext_vector_type(4)));
typedef float f32x16 __attribute__((ext_vector_type(16)));
typedef unsigned u32x2 __attribute__((ext_vector_type(2)));
typedef unsigned u32x4 __attribute__((ext_vector_type(4)));

#define DBG_S0 2
#define DBG_S1 3
#ifndef DUP_UMASK
#define DUP_UMASK 0
#endif
#ifndef N_LAUNCH_MODE
#define N_LAUNCH_MODE 1
#endif

constexpr int NB = 4, SEQ = 8192, DM = 1024, CTXL = 256;
constexpr int ML = NB * SEQ, MC = NB * CTXL, MT = ML + MC;
constexpr int INC = 6752;
constexpr int UT = 11;
constexpr int FF = 2816, MF = 3584, NE = 8;
constexpr int NRMAX = 65536 + 2048;
constexpr float EPS = 1e-6f;
constexpr float LOG2E = 1.4426950408889634f;

constexpr size_t MiB = 1u << 20;
constexpr size_t WS_CTL = 0;
constexpr size_t WS_MOD = 1 * MiB;
constexpr size_t WS_ROPER = WS_MOD + 256 * 1024;
constexpr size_t WS_ROPEM = WS_ROPER + 2 * MiB;
constexpr size_t WS_M1 = WS_ROPEM + 1 * MiB;
constexpr size_t WS_TW = WS_M1 + 64 * 1024;
constexpr size_t WS_D2 = WS_TW + 64 * 1024;
constexpr size_t WS_EP = WS_D2 + 32 * 1024;
constexpr size_t WS_XC = WS_EP + 16 * 1024;
constexpr size_t WS_CPQ = WS_XC + 4 * MiB;
constexpr size_t WS_WUQ = WS_CPQ + 2 * MiB;
constexpr size_t WS_WUKV = WS_WUQ + 512 * 1024;
constexpr size_t WS_ROWINFO = WS_WUKV + 512 * 1024;
constexpr size_t WS_ROWW = WS_ROWINFO + 512 * 1024;
constexpr size_t WS_TOK = WS_ROWW + 512 * 1024;
constexpr size_t WS_TILEE = WS_TOK + 512 * 1024;
constexpr size_t WS_WGCNT = WS_TILEE + 4096;
constexpr size_t WS_R0END = 16 * MiB;
static_assert(WS_WGCNT + 16384 <= WS_R0END, "R0");
constexpr size_t WS_WNG = WS_R0END;
constexpr size_t WS_WG = WS_WNG + (size_t)2 * 2816 * 1024 * 2;
constexpr size_t WS_WB = WS_WG + (size_t)2 * 4096 * 1024 * 2;
constexpr size_t WS_WO = WS_WB + (size_t)2 * 4 * 1024 * 256 * 2;
constexpr size_t WS_WGU = WS_WO + (size_t)2 * 1024 * 1024 * 2;
constexpr size_t WS_WD = WS_WGU + (size_t)5632 * 1024 * 2;
constexpr size_t WS_RWEND = WS_WD + (size_t)1024 * 2816 * 2;
constexpr size_t WS_H = WS_RWEND;
constexpr size_t WS_YBR = WS_H + (size_t)MT * 1024 * 2;
constexpr size_t WS_MSCR = WS_YBR + (size_t)MT * 1024 * 2;
constexpr size_t WS_H8 = WS_MSCR;
constexpr size_t WS_WG8 = WS_H8 + (size_t)MT * 1024;
static_assert(WS_WG8 + (size_t)2 * 4096 * 1024 <= WS_MSCR + (size_t)256 * 262144, "fp8 region");
constexpr size_t WS_BIG = WS_MSCR + (size_t)256 * 262144;
constexpr size_t WS_U = WS_BIG;
constexpr size_t WS_ST = WS_U + (size_t)UT * MT * 256 * 2;
constexpr size_t WS_STC = WS_ST + (size_t)2 * 16 * 64 * 4096 * 4;
constexpr size_t WS_A2 = WS_STC + (size_t)2 * 16 * 2 * 4096 * 4;
constexpr size_t WS_MQ = WS_A2 + (size_t)4 * 64 * 128 * 256 * 4;
constexpr size_t WS_MQC = WS_MQ + (size_t)16 * 8192 * 96 * 2;
constexpr size_t WS_MK = WS_MQC + (size_t)16 * 256 * 96 * 2;
constexpr size_t WS_MVT = WS_MK + (size_t)16 * 8448 * 104 * 2;
constexpr size_t WS_NVT = WS_MVT + (size_t)16 * 132 * 64 * 72 * 2;
constexpr size_t WS_BIGEND = WS_NVT + (size_t)16 * 64 * 8448 * 2;
constexpr size_t WS_SG = WS_BIG;
constexpr size_t WS_HID = WS_BIG;
static_assert(WS_SG + (size_t)MT * 4096 * 2 <= WS_BIGEND, "SG overlay");
constexpr size_t WS_MWGU = WS_R0END;
constexpr size_t WS_MWD = WS_MWGU + (size_t)8 * 7168 * 1024 * 2;
constexpr size_t WS_XG = WS_MWD + (size_t)8 * 1024 * 3584 * 2;
constexpr size_t WS_HIDM = WS_XG + (size_t)NRMAX * 1024 * 2;
constexpr size_t WS_Y01 = WS_HIDM + (size_t)72 * 256 * 3584 * 2;
constexpr size_t WS_MOEEND = WS_Y01 + (size_t)2 * ML * 1024 * 2;
constexpr size_t WS_NEED = WS_BIGEND > WS_MOEEND ? WS_BIGEND : WS_MOEEND;

constexpr int CW_BAR = 0, CW_Q = 16384, CW_CNT = 8192, CW_CUR = 8256;

constexpr int LDS_BYTES = 147456;
constexpr int LDS_MISC = 143360;

__device__ __forceinline__ float bf2f(unsigned h) { return __uint_as_float(h << 16); }
__device__ __forceinline__ float bflo(unsigned w) { return __uint_as_float(w << 16); }
__device__ __forceinline__ float bfhi(unsigned w) { return __uint_as_float(w & 0xffff0000u); }
typedef __bf16 bf16x2_t __attribute__((ext_vector_type(2)));
__device__ __forceinline__ unsigned pk2(float lo, float hi) { f32x2 v = {lo, hi}; bf16x2_t b = __builtin_convertvector(v, bf16x2_t); return __builtin_bit_cast(unsigned, b); }
__device__ __forceinline__ unsigned f2bf(float f) { return pk2(f, 0.f) & 0xffffu; }
__device__ __forceinline__ unsigned pk4_fp8(float a, float b, float c, float d) { int w = __builtin_amdgcn_cvt_pk_fp8_f32(a, b, 0, false); w = __builtin_amdgcn_cvt_pk_fp8_f32(c, d, w, true); return (unsigned)w; }
template <int CTRL> __device__ __forceinline__ float dppf(float x) { return __builtin_bit_cast(float, __builtin_amdgcn_mov_dpp(__builtin_bit_cast(int, x), CTRL, 0xf, 0xf, true)); }
__device__ __forceinline__ float xhalf_sum(float x) { auto t = __builtin_amdgcn_permlane32_swap(__float_as_uint(x), __float_as_uint(x), false, false); return __uint_as_float(t[0]) + __uint_as_float(t[1]); }
__device__ __forceinline__ float xhalf_max(float x) { auto t = __builtin_amdgcn_permlane32_swap(__float_as_uint(x), __float_as_uint(x), false, false); return fmaxf(__uint_as_float(t[0]), __uint_as_float(t[1])); }
__device__ __forceinline__ float wave_sum(float v) {
    v += dppf<0xB1>(v); v += dppf<0x4E>(v);
    v += dppf<0x141>(v); v += dppf<0x128>(v);
    auto s = __builtin_amdgcn_permlane16_swap(__float_as_uint(v), __float_as_uint(v), false, false); v = __uint_as_float(s[0]) + __uint_as_float(s[1]);
    return xhalf_sum(v);
}
__device__ __forceinline__ float fexp2(float x) { return __builtin_amdgcn_exp2f(x); }
__device__ __forceinline__ float siluf(float x) { return x * __builtin_amdgcn_rcpf(1.f + __expf(-x)); }
__device__ __forceinline__ int crow(int r, int hi) { return (r & 3) + 8 * (r >> 2) + 4 * hi; }
__device__ __forceinline__ f32x16 mfma32(bf16x8 a, bf16x8 b, f32x16 c) { return __builtin_amdgcn_mfma_f32_32x32x16_bf16(a, b, c, 0, 0, 0); }
__device__ __forceinline__ f32x16 zero16() { f32x16 z;
#pragma unroll
    for (int i = 0; i < 16; ++i) z[i] = 0.f;
    return z; }
__device__ __forceinline__ bf16x8 as_bf16x8(u32x4 w) { return __builtin_bit_cast(bf16x8, w); }
#define LDS_WAIT() asm volatile("s_waitcnt lgkmcnt(0)" ::: "memory")
__device__ __forceinline__ int my_lane() { int l; asm volatile("v_mbcnt_lo_u32_b32 %0, -1, 0\n\tv_mbcnt_hi_u32_b32 %0, -1, %0" : "=v"(l)); return l; }

#define XB_TMO      128
#define XB_XCNT(j)  (256  + 64 * (j))
#define XB_XSUB(j)  (1280 + 64 * (j))
#define XB_XGEN(j)  (2304 + 64 * (j))
#define XB_TOP      3328
#define XB_TOPGEN   3392
#define XCD_BAR_WORDS 3456
#define XB_SPIN_CAP (1u << 22)
__device__ __forceinline__ unsigned xb_ld(unsigned* p)              { return __hip_atomic_load(p, __ATOMIC_RELAXED, __HIP_MEMORY_SCOPE_AGENT); }
__device__ __forceinline__ unsigned xb_add(unsigned* p, unsigned v) { return __hip_atomic_fetch_add(p, v, __ATOMIC_RELAXED, __HIP_MEMORY_SCOPE_AGENT); }
__device__ __forceinline__ unsigned xb_xcc_id() { return (unsigned)__builtin_amdgcn_s_getreg((3 << 11) | 20) & 0xFu; }
#define XB_SPIN(cond, bar) do { unsigned _sp = 0; while (cond) { __builtin_amdgcn_s_sleep(1); \
    if ((++_sp & 255u) == 0u) { if (xb_ld(&(bar)[XB_TMO])) break; if (_sp > XB_SPIN_CAP) { atomicAdd(&(bar)[XB_TMO], 1u); break; } } } } while (0)
struct XcdBarrier { unsigned* bar; unsigned x; volatile LAS unsigned* st; };
__device__ __forceinline__ XcdBarrier xcd_barrier_post(unsigned* bar, volatile LAS unsigned* st, bool leader) {
    XcdBarrier b; b.bar = bar; b.x = xb_xcc_id(); b.st = st;
    if (leader) (void)xb_add(&bar[XB_XCNT(b.x)], 1u);
    return b;
}
__device__ __forceinline__ void xcd_barrier_complete(unsigned* bar, unsigned x, unsigned& nloc, unsigned& nx) {
    const unsigned G = gridDim.x * gridDim.y * gridDim.z;
    unsigned sum, cnt, mine, sp = 0u;
    for (;;) {
        sum = 0u; cnt = 0u; mine = 0u;
#pragma unroll
        for (unsigned j = 0; j < 16; ++j) { const unsigned c = xb_ld(&bar[XB_XCNT(j)]); sum += c; cnt += (c > 0u) ? 1u : 0u; mine = (j == x) ? c : mine; }
        if (sum == G) break;
        __builtin_amdgcn_s_sleep(1);
        if ((++sp & 255u) == 0u) { if (xb_ld(&bar[XB_TMO])) break; if (sp > XB_SPIN_CAP) { atomicAdd(&bar[XB_TMO], 1u); break; } }
    }
    nloc = mine > 0u ? mine : 1u; nx = cnt > 0u ? cnt : 1u;
}
__device__ __forceinline__ void xcd_barrier(const XcdBarrier& b, bool leader) {
    asm volatile("s_waitcnt vmcnt(0)" ::: "memory");
    __syncthreads();
    if (leader) {
        unsigned* bar = b.bar;
        __builtin_amdgcn_s_waitcnt(0);
        unsigned nloc = b.st[0], nx = b.st[1];
        if (nloc == 0u) { xcd_barrier_complete(bar, b.x, nloc, nx); b.st[0] = nloc; b.st[1] = nx; }
        const unsigned old = xb_add(&bar[XB_XSUB(b.x)], 1u);
        const unsigned gen = old / nloc;
        if (old + 1u == (gen + 1u) * nloc) {
            __builtin_amdgcn_fence(__ATOMIC_RELEASE, "agent");
            asm volatile("s_waitcnt vmcnt(0)" ::: "memory");
            const unsigned og = xb_add(&bar[XB_TOP], 1u);
            const unsigned tg = og / nx;
            if (og + 1u == (tg + 1u) * nx) xb_add(&bar[XB_TOPGEN], 1u);
            else XB_SPIN(xb_ld(&bar[XB_TOPGEN]) == tg, bar);
            __builtin_amdgcn_fence(__ATOMIC_ACQUIRE, "agent");
            xb_add(&bar[XB_XGEN(b.x)], 1u);
            asm volatile("s_waitcnt vmcnt(0)" ::: "memory");
        } else {
            XB_SPIN(xb_ld(&bar[XB_XGEN(b.x)]) == gen, bar);
            __builtin_amdgcn_fence(__ATOMIC_ACQUIRE, "agent");
            asm volatile("s_waitcnt vmcnt(0)" ::: "memory");
        }
    }
    __syncthreads();
}

namespace pg8 {
constexpr int BM = 256, BK = 64, HALF = 128, HTB = HALF * BK * 2, STAGE_BYTES = 8 * HTB, NXCD = 8, WGM = 8;
__host__ __device__ __forceinline__ int lds_byte(int r, int c) { const int st = (r >> 4) * 2 + (c >> 5), rr = r & 15, cc = c & 31, ob = rr * 64 + cc * 2; return st * 1024 + (ob ^ (((ob >> 9) & 1) << 5)); }
__host__ __device__ __forceinline__ void stage_rc(int b, int& R, int& C) { const int st = b / 1024, sb = b % 1024, swz = sb ^ (((sb >> 9) & 1) << 5); R = (st >> 1) * 16 + swz / 64; C = (st & 1) * 32 + (swz % 64) / 2; }
__host__ __device__ __forceinline__ int perm32(int rho) { const int n = rho >> 4, i = rho & 15; return 8 * (i >> 2) + 4 * n + (i & 3); }

struct Unit { int pm, pn, aux; int aofs, bofs; };
struct Gemm { const bf16_t* A; const bf16_t* Bt; int lda, ldb, K; };

struct StaticOrder {
    int nM, nN, nwg, G, c;
    __device__ void init(int nM_, int nN_, int G_, int c_) { nM = nM_; nN = nN_; nwg = nM * nN; G = G_; c = c_; }
    __device__ bool next(int i, Unit& u) const {
        const long L = (long)i * G + c; if (L >= nwg) return false;
        int wgid = (int)L; { const int q = nwg / NXCD, r = nwg % NXCD, xcd = wgid % NXCD, off = wgid / NXCD; wgid = (xcd < r ? xcd * (q + 1) : r * (q + 1) + (xcd - r) * q) + off; }
        const int nig = WGM * nN, gid = wgid / nig, fm = gid * WGM, gsz = (nM - fm) < WGM ? (nM - fm) : WGM;
        u.pm = fm + ((wgid % nig) % gsz); u.pn = (wgid % nig) / gsz; u.aux = 0; u.aofs = 0; u.bofs = 0; return true;
    }
};
struct TableOrder {
    const LAS int* tab; int n;
    __device__ bool next(int i, Unit& u) const { if (i >= n) return false; u.pm = __builtin_amdgcn_readfirstlane(tab[2 * i]); u.pn = __builtin_amdgcn_readfirstlane(tab[2 * i + 1]); u.aux = 0; u.aofs = 0; u.bofs = 0; return true; }
};
struct MergeOrder {
    StaticOrder so;
    __device__ bool next(int i, Unit& u) const { if (!so.next(i >> 2, u)) return false; const int s = i & 3; u.aux = s; u.aofs = s * 256 * 2; u.bofs = s * 1024 * 256 * 2; return true; }
};
struct MoeOrder {
    int c0, lg, nN, G, c; const int* tile_e; int bstride;
    __device__ bool next(int i, Unit& u) const {
        const int L = i * G + c; if (L >= (nN << lg)) return false;
        u.pm = __builtin_amdgcn_readfirstlane(c0 + (L & ((1 << lg) - 1))); u.pn = __builtin_amdgcn_readfirstlane(L >> lg); u.aux = 0; u.aofs = 0;
        int e = __builtin_amdgcn_readfirstlane(tile_e[u.pm]); e = e < 0 ? 0 : e; u.bofs = e * bstride; return true;
    }
};

typedef int i32x8 __attribute__((ext_vector_type(8)));
template <class Epi, class Sched, bool F8 = false>
__device__ __forceinline__ void gemm_phase(LAS unsigned char* lds, const Gemm g, const Sched& S, const Epi& E, int wid) {
    const int lane = my_lane(), tid = wid * 64 + lane;
    const int wr = wid >> 2, wc = wid & 3, fr = lane & 15, fq = lane >> 4;
    const int K = g.K, nt = K / BK;
    unsigned v_offA, v_offB;
    { int R, C; stage_rc(tid * 16, R, C); const int Rb = Epi::PERM ? ((R & ~31) + perm32(R & 31)) : R;
        v_offA = (unsigned)(R * g.lda + C) * 2u; v_offB = (unsigned)(Rb * g.ldb + C) * 2u; }
    const unsigned rstep_offA = 64u * g.lda * 2u, rstep_offB = 64u * g.ldb * 2u;
    const unsigned kstep = (unsigned)(BK * 2);
    const unsigned hstepA = (unsigned)HALF * g.lda * 2u, hstepB = (unsigned)HALF * g.ldb * 2u;
    const unsigned tstepA = 2u * hstepA, tstepB = 2u * hstepB;
    const unsigned ldsw = (unsigned)wid * 1024u;
    const __amdgpu_buffer_rsrc_t rs_offA = __builtin_amdgcn_make_buffer_rsrc((void*)g.A, 0, 0x7fffffff, 0x00020000), rs_offB = __builtin_amdgcn_make_buffer_rsrc((void*)g.Bt, 0, 0x7fffffff, 0x00020000);
    const int aoff = lds_byte(wr * 64 + fr, F8 ? fq * 16 : fq * 8), boff = lds_byte(wc * 32 + fr, F8 ? fq * 16 : fq * 8);
#define PG8_SA(b, h) (((b) * 2 + (h)) * HTB)
#define PG8_SB(b, h) ((4 + (b) * 2 + (h)) * HTB)
#define PG8_STAGE(bufoff, gbase, voff) do { _Pragma("unroll") for (int _i = 0; _i < 2; ++_i) \
        __builtin_amdgcn_raw_ptr_buffer_load_lds(rs_##voff, (LAS void*)(lds + (bufoff) + ldsw + _i * 8192), 16, (int)(v_##voff), (int)((gbase) + _i * rstep_##voff), 0, 0); } while (0)
#define PG8_LD8(p) ({ const u32x4 lo_ = *(const LAS u32x4*)(p), hi_ = *(const LAS u32x4*)((p) + 16); (i32x8){(int)lo_.x, (int)lo_.y, (int)lo_.z, (int)lo_.w, (int)hi_.x, (int)hi_.y, (int)hi_.z, (int)hi_.w}; })
#define PG8_LDA(dst, b, h) do { if constexpr (F8) { _Pragma("unroll") for (int m = 0; m < 4; ++m) dst##8[m] = PG8_LD8(lds + PG8_SA(b, h) + aoff + m * 2048); } \
        else { _Pragma("unroll") for (int m = 0; m < 4; ++m) _Pragma("unroll") for (int k = 0; k < 2; ++k) dst[m][k] = *(const LAS bf16x8*)(lds + PG8_SA(b, h) + aoff + m * 2048 + k * 1024); } } while (0)
#define PG8_LDB(dst, b, h) do { if constexpr (F8) { _Pragma("unroll") for (int n = 0; n < 2; ++n) dst##8[n] = PG8_LD8(lds + PG8_SB(b, h) + boff + n * 2048); } \
        else { _Pragma("unroll") for (int n = 0; n < 2; ++n) _Pragma("unroll") for (int k = 0; k < 2; ++k) dst[n][k] = *(const LAS bf16x8*)(lds + PG8_SB(b, h) + boff + n * 2048 + k * 1024); } } while (0)
#define PG8_MMA(ai, bj, At, Bt) do { __builtin_amdgcn_s_setprio(1); \
        if constexpr (F8) { _Pragma("unroll") for (int m = 0; m < 4; ++m) _Pragma("unroll") for (int n = 0; n < 2; ++n) \
            acc[ai][bj][m][n] = __builtin_amdgcn_mfma_scale_f32_16x16x128_f8f6f4(Bt##8[n], At##8[m], acc[ai][bj][m][n], 0, 0, 0, 0x7f7f7f7f, 0, 0x7f7f7f7f); } \
        else { _Pragma("unroll") for (int m = 0; m < 4; ++m) _Pragma("unroll") for (int n = 0; n < 2; ++n) _Pragma("unroll") for (int k = 0; k < 2; ++k) \
            acc[ai][bj][m][n] = __builtin_amdgcn_mfma_f32_16x16x32_bf16(Bt[n][k], At[m][k], acc[ai][bj][m][n], 0, 0, 0); } \
        __builtin_amdgcn_s_setprio(0); } while (0)
#define PG8_WAIT_V(n) asm volatile("s_waitcnt vmcnt(" #n ")" ::: "memory")
#define PG8_WAIT_L(n) asm volatile("s_waitcnt lgkmcnt(" #n ")" ::: "memory")
#define PG8_BAR __builtin_amdgcn_s_barrier()
#define PG8_SCHED __builtin_amdgcn_sched_barrier(0)
    Unit cur, nxt; int ui = 0;
    if (!S.next(0, cur)) return;
    f32x4 acc[2][2][4][2];
#pragma unroll
    for (int a = 0; a < 2; ++a)
#pragma unroll
        for (int b = 0; b < 2; ++b)
#pragma unroll
            for (int m = 0; m < 4; ++m)
#pragma unroll
                for (int n = 0; n < 2; ++n) acc[a][b][m][n] = (f32x4){0.f, 0.f, 0.f, 0.f};
    bf16x8 At[4][2], B0[2][2], B1[2][2]; i32x8 At8[4], B08[2], B18[2];
    unsigned cA = (unsigned)cur.aofs + (unsigned)cur.pm * tstepA, cB = (unsigned)cur.bofs + (unsigned)cur.pn * tstepB;
    PG8_STAGE(PG8_SB(0, 0), cB, offB); PG8_STAGE(PG8_SB(0, 1), cB + hstepB, offB); PG8_STAGE(PG8_SA(0, 0), cA, offA); PG8_STAGE(PG8_SA(0, 1), cA + hstepA, offA);
    if (wr == 1) PG8_BAR;
    PG8_WAIT_V(2); PG8_BAR;
    PG8_STAGE(PG8_SB(1, 0), cB + kstep, offB); PG8_STAGE(PG8_SA(1, 0), cA + kstep, offA); PG8_STAGE(PG8_SB(1, 1), cB + hstepB + kstep, offB);
    PG8_WAIT_V(6); PG8_BAR;
    for (;;) {
        const bool has_next = S.next(ui + 1, nxt);
        const unsigned nA = has_next ? (unsigned)nxt.aofs + (unsigned)nxt.pm * tstepA : cA, nB = has_next ? (unsigned)nxt.bofs + (unsigned)nxt.pn * tstepB : cB;
#pragma nounroll
        for (int t = 0; t < nt; t += 2) {
            const bool last = (t == nt - 2);
            const unsigned a1 = cA + (unsigned)(t + 1) * kstep;
            const unsigned a2 = last ? nA : cA + (unsigned)(t + 2) * kstep, b2 = last ? nB : cB + (unsigned)(t + 2) * kstep;
            const unsigned a3 = a2 + kstep, b3 = b2 + kstep;
            if constexpr (Epi::MIDK) { if (t != 0 && (t & 3) == 0) E.mid(acc, cur, t >> 2, wr, wc, fr, fq); }
            PG8_LDB(B0, 0, 0); PG8_LDB(B1, 0, 1); PG8_SCHED; PG8_LDA(At, 0, 0); PG8_STAGE(PG8_SA(1, 1), a1 + hstepA, offA);
            PG8_WAIT_V(8); PG8_WAIT_L(0); PG8_BAR; PG8_MMA(0, 0, At, B0); PG8_MMA(0, 1, At, B1); PG8_BAR; PG8_SCHED;
            PG8_LDA(At, 0, 1); PG8_STAGE(PG8_SB(0, 0), b2, offB); PG8_STAGE(PG8_SB(0, 1), b2 + hstepB, offB); PG8_STAGE(PG8_SA(0, 0), a2, offA);
            PG8_WAIT_V(8); PG8_WAIT_L(0); PG8_BAR; PG8_MMA(1, 0, At, B0); PG8_MMA(1, 1, At, B1); PG8_BAR; PG8_SCHED;
            PG8_LDB(B0, 1, 0); PG8_LDB(B1, 1, 1); PG8_SCHED; PG8_LDA(At, 1, 0); PG8_STAGE(PG8_SA(0, 1), a2 + hstepA, offA);
            PG8_WAIT_V(8); PG8_WAIT_L(0); PG8_BAR; PG8_MMA(0, 0, At, B0); PG8_MMA(0, 1, At, B1); PG8_BAR; PG8_SCHED;
            PG8_LDA(At, 1, 1); PG8_STAGE(PG8_SB(1, 0), b3, offB); PG8_STAGE(PG8_SB(1, 1), b3 + hstepB, offB); PG8_STAGE(PG8_SA(1, 0), a3, offA);
            PG8_WAIT_V(8); PG8_WAIT_L(0); PG8_BAR; PG8_MMA(1, 0, At, B0); PG8_MMA(1, 1, At, B1); PG8_BAR; PG8_SCHED;
        }
        if (wr == 0) PG8_BAR;
        E(acc, cur, wr, wc, fr, fq);
        if (!has_next) break;
#pragma unroll
        for (int a = 0; a < 2; ++a)
#pragma unroll
            for (int b = 0; b < 2; ++b)
#pragma unroll
                for (int m = 0; m < 4; ++m)
#pragma unroll
                    for (int n = 0; n < 2; ++n) acc[a][b][m][n] = (f32x4){0.f, 0.f, 0.f, 0.f};
        cur = nxt; cA = nA; cB = nB; ++ui;
        if (wr == 1) PG8_BAR;
    }
    PG8_WAIT_V(0);
    PG8_BAR;
#undef PG8_SA
#undef PG8_SB
#undef PG8_STAGE
#undef PG8_LDA
#undef PG8_LDB
#undef PG8_MMA
#undef PG8_LD8
#undef PG8_WAIT_V
#undef PG8_WAIT_L
#undef PG8_BAR
#undef PG8_SCHED
}

struct EpiTileBf16 {
    static constexpr bool PERM = true, MIDK = false;
    bf16_t* O; size_t tstride;
    __device__ __forceinline__ void operator()(const f32x4 (&acc)[2][2][4][2], const Unit& u, int wr, int wc, int fr, int fq) const {
        const int row0 = u.pm * BM + wr * 64 + fr; bf16_t* base = O + (size_t)u.pn * tstride; const int col0 = wc * 32 + 8 * fq;
#pragma unroll
        for (int ai = 0; ai < 2; ++ai)
#pragma unroll
            for (int m = 0; m < 4; ++m) { bf16_t* rowp = base + (size_t)(row0 + ai * HALF + m * 16) * 256 + col0;
#pragma unroll
                for (int bj = 0; bj < 2; ++bj) { const f32x4 v0 = acc[ai][bj][m][0], v1 = acc[ai][bj][m][1];
                    u32x4 w; w.x = pk2(v0[0], v0[1]); w.y = pk2(v0[2], v0[3]); w.z = pk2(v1[0], v1[1]); w.w = pk2(v1[2], v1[3]);
                    *(u32x4*)(rowp + bj * HALF) = w; } }
    }
};
struct EpiGateRatio {
    static constexpr bool PERM = true, MIDK = false;
    bf16_t* O; float descale;
    __device__ __forceinline__ void operator()(const f32x4 (&acc)[2][2][4][2], const Unit& u, int wr, int wc, int, int) const {
        const int l2 = my_lane(); const int fr = l2 & 15, fq = l2 >> 4;
        bf16_t* tb = O + ((size_t)((u.pm * 4 + (u.pn >> 2)) * 4 + (fq >> 1)) << 16) + ((wr * 64 + fr) << 8) + (u.pn & 3) * 64 + wc * 16 + 8 * (fq & 1);
#pragma unroll
        for (int ai = 0; ai < 2; ++ai)
#pragma unroll
            for (int m = 0; m < 4; ++m) { bf16_t* rowp = tb + ((ai * HALF + m * 16) << 8);
                f32x4 g0 = acc[ai][0][m][0], g1 = acc[ai][0][m][1], g2 = acc[ai][1][m][0], g3 = acc[ai][1][m][1];
#pragma unroll
                for (int j = 0; j < 4; ++j) {
                    const float k = -descale * LOG2E;
                    const float d0 = 1.f + fexp2(__builtin_amdgcn_fmed3f(g0[j] * k, -86.f, 86.f)), d1 = 1.f + fexp2(__builtin_amdgcn_fmed3f(g1[j] * k, -86.f, 86.f));
                    const float d2 = 1.f + fexp2(__builtin_amdgcn_fmed3f(g2[j] * k, -86.f, 86.f)), d3 = 1.f + fexp2(__builtin_amdgcn_fmed3f(g3[j] * k, -86.f, 86.f));
                    g0[j] = d1 * __builtin_amdgcn_rcpf(d0); g1[j] = d2 * __builtin_amdgcn_rcpf(d1); g2[j] = d3 * __builtin_amdgcn_rcpf(d2); g3[j] = __builtin_amdgcn_rcpf(d3); }
                u32x2 w0, w1, w2, w3; w0.x = pk2(g0[0], g0[1]); w0.y = pk2(g0[2], g0[3]); w1.x = pk2(g1[0], g1[1]); w1.y = pk2(g1[2], g1[3]);
                w2.x = pk2(g2[0], g2[1]); w2.y = pk2(g2[2], g2[3]); w3.x = pk2(g3[0], g3[1]); w3.y = pk2(g3[2], g3[3]);
                { auto t = __builtin_amdgcn_permlane32_swap(w0.x, w1.x, false, false); w0.x = t[0]; w1.x = t[1]; t = __builtin_amdgcn_permlane32_swap(w0.y, w1.y, false, false); w0.y = t[0]; w1.y = t[1]; }
                { auto t = __builtin_amdgcn_permlane32_swap(w2.x, w3.x, false, false); w2.x = t[0]; w3.x = t[1]; t = __builtin_amdgcn_permlane32_swap(w2.y, w3.y, false, false); w2.y = t[0]; w3.y = t[1]; }
                *(u32x4*)(rowp) = (u32x4){w0.x, w0.y, w1.x, w1.y};
                *(u32x4*)(rowp + 131072) = (u32x4){w2.x, w2.y, w3.x, w3.y}; }
    }
};
struct EpiMerge {
    static constexpr bool PERM = true, MIDK = true;
    const bf16_t* SG; bf16_t* M;
    __device__ __forceinline__ void mid(f32x4 (&acc)[2][2][4][2], const Unit& u, int seg, int wr, int wc, int fr, int fq) const {
        int lo = ((wr * 64 + fr) << 8) + wc * 32 + 8 * fq; asm volatile("" : "+v"(lo));
        const bf16_t* sgp = SG + ((size_t)((u.pm * 4 + u.pn) * 4 + (seg - 1)) << 16) + lo;
#pragma unroll
        for (int ai = 0; ai < 2; ++ai) {
            u32x4 s[4][2];
#pragma unroll
            for (int m = 0; m < 4; ++m)
#pragma unroll
                for (int bj = 0; bj < 2; ++bj) s[m][bj] = *(const u32x4*)(sgp + ((ai * HALF + m * 16) << 8) + bj * HALF);
#pragma unroll
            for (int m = 0; m < 4; ++m)
#pragma unroll
                for (int bj = 0; bj < 2; ++bj) { const u32x4 r = s[m][bj];
                    f32x4& v0 = acc[ai][bj][m][0]; f32x4& v1 = acc[ai][bj][m][1];
                    v0[0] *= bflo(r.x); v0[1] *= bfhi(r.x); v0[2] *= bflo(r.y); v0[3] *= bfhi(r.y);
                    v1[0] *= bflo(r.z); v1[1] *= bfhi(r.z); v1[2] *= bflo(r.w); v1[3] *= bfhi(r.w); }
            asm volatile("" ::: "memory"); }
    }
    __device__ __forceinline__ void operator()(const f32x4 (&acc)[2][2][4][2], const Unit& u, int wr, int wc, int fr, int fq) const {
        const int row0 = u.pm * BM + wr * 64 + fr; const int col0 = u.pn * BM + wc * 32 + 8 * fq;
        const bf16_t* sgp = SG + ((size_t)((u.pm * 4 + u.pn) * 4 + 3) << 16) + ((wr * 64 + fr) << 8) + wc * 32 + 8 * fq; bf16_t* mp = M + (size_t)row0 * 1024 + col0;
#pragma unroll
        for (int ai = 0; ai < 2; ++ai) {
            u32x4 sq[4][2];
#pragma unroll
            for (int m = 0; m < 4; ++m)
#pragma unroll
                for (int bj = 0; bj < 2; ++bj) sq[m][bj] = *(const u32x4*)(sgp + ((ai * HALF + m * 16) << 8) + bj * HALF);
            asm volatile("" ::: "memory");
#pragma unroll
            for (int m = 0; m < 4; ++m)
#pragma unroll
                for (int bj = 0; bj < 2; ++bj) { const u32x4 s = sq[m][bj];
                    const f32x4 v0 = acc[ai][bj][m][0], v1 = acc[ai][bj][m][1];
                    u32x4 w; w.x = pk2(v0[0] * bflo(s.x), v0[1] * bfhi(s.x)); w.y = pk2(v0[2] * bflo(s.y), v0[3] * bfhi(s.y));
                    w.z = pk2(v1[0] * bflo(s.z), v1[1] * bfhi(s.z)); w.w = pk2(v1[2] * bflo(s.w), v1[3] * bfhi(s.w));
                    *(u32x4*)(mp + (size_t)(ai * HALF + m * 16) * 1024 + bj * HALF) = w; }
            asm volatile("" ::: "memory"); }
    }
};
struct EpiResid {
    static constexpr bool PERM = false, MIDK = false;
    const float* sl; const float* sc; float* dl; float* dc; const float* gate; float dsc = 1.f;
    __device__ __forceinline__ void operator()(const f32x4 (&acc)[2][2][4][2], const Unit& u, int wr, int wc, int, int) const {
        const int l2 = my_lane(); const int fr = l2 & 15, fq = l2 >> 4;
        const int rt = u.pm * BM; const bool isc = rt >= ML;
        const float* src = isc ? sc + (size_t)(rt - ML) * 1024 : sl + (size_t)rt * 1024;
        float* dst = isc ? dc + (size_t)(rt - ML) * 1024 : dl + (size_t)rt * 1024;
        const float* gv = gate + (size_t)(isc ? 4 : (rt >> 13)) * 6144;
        const int col0 = u.pn * BM + wc * 32 + 4 * fq; const int r0 = wr * 64 + fr;
        f32x4 gg[2][2];
#pragma unroll
        for (int bj = 0; bj < 2; ++bj)
#pragma unroll
            for (int n = 0; n < 2; ++n) gg[bj][n] = *(const f32x4*)(gv + col0 + bj * HALF + n * 16) * dsc;
#pragma unroll
        for (int ai = 0; ai < 2; ++ai) {
            f32x4 x[4][2][2];
#pragma unroll
            for (int m = 0; m < 4; ++m)
#pragma unroll
                for (int bj = 0; bj < 2; ++bj)
#pragma unroll
                    for (int n = 0; n < 2; ++n) x[m][bj][n] = *(const f32x4*)(src + (size_t)(r0 + ai * HALF + m * 16) * 1024 + col0 + bj * HALF + n * 16);
            asm volatile("" ::: "memory");
#pragma unroll
            for (int m = 0; m < 4; ++m)
#pragma unroll
                for (int bj = 0; bj < 2; ++bj)
#pragma unroll
                    for (int n = 0; n < 2; ++n) *(f32x4*)(dst + (size_t)(r0 + ai * HALF + m * 16) * 1024 + col0 + bj * HALF + n * 16) = x[m][bj][n] + gg[bj][n] * acc[ai][bj][m][n];
            asm volatile("" ::: "memory"); }
    }
};
struct EpiSwiGLU {
    static constexpr bool PERM = true, MIDK = false;
    bf16_t* Hd; int ldc; int rowsub; float descale;
    __device__ __forceinline__ void operator()(const f32x4 (&acc)[2][2][4][2], const Unit& u, int wr, int wc, int, int) const {
        const int l2 = my_lane(); const int fr = l2 & 15, fq = l2 >> 4;
        const int row0 = u.pm * BM - rowsub + wr * 64 + fr; const int col0 = u.pn * HALF + wc * 32 + 8 * fq;
#pragma unroll
        for (int ai = 0; ai < 2; ++ai)
#pragma unroll
            for (int m = 0; m < 4; ++m) { bf16_t* rowp = Hd + (size_t)(row0 + ai * HALF + m * 16) * ldc + col0;
                f32x4 v0, v1;
#pragma unroll
                for (int j = 0; j < 4; ++j) { const float kg = -descale * LOG2E, k2 = descale * descale; const float a0 = acc[ai][0][m][0][j], a1 = acc[ai][0][m][1][j];
                    v0[j] = a0 * acc[ai][1][m][0][j] * k2 * __builtin_amdgcn_rcpf(1.f + fexp2(a0 * kg)); v1[j] = a1 * acc[ai][1][m][1][j] * k2 * __builtin_amdgcn_rcpf(1.f + fexp2(a1 * kg)); }
                u32x4 w; w.x = pk2(v0[0], v0[1]); w.y = pk2(v0[2], v0[3]); w.z = pk2(v1[0], v1[1]); w.w = pk2(v1[2], v1[3]);
                *(u32x4*)rowp = w; }
    }
};
struct EpiSwiGLU8 {
    static constexpr bool PERM = true, MIDK = false;
    unsigned char* Hd; int ldc; int rowsub; float descale;
    __device__ __forceinline__ void operator()(const f32x4 (&acc)[2][2][4][2], const Unit& u, int wr, int wc, int, int) const {
        const int l2 = my_lane(); const int fr = l2 & 15, fq = l2 >> 4;
        const int row0 = u.pm * BM - rowsub + wr * 64 + fr; const int col0 = u.pn * HALF + wc * 32 + 8 * fq;
#pragma unroll
        for (int ai = 0; ai < 2; ++ai)
#pragma unroll
            for (int m = 0; m < 4; ++m) { unsigned char* rowp = Hd + (size_t)(row0 + ai * HALF + m * 16) * ldc + col0;
                f32x4 v0, v1;
#pragma unroll
                for (int j = 0; j < 4; ++j) { const float kg = -descale * LOG2E, k2 = descale * descale * 8.f; const float a0 = acc[ai][0][m][0][j], a1 = acc[ai][0][m][1][j];
                    v0[j] = a0 * acc[ai][1][m][0][j] * k2 * __builtin_amdgcn_rcpf(1.f + fexp2(a0 * kg)); v1[j] = a1 * acc[ai][1][m][1][j] * k2 * __builtin_amdgcn_rcpf(1.f + fexp2(a1 * kg)); }
                u32x2 w; w.x = pk4_fp8(v0[0], v0[1], v0[2], v0[3]); w.y = pk4_fp8(v1[0], v1[1], v1[2], v1[3]);
                *(u32x2*)rowp = w; }
    }
};
struct EpiMoeDown {
    static constexpr bool PERM = true, MIDK = false;
    const int* rowinfo; const float* roww; bf16_t* Y; float descale;
    __device__ __forceinline__ void operator()(const f32x4 (&acc)[2][2][4][2], const Unit& u, int wr, int wc, int, int) const {
        const int l2 = my_lane(); const int fr = l2 & 15, fq = l2 >> 4;
        const int row0 = u.pm * BM + wr * 64 + fr; const int col0 = u.pn * BM + wc * 32 + 8 * fq;
#pragma unroll
        for (int ai = 0; ai < 2; ++ai)
#pragma unroll
            for (int m = 0; m < 4; ++m) { const int row = row0 + ai * HALF + m * 16; const int info = rowinfo[row];
                if (info >= 0) { const float w8 = roww[row] * descale; bf16_t* rowp = Y + (size_t)(info & 1) * ML * 1024 + (size_t)(info >> 1) * 1024 + col0;
#pragma unroll
                    for (int bj = 0; bj < 2; ++bj) { const f32x4 v0 = acc[ai][bj][m][0] * w8, v1 = acc[ai][bj][m][1] * w8;
                        u32x4 w; w.x = pk2(v0[0], v0[1]); w.y = pk2(v0[2], v0[3]); w.z = pk2(v1[0], v1[1]); w.w = pk2(v1[2], v1[3]);
                        *(u32x4*)(rowp + bj * HALF) = w; } } }
    }
};
}

struct Args { const float* in[26]; float* out; unsigned char* ws; int ph_lo, ph_hi, qbank, umask; };
enum { I_X = 0, I_C, I_CTX, I_CCTX, I_ADAW, I_ADAB, I_NMIX, I_NFFN, I_WIN, I_DECF, I_DECB, I_QNORM, I_KVNORM, I_WUQ, I_WUKV, I_RPB, I_WBR, I_WOUT,
       I_FG, I_FU, I_FD, I_ROUTER, I_MG, I_MU, I_MD, I_NFINAL };

__device__ __forceinline__ int q_next(unsigned* qw, volatile LAS int* slot, int wave) {
    __syncthreads();
    if (wave == 0 && my_lane() == 0) *slot = (int)atomicAdd(qw, 1u);
    __syncthreads();
    return *slot;
}

__device__ __forceinline__ void cvt_block(const float* W, int ldw, int k0, int sc0, bf16_t* D, int drow0, int ldd, LAS float* scr, int lane) {
    float v[32];
    const float* wp = W + (size_t)(k0 + (lane >> 5)) * ldw + (sc0 >= 0 ? sc0 : 0) + (lane & 31);
#pragma unroll
    for (int i = 0; i < 32; ++i) v[i] = wp[(size_t)(2 * i) * ldw];
#pragma unroll
    for (int i = 0; i < 32; ++i) scr[(2 * i + (lane >> 5)) * 33 + (lane & 31)] = sc0 >= 0 ? v[i] : 0.f;
    LDS_WAIT();
    const int c = lane & 7;
#pragma unroll
    for (int j = 0; j < 4; ++j) { const int n = (lane >> 3) + 8 * j; const LAS float* s = scr + (8 * c) * 33 + n;
        u32x4 o; o.x = pk2(s[0 * 33], s[1 * 33]); o.y = pk2(s[2 * 33], s[3 * 33]); o.z = pk2(s[4 * 33], s[5 * 33]); o.w = pk2(s[6 * 33], s[7 * 33]);
        *(u32x4*)(D + (size_t)(drow0 + n) * ldd + k0 + 8 * c) = o; }
    LDS_WAIT();
}
template <bool SPREAD = false>
__device__ __forceinline__ void cvt_block8(const float* W, int ldw, int k0, int sc0, unsigned char* D, int drow0, int ldd, float scale, LAS float* scr, int lane) {
    float v[32];
    const float* wp = W + (size_t)(k0 + (lane >> 5)) * ldw + sc0 + (lane & 31);
#pragma unroll
    for (int i = 0; i < 32; ++i) v[i] = wp[(size_t)(2 * i) * ldw];
#pragma unroll
    for (int i = 0; i < 32; ++i) scr[(2 * i + (lane >> 5)) * 33 + (lane & 31)] = v[i] * scale;
    LDS_WAIT();
    const int c = lane & 7;
#pragma unroll
    for (int j = 0; j < 4; ++j) { const int n = (lane >> 3) + 8 * j; const LAS float* s = scr + (8 * c) * 33 + n;
        u32x2 o; o.x = pk4_fp8(s[0 * 33], s[1 * 33], s[2 * 33], s[3 * 33]); o.y = pk4_fp8(s[4 * 33], s[5 * 33], s[6 * 33], s[7 * 33]);
        *(u32x2*)(D + (size_t)(drow0 + (SPREAD ? 32 * (n >> 4) + 8 * (((n >> 3) & 1) | (((n >> 2) & 1) << 1)) + (n & 3) : n)) * ldd + k0 + 8 * c) = o; }
    LDS_WAIT();
}
__device__ __forceinline__ int map_ng(int j) {
    if (j < 1024) return j;
    if (j < 2304) return 1184 + (j - 1024);
    if (j < 2464) return 1024 + (j - 2304);
    if (j < 2560) return -1;
    if (j < 2752) return 2464 + (j - 2560);
    return -1;
}

__device__ __forceinline__ void ph_prologue(const Args& a, LAS unsigned char* lds, int tid, int lane, int wave, int bid, int G) { asm volatile("" : "+v"(lane)); asm volatile("" : "+v"(tid));
    unsigned char* ws = a.ws;
    LAS float* s = (LAS float*)lds;
    LAS float* red = (LAS float*)(lds + 20480);
    for (int i = tid; i < 5 * 1024; i += 512) { const int r = i >> 10, k = i & 1023; const float v = r < 4 ? a.in[I_C][r * 1024 + k] : a.in[I_CCTX][k]; s[i] = siluf(v); }
    __syncthreads();
    float* MOD = (float*)(ws + WS_MOD);
    for (int unit = bid; unit < 384; unit += G) {
        const int L = unit / 192, j0 = (unit % 192) * 32, jj = tid & 31, ks = tid >> 5;
        float acc[5] = {0.f, 0.f, 0.f, 0.f, 0.f};
        const float* W = a.in[I_ADAW] + (size_t)L * 1024 * 6144 + j0 + jj;
        for (int k0 = ks * 64; k0 < ks * 64 + 64; k0 += 16) { float w[16];
#pragma unroll
            for (int i = 0; i < 16; ++i) w[i] = W[(size_t)(k0 + i) * 6144];
#pragma unroll
            for (int i = 0; i < 16; ++i)
#pragma unroll
                for (int r = 0; r < 5; ++r) acc[r] += s[r * 1024 + k0 + i] * w[i]; }
#pragma unroll
        for (int r = 0; r < 5; ++r) red[(ks * 5 + r) * 32 + jj] = acc[r];
        __syncthreads();
        if (tid < 160) { const int r = tid >> 5; float t = 0.f;
            for (int q = 0; q < 16; ++q) t += red[(q * 5 + r) * 32 + jj];
            MOD[(size_t)(L * 5 + r) * 6144 + j0 + jj] = t + a.in[I_ADAB][L * 6144 + j0 + jj]; }
        __syncthreads();
    }
    LAS float* scr = (LAS float*)(lds + 32768 + wave * 8448);
    const int gw = bid * 8 + wave, NGW = G * 8;
    constexpr int IA = 16 * 88, IB = 16 * 128, IC = 4 * 4 * 32, ID = 16 * 32, IE = 3 * 12, IF = 2 * 16, IL = IA + IB + IC + ID + IE + IF, IG = 16 * 176, IH = 44 * 32;
    for (int it = gw; it < 2 * IL + IG + IH; it += NGW) {
        int r = it;
        if (r < 2 * IL) { const int L = r / IL; r -= L * IL;
            const float* win = a.in[I_WIN] + (size_t)L * 1024 * INC;
            if (r < IA) { const int kb = r / 88, nb = r % 88; cvt_block(win, INC, kb * 64, map_ng(nb * 32), (bf16_t*)(ws + WS_WNG) + (size_t)L * 2816 * 1024, nb * 32, 1024, scr, lane); continue; } r -= IA;
            if (r < IB) { const int kb = r / 128, nb = r % 128; const int br = nb >> 5, cb = nb & 31;
                cvt_block8<true>(win, INC, kb * 64, 2656 + nb * 32, ws + WS_WG8 + (size_t)L * 4096 * 1024, 256 * (cb >> 1) + 128 * (br >> 1) + 64 * (cb & 1) + 4 * (br & 1), 1024, 64.f, scr, lane); continue; } r -= IB;
            if (r < IC) { const int i = r / 128, q = r % 128, kb = q / 32, nb = q % 32;
                cvt_block(a.in[I_WBR] + (size_t)(L * 4 + i) * 256 * 1024, 1024, kb * 64, nb * 32, (bf16_t*)(ws + WS_WB) + (size_t)L * 1024 * 1024 + i * 256, nb * 32, 1024, scr, lane); continue; } r -= IC;
            if (r < ID) { const int kb = r / 32, nb = r % 32; cvt_block(a.in[I_WOUT] + (size_t)L * 1024 * 1024, 1024, kb * 64, nb * 32, (bf16_t*)(ws + WS_WO) + (size_t)L * 1024 * 1024, nb * 32, 1024, scr, lane); continue; } r -= ID;
            if (r < IE) { const int kb = r / 12, nb = r % 12; cvt_block(a.in[I_WUQ] + (size_t)L * 192 * 384, 384, kb * 64, nb * 32, (bf16_t*)(ws + WS_WUQ) + (size_t)L * 384 * 192, nb * 32, 192, scr, lane); continue; } r -= IE;
            { const int kb = r / 16, nb = r % 16; cvt_block(a.in[I_WUKV] + (size_t)L * 128 * 512, 512, kb * 64, nb * 32, (bf16_t*)(ws + WS_WUKV) + (size_t)L * 512 * 128, nb * 32, 128, scr, lane); continue; }
        }
        r -= 2 * IL;
        if (r < IG) { const int kb = r / 176, nb = r % 176, pn = nb >> 3, wi = nb & 7;
            cvt_block(wi < 4 ? a.in[I_FG] : a.in[I_FU], FF, kb * 64, 128 * pn + 32 * (wi & 3), (bf16_t*)(ws + WS_WGU), nb * 32, 1024, scr, lane); continue; } r -= IG;
        { const int kb = r / 32, nb = r % 32; cvt_block8(a.in[I_FD], 1024, kb * 64, nb * 32, ws + WS_WD, nb * 32, FF, 64.f, scr, lane); }
    }
    const int gt = bid * 512 + tid, NGT = G * 512;
    float* RR = (float*)(ws + WS_ROPER); float* RM = (float*)(ws + WS_ROPEM);
    for (int i = gt; i < 8192 * 32; i += NGT) { const int t = i >> 5, f = i & 31; const float pos = (float)(f < 16 ? (t >> 6) : (t & 63));
        const float inv = powf(10000.f, -(float)(f & 15) / 16.f); const float ang = pos * inv; RR[2 * i] = cosf(ang); RR[2 * i + 1] = sinf(ang); }
    for (int i = gt; i < 8192 * 16; i += NGT) { const int t = i >> 4, f = i & 15; const float pos = (float)(f < 8 ? (t >> 6) : (t & 63));
        const float inv = powf(10000.f, -(float)(f & 7) / 8.f); const float ang = pos * inv; RM[2 * i] = cosf(ang); RM[2 * i + 1] = sinf(ang); }
    const float TWO_PI = 6.283185307179586f;
    bf16_t* M1 = (bf16_t*)(ws + WS_M1);
    for (int i = gt; i < 256 * 128; i += NGT) { const int r = i >> 7, t2 = i & 127; const int m = ((r & 127) * t2) & 127; const float ang = TWO_PI * (float)m / 128.f;
        M1[i] = (bf16_t)f2bf(r < 128 ? cosf(ang) : -sinf(ang)); }
    float* TW = (float*)(ws + WS_TW);
    for (int i = gt; i < 8192; i += NGT) { const float ang = TWO_PI * (float)i / 8192.f; TW[2 * i] = cosf(ang); TW[2 * i + 1] = sinf(ang); }
    bf16_t* D2 = (bf16_t*)(ws + WS_D2);
    for (int i = gt; i < 128 * 128; i += NGT) { const int row = i >> 7, k = i & 127; const int ro = row >> 6, k1 = row & 63, t1 = k >> 1, ri = k & 1;
        const float ang = TWO_PI * (float)((k1 * t1) & 63) / 64.f; const float cs = cosf(ang), sn = sinf(ang);
        D2[i] = (bf16_t)f2bf(ro == 0 ? (ri == 0 ? cs : sn) : (ri == 0 ? -sn : cs)); }
    bf16_t* EP = (bf16_t*)(ws + WS_EP);
    for (int i = gt; i < 64 * 128; i += NGT) { const int l = i >> 7, q = i & 127, part = q >> 6, p = q & 63; const int ct = p >> 5, sp = (p >> 4) & 1, hh = (p >> 3) & 1, j = p & 7;
        const int c = ct * 32 + 16 * sp + 8 * (j >> 2) + 4 * hh + (j & 3); const float ang = TWO_PI * (float)((l * c) & 63) / 64.f;
        EP[i] = (bf16_t)f2bf(part == 0 ? cosf(ang) : sinf(ang)); }
}

__device__ __forceinline__ void norm_rows(const float* xl, const float* xc, const float* gain, const float* modL, int sh_off, int sc_off, bf16_t* O, unsigned char* O8, int lane, int gw, int NGW) { asm volatile("" : "+v"(lane));
    f32x4 gn[4];
#pragma unroll
    for (int j = 0; j < 4; ++j) gn[j] = *(const f32x4*)(gain + 4 * lane + 256 * j);
    for (int row = gw; row < MT; row += NGW) {
        const bool isc = row >= ML; const float* xr = isc ? xc + (size_t)(row - ML) * 1024 : xl + (size_t)row * 1024;
        const float* mv = modL + (size_t)(isc ? 4 : (row >> 13)) * 6144;
        f32x4 v[4]; float ss = 0.f;
#pragma unroll
        for (int j = 0; j < 4; ++j) { v[j] = *(const f32x4*)(xr + 4 * lane + 256 * j); ss += (v[j][0] * v[j][0] + v[j][1] * v[j][1]) + (v[j][2] * v[j][2] + v[j][3] * v[j][3]); }
        const float rstd = 1.f / sqrtf(wave_sum(ss) * (1.f / 1024.f) + EPS);
        u32x2* o8 = (u32x2*)(O + (size_t)row * 1024) + lane;
#pragma unroll
        for (int j = 0; j < 4; ++j) { const f32x4 sc = *(const f32x4*)(mv + sc_off + 4 * lane + 256 * j), sh = *(const f32x4*)(mv + sh_off + 4 * lane + 256 * j);
            const f32x4 y = v[j] * rstd * gn[j] * (sc + 1.f) + sh; u32x2 w; w.x = pk2(y[0], y[1]); w.y = pk2(y[2], y[3]); o8[64 * j] = w;
            if (O8) *(unsigned*)(O8 + (size_t)row * 1024 + 4 * lane + 256 * j) = pk4_fp8(y[0] * 8.f, y[1] * 8.f, y[2] * 8.f, y[3] * 8.f); }
    }
}

__device__ __forceinline__ float logsig2(float x) { return -log1pf(expf(-x)) * LOG2E; }

template <bool DO_KS, bool DO_QS, bool DO_KT>
__device__ __forceinline__ void ret_stage(const bf16_t* U, const float* RR, int row0, int t0, int hd, LAS bf16_t* Ks, LAS bf16_t* Qs, LAS bf16_t* KT, LAS bf16_t* VT, int tid) {
    const int j = tid >> 2, qd = tid & 3; const size_t rb = (size_t)(row0 + j) * 256 + hd * 64 + 8 * qd;
    float c[8], s[8];
    if (t0 >= 0) { const float* rr = RR + ((size_t)(t0 + j) * 32 + 8 * qd) * 2;
#pragma unroll
        for (int i = 0; i < 8; i += 2) { const f32x4 v = *(const f32x4*)(rr + 2 * i); c[i] = v[0]; s[i] = v[1]; c[i + 1] = v[2]; s[i + 1] = v[3]; } }
    else {
#pragma unroll
        for (int i = 0; i < 8; ++i) { c[i] = 1.f; s[i] = 0.f; } }
    {
        const u32x4 a = *(const u32x4*)(U + rb), b = *(const u32x4*)(U + rb + 32);
        float x1[8] = {bflo(a.x), bfhi(a.x), bflo(a.y), bfhi(a.y), bflo(a.z), bfhi(a.z), bflo(a.w), bfhi(a.w)};
        float x2[8] = {bflo(b.x), bfhi(b.x), bflo(b.y), bfhi(b.y), bflo(b.z), bfhi(b.z), bflo(b.w), bfhi(b.w)};
        float o1[8], o2[8];
#pragma unroll
        for (int i = 0; i < 8; ++i) { o1[i] = (x1[i] * c[i] - x2[i] * s[i]) * 0.125f; o2[i] = (x2[i] * c[i] + x1[i] * s[i]) * 0.125f; }
        if (DO_KS) { u32x4 w1, w2; w1.x = pk2(o1[0], o1[1]); w1.y = pk2(o1[2], o1[3]); w1.z = pk2(o1[4], o1[5]); w1.w = pk2(o1[6], o1[7]);
            w2.x = pk2(o2[0], o2[1]); w2.y = pk2(o2[2], o2[3]); w2.z = pk2(o2[4], o2[5]); w2.w = pk2(o2[6], o2[7]);
            *(LAS u32x4*)(Ks + j * 72 + 8 * qd) = w1; *(LAS u32x4*)(Ks + j * 72 + 32 + 8 * qd) = w2; }
        if (DO_KT) {
#pragma unroll
            for (int i = 0; i < 8; ++i) { KT[(8 * qd + i) * 136 + j] = (bf16_t)f2bf(o1[i]); KT[(32 + 8 * qd + i) * 136 + j] = (bf16_t)f2bf(o2[i]); } }
    }
    if (DO_QS) {
        const bf16_t* Uq = U + (size_t)4 * MT * 256;
        const u32x4 a = *(const u32x4*)(Uq + rb), b = *(const u32x4*)(Uq + rb + 32);
        float x1[8] = {bflo(a.x), bfhi(a.x), bflo(a.y), bfhi(a.y), bflo(a.z), bfhi(a.z), bflo(a.w), bfhi(a.w)};
        float x2[8] = {bflo(b.x), bfhi(b.x), bflo(b.y), bfhi(b.y), bflo(b.z), bfhi(b.z), bflo(b.w), bfhi(b.w)};
        float o1[8], o2[8];
#pragma unroll
        for (int i = 0; i < 8; ++i) { o1[i] = x1[i] * c[i] - x2[i] * s[i]; o2[i] = x2[i] * c[i] + x1[i] * s[i]; }
        u32x4 w1, w2; w1.x = pk2(o1[0], o1[1]); w1.y = pk2(o1[2], o1[3]); w1.z = pk2(o1[4], o1[5]); w1.w = pk2(o1[6], o1[7]);
        w2.x = pk2(o2[0], o2[1]); w2.y = pk2(o2[2], o2[3]); w2.z = pk2(o2[4], o2[5]); w2.w = pk2(o2[6], o2[7]);
        *(LAS u32x4*)(Qs + j * 72 + 8 * qd) = w1; *(LAS u32x4*)(Qs + j * 72 + 32 + 8 * qd) = w2;
    }
    {
        const bf16_t* Uv = U + (size_t)1 * MT * 256;
        const u32x4 a = *(const u32x4*)(Uv + rb), b = *(const u32x4*)(Uv + rb + 32);
        const unsigned wa[4] = {a.x, a.y, a.z, a.w}, wb[4] = {b.x, b.y, b.z, b.w};
#pragma unroll
        for (int i = 0; i < 4; ++i) { VT[(8 * qd + 2 * i) * 136 + j] = (bf16_t)(wa[i] & 0xffffu); VT[(8 * qd + 2 * i + 1) * 136 + j] = (bf16_t)(wa[i] >> 16);
            VT[(32 + 8 * qd + 2 * i) * 136 + j] = (bf16_t)(wb[i] & 0xffffu); VT[(32 + 8 * qd + 2 * i + 1) * 136 + j] = (bf16_t)(wb[i] >> 16); }
    }
}

__device__ __forceinline__ void ret_dstate_unit(const Args& a, int L, int u, LAS unsigned char* lds, int tid, int lane, int wave) { asm volatile("" : "+v"(lane)); asm volatile("" : "+v"(tid));
    const bf16_t* U = (const bf16_t*)(a.ws + WS_U); const float* RR = (const float*)(a.ws + WS_ROPER);
    LAS bf16_t* KT = (LAS bf16_t*)lds; LAS bf16_t* VT = (LAS bf16_t*)(lds + 17408);
    int b, hd, n, row0, t0; float* dst0;
    if (u < 1024) { b = u >> 8; hd = (u >> 6) & 3; n = u & 63; row0 = b * SEQ + n * 128; t0 = n * 128; dst0 = (float*)(a.ws + WS_ST) + ((size_t)((b * 4 + hd) * 64 + n)) * 4096; }
    else { const int v = u - 1024; b = v >> 3; hd = (v >> 1) & 3; n = v & 1; row0 = ML + b * CTXL + n * 128; t0 = -1; dst0 = (float*)(a.ws + WS_STC) + ((size_t)((b * 4 + hd) * 2 + n)) * 4096; }
    ret_stage<false, false, true>(U, RR, row0, t0, hd, KT, KT, KT, VT, tid);
    __syncthreads();
    const int dir = wave >> 2, dkb = (wave >> 1) & 1, dvb = wave & 1, r = lane & 31, h = lane >> 5;
    const float lg2 = logsig2(a.in[dir ? I_DECB : I_DECF][L * 4 + hd]);
    f32x16 acc = zero16();
#pragma unroll
    for (int s = 0; s < 8; ++s) {
        const u32x4 kw = *(const LAS u32x4*)(KT + (dkb * 32 + r) * 136 + 16 * s + 8 * h);
        const int j0 = 16 * s + 8 * h;
        float w[8];
#pragma unroll
        for (int i = 0; i < 8; ++i) w[i] = fexp2(lg2 * (float)(dir ? (j0 + i) : (127 - j0 - i)));
        u32x4 ka; ka.x = pk2(bflo(kw.x) * w[0], bfhi(kw.x) * w[1]); ka.y = pk2(bflo(kw.y) * w[2], bfhi(kw.y) * w[3]);
        ka.z = pk2(bflo(kw.z) * w[4], bfhi(kw.z) * w[5]); ka.w = pk2(bflo(kw.w) * w[6], bfhi(kw.w) * w[7]);
        const bf16x8 vb = *(const LAS bf16x8*)(VT + (dvb * 32 + r) * 136 + 16 * s + 8 * h);
        acc = mfma32(as_bf16x8(ka), vb, acc);
    }
    float* dst = dst0 + (size_t)dir * (u < 1024 ? (size_t)16 * 64 * 4096 : (size_t)16 * 2 * 4096);
#pragma unroll
    for (int q = 0; q < 16; ++q) dst[(dkb * 32 + crow(q, h)) * 64 + dvb * 32 + r] = acc[q];
}

__device__ __forceinline__ void ret_scan_unit(const Args& a, int L, int u, int tid) { asm volatile("" : "+v"(tid));
    const int dir = u >> 7, bh = (u >> 3) & 15, e = (u & 7) * 512 + tid, hd = bh & 3;
    const float lg2 = logsig2(a.in[dir ? I_DECB : I_DECF][L * 4 + hd]); const float g128 = fexp2(lg2 * 128.f);
    float* st = (float*)(a.ws + WS_ST) + ((size_t)(dir * 16 + bh) * 64) * 4096 + e;
    const float* sc = (const float*)(a.ws + WS_STC) + ((size_t)(dir * 16 + bh) * 2) * 4096 + e;
    float S = dir == 0 ? g128 * sc[0] + sc[4096] : sc[0] + g128 * sc[4096];
    long step = dir == 0 ? 4096 : -4096; asm volatile("" : "+v"(step));
    float* p = st + (dir == 0 ? 0 : (size_t)63 * 4096);
#pragma nounroll
    for (int n0 = 0; n0 < 64; n0 += 8) {
        float t[8];
#pragma unroll
        for (int i = 0; i < 8; ++i) t[i] = p[i * step];
#pragma unroll
        for (int i = 0; i < 8; ++i) { p[i * step] = S; S = g128 * S + t[i]; }
        p += 8 * step;
    }
}

__device__ __forceinline__ void ret_out_unit(const Args& a, int L, int u, LAS unsigned char* lds, int tid, int lane, int wave) { asm volatile("" : "+v"(lane)); asm volatile("" : "+v"(tid));
    const bf16_t* U = (const bf16_t*)(a.ws + WS_U); const float* RR = (const float*)(a.ws + WS_ROPER);
    LAS bf16_t* Qs = (LAS bf16_t*)lds; LAS bf16_t* Ks = (LAS bf16_t*)(lds + 18432); LAS bf16_t* VT = (LAS bf16_t*)(lds + 36864);
    LAS bf16_t* SfT = (LAS bf16_t*)(lds + 54272); LAS bf16_t* SbT = (LAS bf16_t*)(lds + 63488); LAS float* Ob = (LAS float*)(lds + 72704);
    int b, hd, n, row0, t0; const float* sf; const float* sb;
    if (u < 1024) { b = u >> 8; hd = (u >> 6) & 3; n = u & 63; row0 = b * SEQ + n * 128; t0 = n * 128;
        sf = (const float*)(a.ws + WS_ST) + ((size_t)((b * 4 + hd) * 64 + n)) * 4096; sb = sf + (size_t)16 * 64 * 4096; }
    else { const int v = u - 1024; b = v >> 3; hd = (v >> 1) & 3; n = v & 1; row0 = ML + b * CTXL + n * 128; t0 = -1;
        const float* stc = (const float*)(a.ws + WS_STC) + ((size_t)((b * 4 + hd) * 2)) * 4096;
        sf = n == 1 ? stc : nullptr; sb = n == 0 ? stc + (size_t)16 * 2 * 4096 + 4096 : nullptr; }
    ret_stage<true, true, false>(U, RR, row0, t0, hd, Ks, Qs, Ks, VT, tid);
    {
        const int dk = tid >> 3, dv0 = (tid & 7) * 8;
#pragma unroll
        for (int i = 0; i < 8; ++i) { SfT[(dv0 + i) * 72 + dk] = (bf16_t)f2bf(sf ? sf[dk * 64 + dv0 + i] : 0.f); SbT[(dv0 + i) * 72 + dk] = (bf16_t)f2bf(sb ? sb[dk * 64 + dv0 + i] : 0.f); }
    }
    __syncthreads();
    const int dir = wave >> 2, it = wave & 3, r = lane & 31, h = lane >> 5;
    const float lg2 = logsig2(a.in[dir ? I_DECB : I_DECF][L * 4 + hd]);
    const int iq = it * 32 + r;
    bf16x8 qf[4];
#pragma unroll
    for (int s = 0; s < 4; ++s) qf[s] = *(const LAS bf16x8*)(Qs + iq * 72 + 16 * s + 8 * h);
    f32x16 o[2];
    {
        const LAS bf16_t* ST_ = dir ? SbT : SfT;
        const float fac = fexp2(lg2 * (float)(dir ? (128 - iq) : (iq + 1)));
#pragma unroll
        for (int dvb = 0; dvb < 2; ++dvb) { f32x16 c = zero16();
#pragma unroll
            for (int s = 0; s < 4; ++s) c = mfma32(*(const LAS bf16x8*)(ST_ + (dvb * 32 + r) * 72 + 16 * s + 8 * h), qf[s], c);
            o[dvb] = c * fac; }
    }
    const int jt0 = dir ? it : 0, jt1 = dir ? 3 : it;
    for (int jt = jt0; jt <= jt1; ++jt) {
        f32x16 sT = zero16();
#pragma unroll
        for (int s = 0; s < 4; ++s) sT = mfma32(*(const LAS bf16x8*)(Ks + (jt * 32 + r) * 72 + 16 * s + 8 * h), qf[s], sT);
        float p[16];
#pragma unroll
        for (int q = 0; q < 16; ++q) { const int j = jt * 32 + crow(q, h); const int d = dir ? (j - iq) : (iq - j); p[q] = d >= 0 ? sT[q] * fexp2(lg2 * (float)d) : 0.f; }
#pragma unroll
        for (int sp = 0; sp < 2; ++sp) {
            u32x4 pw; pw.x = pk2(p[8 * sp + 0], p[8 * sp + 1]); pw.y = pk2(p[8 * sp + 2], p[8 * sp + 3]); pw.z = pk2(p[8 * sp + 4], p[8 * sp + 5]); pw.w = pk2(p[8 * sp + 6], p[8 * sp + 7]);
#pragma unroll
            for (int dvb = 0; dvb < 2; ++dvb) {
                const LAS bf16_t* vp = VT + (dvb * 32 + r) * 136 + jt * 32 + 16 * sp + 4 * h;
                const u32x2 v0 = *(const LAS u32x2*)vp, v1 = *(const LAS u32x2*)(vp + 8);
                u32x4 vw; vw.x = v0.x; vw.y = v0.y; vw.z = v1.x; vw.w = v1.y;
                o[dvb] = mfma32(as_bf16x8(vw), as_bf16x8(pw), o[dvb]);
            }
        }
    }
    float ss = 0.f;
#pragma unroll
    for (int dvb = 0; dvb < 2; ++dvb)
#pragma unroll
        for (int q = 0; q < 16; ++q) ss += o[dvb][q] * o[dvb][q];
    ss = xhalf_sum(ss);
    const float rn = 1.f / sqrtf(ss * (1.f / 64.f) + EPS);
    const bf16_t* Ug = U + (size_t)(dir ? 6 : 5) * MT * 256 + (size_t)(row0 + iq) * 256 + hd * 64;
#pragma unroll
    for (int dvb = 0; dvb < 2; ++dvb)
#pragma unroll
        for (int q4 = 0; q4 < 4; ++q4) { const int dv = dvb * 32 + 8 * q4 + 4 * h; const u32x2 gw = *(const u32x2*)(Ug + dv);
            o[dvb][4 * q4 + 0] *= rn * siluf(bflo(gw.x)); o[dvb][4 * q4 + 1] *= rn * siluf(bfhi(gw.x)); o[dvb][4 * q4 + 2] *= rn * siluf(bflo(gw.y)); o[dvb][4 * q4 + 3] *= rn * siluf(bfhi(gw.y)); }
    if (dir == 1) {
#pragma unroll
        for (int dvb = 0; dvb < 2; ++dvb)
#pragma unroll
            for (int q4 = 0; q4 < 4; ++q4) *(LAS f32x4*)(Ob + iq * 68 + dvb * 32 + 8 * q4 + 4 * h) = (f32x4){o[dvb][4 * q4], o[dvb][4 * q4 + 1], o[dvb][4 * q4 + 2], o[dvb][4 * q4 + 3]};
    }
    __syncthreads();
    if (dir == 0) {
        bf16_t* Y = (bf16_t*)(a.ws + WS_YBR) + (size_t)(row0 + iq) * 1024 + hd * 64;
#pragma unroll
        for (int dvb = 0; dvb < 2; ++dvb)
#pragma unroll
            for (int q4 = 0; q4 < 4; ++q4) { const int dv = dvb * 32 + 8 * q4 + 4 * h; const f32x4 ob = *(const LAS f32x4*)(Ob + iq * 68 + dv);
                u32x2 w; w.x = pk2(o[dvb][4 * q4] + ob[0], o[dvb][4 * q4 + 1] + ob[1]); w.y = pk2(o[dvb][4 * q4 + 2] + ob[2], o[dvb][4 * q4 + 3] + ob[3]);
                *(u32x2*)(Y + dv) = w; }
    }
}

__device__ __forceinline__ void mla_prep_wave(const Args& a, int L, int blk, int half, int lane) { asm volatile("" : "+v"(lane));
    const unsigned char* ws = a.ws; const bf16_t* U = (const bf16_t*)(ws + WS_U);
    const int r = lane & 31, h = lane >> 5, row = blk * 32 + r; const bool isc = row >= ML;
    int b, key, t;
    if (!isc) { b = row >> 13; t = row & 8191; key = t; } else { const int rc = row - ML; b = rc >> 8; t = rc & 255; key = SEQ + t; }
    const float* RM = (const float*)(ws + WS_ROPEM);
    bf16_t* MK = (bf16_t*)(a.ws + WS_MK); bf16_t* MVT = (bf16_t*)(a.ws + WS_MVT);
    {
        const bf16_t* up = U + (size_t)9 * MT * 256 + (size_t)row * 256;
        u32x4 xs[8]; float ss = 0.f;
#pragma unroll
        for (int s = 0; s < 8; ++s) { xs[s] = *(const u32x4*)(up + 16 * s + 8 * h);
            const float v[8] = {bflo(xs[s].x), bfhi(xs[s].x), bflo(xs[s].y), bfhi(xs[s].y), bflo(xs[s].z), bfhi(xs[s].z), bflo(xs[s].w), bfhi(xs[s].w)};
#pragma unroll
            for (int i = 0; i < 8; ++i) ss += v[i] * v[i]; }
        ss = xhalf_sum(ss);
        const float rstd = 1.f / sqrtf(ss * (1.f / 128.f) + EPS);
        const float* kvn = a.in[I_KVNORM] + L * 128;
#pragma unroll
        for (int s = 0; s < 8; ++s) { const f32x4 g0 = *(const f32x4*)(kvn + 16 * s + 8 * h), g1 = *(const f32x4*)(kvn + 16 * s + 8 * h + 4);
            u32x4 w; w.x = pk2(bflo(xs[s].x) * rstd * g0[0], bfhi(xs[s].x) * rstd * g0[1]); w.y = pk2(bflo(xs[s].y) * rstd * g0[2], bfhi(xs[s].y) * rstd * g0[3]);
            w.z = pk2(bflo(xs[s].z) * rstd * g1[0], bfhi(xs[s].z) * rstd * g1[1]); w.w = pk2(bflo(xs[s].w) * rstd * g1[2], bfhi(xs[s].w) * rstd * g1[3]); xs[s] = w;  asm volatile("" ::: "memory"); }
        const bf16_t* W = (const bf16_t*)(ws + WS_WUKV) + (size_t)L * 512 * 128;
#pragma unroll 2
        for (int ob = 8 * half; ob < 8 * half + 8; ++ob) {
            f32x16 acc = zero16();
#pragma unroll
            for (int s = 0; s < 8; ++s) acc = mfma32(*(const bf16x8*)(W + (size_t)(ob * 32 + r) * 128 + 16 * s + 8 * h), as_bf16x8(xs[s]), acc);
            const int hh = ob >> 2, part = ob & 3;
            if (part < 2) {
                bf16_t* kp = MK + ((size_t)(b * 4 + hh) * 8448 + key) * 104 + part * 32 + 4 * h;
#pragma unroll
                for (int q4 = 0; q4 < 4; ++q4) { u32x2 w; w.x = pk2(acc[4 * q4], acc[4 * q4 + 1]); w.y = pk2(acc[4 * q4 + 2], acc[4 * q4 + 3]); *(u32x2*)(kp + 8 * q4) = w; }
            } else {
                const int k16 = key & 15;
                bf16_t* vp = MVT + (((size_t)(b * 4 + hh) * 132 + (key >> 6)) * 64 + (part - 2) * 32) * 72 + 16 * ((key >> 4) & 3) + (((k16 & 4) << 1) | ((k16 & 8) >> 1) | (k16 & 3));
#pragma unroll
                for (int q = 0; q < 16; ++q) vp[crow(q, h) * 72] = (bf16_t)f2bf(acc[q]);
            }
        }
        if (half == 0) {
        const u32x4 a1 = *(const u32x4*)(up + 128 + 8 * h), a2 = *(const u32x4*)(up + 144 + 8 * h);
        float x1[8] = {bflo(a1.x), bfhi(a1.x), bflo(a1.y), bfhi(a1.y), bflo(a1.z), bfhi(a1.z), bflo(a1.w), bfhi(a1.w)};
        float x2[8] = {bflo(a2.x), bfhi(a2.x), bflo(a2.y), bfhi(a2.y), bflo(a2.z), bfhi(a2.z), bflo(a2.w), bfhi(a2.w)};
        float o1[8], o2[8];
#pragma unroll
        for (int i = 0; i < 8; ++i) { float c = 1.f, s = 0.f; if (!isc) { const f32x2 cs = *(const f32x2*)(RM + ((size_t)t * 16 + 8 * h + i) * 2); c = cs[0]; s = cs[1]; }
            o1[i] = x1[i] * c - x2[i] * s; o2[i] = x2[i] * c + x1[i] * s; }
        u32x4 w1, w2; w1.x = pk2(o1[0], o1[1]); w1.y = pk2(o1[2], o1[3]); w1.z = pk2(o1[4], o1[5]); w1.w = pk2(o1[6], o1[7]);
        w2.x = pk2(o2[0], o2[1]); w2.y = pk2(o2[2], o2[3]); w2.z = pk2(o2[4], o2[5]); w2.w = pk2(o2[6], o2[7]);
#pragma unroll
        for (int hh = 0; hh < 4; ++hh) { bf16_t* kp = MK + ((size_t)(b * 4 + hh) * 8448 + key) * 104 + 64; *(u32x4*)(kp + 8 * h) = w1; *(u32x4*)(kp + 16 + 8 * h) = w2; }
        }
    }
    if (!isc || L == 0) {
        const bf16_t* up = U + (size_t)10 * MT * 256 + (size_t)row * 256;
        u32x4 xs[12]; float ss = 0.f;
#pragma unroll
        for (int s = 0; s < 12; ++s) { xs[s] = *(const u32x4*)(up + 16 * s + 8 * h);
            const float v[8] = {bflo(xs[s].x), bfhi(xs[s].x), bflo(xs[s].y), bfhi(xs[s].y), bflo(xs[s].z), bfhi(xs[s].z), bflo(xs[s].w), bfhi(xs[s].w)};
#pragma unroll
            for (int i = 0; i < 8; ++i) ss += v[i] * v[i]; }
        ss = xhalf_sum(ss);
        const float rstd = 1.f / sqrtf(ss * (1.f / 192.f) + EPS);
        const float* qn = a.in[I_QNORM] + L * 192;
#pragma unroll
        for (int s = 0; s < 12; ++s) { const f32x4 g0 = *(const f32x4*)(qn + 16 * s + 8 * h), g1 = *(const f32x4*)(qn + 16 * s + 8 * h + 4);
            u32x4 w; w.x = pk2(bflo(xs[s].x) * rstd * g0[0], bfhi(xs[s].x) * rstd * g0[1]); w.y = pk2(bflo(xs[s].y) * rstd * g0[2], bfhi(xs[s].y) * rstd * g0[3]);
            w.z = pk2(bflo(xs[s].z) * rstd * g1[0], bfhi(xs[s].z) * rstd * g1[1]); w.w = pk2(bflo(xs[s].w) * rstd * g1[2], bfhi(xs[s].w) * rstd * g1[3]); xs[s] = w;  asm volatile("" ::: "memory"); }
        const bf16_t* W = (const bf16_t*)(ws + WS_WUQ) + (size_t)L * 384 * 192;
        const float qsc = 0.10206207261596577f * LOG2E;
#pragma unroll 2
        for (int ob = 6 * half; ob < 6 * half + 6; ++ob) {
            f32x16 acc = zero16();
#pragma unroll
            for (int s = 0; s < 12; ++s) acc = mfma32(*(const bf16x8*)(W + (size_t)(ob * 32 + r) * 192 + 16 * s + 8 * h), as_bf16x8(xs[s]), acc);
            const int hh = ob / 3, part = ob % 3;
            if (part == 2 && !isc) {
#pragma unroll
                for (int q = 0; q < 8; ++q) { const f32x2 cs = *(const f32x2*)(RM + ((size_t)t * 16 + crow(q, h)) * 2); const float x1 = acc[q], x2 = acc[q + 8];
                    acc[q] = x1 * cs[0] - x2 * cs[1]; acc[q + 8] = x2 * cs[0] + x1 * cs[1]; }
            }
            bf16_t* qp = isc ? (bf16_t*)(a.ws + WS_MQC) + ((size_t)(b * 4 + hh) * 256 + t) * 96 : (bf16_t*)(a.ws + WS_MQ) + ((size_t)(b * 4 + hh) * 8192 + t) * 96;
            qp += part * 32 + 4 * h;
#pragma unroll
            for (int q4 = 0; q4 < 4; ++q4) { u32x2 w; w.x = pk2(acc[4 * q4] * qsc, acc[4 * q4 + 1] * qsc); w.y = pk2(acc[4 * q4 + 2] * qsc, acc[4 * q4 + 3] * qsc); *(u32x2*)(qp + 8 * q4) = w; }
        }
    }
}

__device__ __forceinline__ void four_stage1_unit(const Args& a, int u, int lane, int wave) { asm volatile("" : "+v"(lane));
    const unsigned char* ws = a.ws; const bf16_t* F = (const bf16_t*)(ws + WS_U) + (size_t)7 * MT * 256;
    const int b = u >> 6, t1 = u & 63, r = lane & 31, h = lane >> 5, c = wave * 32 + r;
    u32x4 fr[8];
#pragma unroll
    for (int s = 0; s < 8; ++s) { unsigned e[8];
#pragma unroll
        for (int j = 0; j < 8; ++j) e[j] = F[(size_t)(b * SEQ + t1 + 64 * (16 * s + 8 * h + j)) * 256 + c];
        fr[s].x = e[0] | (e[1] << 16); fr[s].y = e[2] | (e[3] << 16); fr[s].z = e[4] | (e[5] << 16); fr[s].w = e[6] | (e[7] << 16); }
    const bf16_t* M1 = (const bf16_t*)(ws + WS_M1); const float* TW = (const float*)(ws + WS_TW);
    unsigned* A2 = (unsigned*)(a.ws + WS_A2) + ((size_t)(b * 64 + t1) * 128) * 256 + c;
    for (int i = 0; i < 4; ++i) {
        f32x16 ar = zero16(), ai = zero16();
#pragma unroll
        for (int s = 0; s < 8; ++s) { ar = mfma32(*(const bf16x8*)(M1 + (size_t)(32 * i + r) * 128 + 16 * s + 8 * h), as_bf16x8(fr[s]), ar);
            ai = mfma32(*(const bf16x8*)(M1 + (size_t)(128 + 32 * i + r) * 128 + 16 * s + 8 * h), as_bf16x8(fr[s]), ai); }
#pragma unroll
        for (int q = 0; q < 16; ++q) { const int k2 = 32 * i + crow(q, h); const f32x2 w = *(const f32x2*)(TW + 2 * (k2 * t1));
            A2[(size_t)k2 * 256] = pk2(ar[q] * w[0] + ai[q] * w[1], ai[q] * w[0] - ar[q] * w[1]); }
    }
}
__device__ __forceinline__ void four_stage2_unit(const Args& a, int u, int lane, int wave) { asm volatile("" : "+v"(lane));
    const unsigned char* ws = a.ws;
    const int b = u >> 7, k2 = u & 127, r = lane & 31, h = lane >> 5, g = wave >> 1, kb = wave & 1;
    const unsigned* A2 = (const unsigned*)(ws + WS_A2) + ((size_t)(b * 64) * 128 + k2) * 256;
    const bf16_t* D2 = (const bf16_t*)(ws + WS_D2); const bf16_t* EP = (const bf16_t*)(ws + WS_EP);
    f32x16 acc[2][2];
#pragma unroll
    for (int ct = 0; ct < 2; ++ct)
#pragma unroll
        for (int ro = 0; ro < 2; ++ro) acc[ct][ro] = zero16();
#pragma unroll
    for (int s = 0; s < 8; ++s) {
        const bf16x8 d0 = *(const bf16x8*)(D2 + (size_t)(kb * 32 + r) * 128 + 16 * s + 8 * h), d1 = *(const bf16x8*)(D2 + (size_t)(64 + kb * 32 + r) * 128 + 16 * s + 8 * h);
#pragma unroll
        for (int ct = 0; ct < 2; ++ct) { const int c = g * 64 + ct * 32 + r; u32x4 f;
            f.x = A2[(size_t)(8 * s + 4 * h + 0) * 128 * 256 + c]; f.y = A2[(size_t)(8 * s + 4 * h + 1) * 128 * 256 + c];
            f.z = A2[(size_t)(8 * s + 4 * h + 2) * 128 * 256 + c]; f.w = A2[(size_t)(8 * s + 4 * h + 3) * 128 * 256 + c];
            acc[ct][0] = mfma32(as_bf16x8(f), d0, acc[ct][0]); acc[ct][1] = mfma32(as_bf16x8(f), d1, acc[ct][1]); }
    }
    f32x16 y[2] = {zero16(), zero16()};
#pragma unroll
    for (int ro = 0; ro < 2; ++ro)
#pragma unroll
        for (int ct = 0; ct < 2; ++ct)
#pragma unroll
            for (int sp = 0; sp < 2; ++sp) { const f32x16& x = acc[ct][ro];
                u32x4 xw; xw.x = pk2(x[8 * sp + 0], x[8 * sp + 1]); xw.y = pk2(x[8 * sp + 2], x[8 * sp + 3]); xw.z = pk2(x[8 * sp + 4], x[8 * sp + 5]); xw.w = pk2(x[8 * sp + 6], x[8 * sp + 7]);
#pragma unroll
                for (int lb = 0; lb < 2; ++lb) y[lb] = mfma32(*(const bf16x8*)(EP + (size_t)(lb * 32 + r) * 128 + ro * 64 + ct * 32 + sp * 16 + h * 8), as_bf16x8(xw), y[lb]); }
    const float sc = 0.0013810679320049757f;
    bf16_t* Y = (bf16_t*)(a.ws + WS_YBR) + ((size_t)(b * SEQ + 128 * (kb * 32 + r) + k2)) * 1024 + 256 + g * 64;
#pragma unroll
    for (int lb = 0; lb < 2; ++lb)
#pragma unroll
        for (int q4 = 0; q4 < 4; ++q4) { u32x2 w; w.x = pk2(y[lb][4 * q4] * sc, y[lb][4 * q4 + 1] * sc); w.y = pk2(y[lb][4 * q4 + 2] * sc, y[lb][4 * q4 + 3] * sc);
            *(u32x2*)(Y + lb * 32 + 8 * q4 + 4 * h) = w; }
}
__device__ __forceinline__ void cfour_step1_unit(const Args& a, int u, LAS unsigned char* lds, int tid) { asm volatile("" : "+v"(tid));
    LAS float* fl = (LAS float*)lds;
    LAS float* cs = (LAS float*)(lds + 2048);
    const bf16_t* F = (const bf16_t*)(a.ws + WS_U) + (size_t)7 * MT * 256;
    const int rr = tid >> 8, col = tid & 255, row = 2 * u + rr;
    fl[tid] = bf2f(F[(size_t)(ML + row) * 256 + col]);
    if (tid < 64) { const float ang = 6.283185307179586f * (float)tid / 64.f; cs[2 * tid] = cosf(ang); cs[2 * tid + 1] = sinf(ang); }
    __syncthreads();
    const int g = col >> 6, l = col & 63; float p = 0.f, q = 0.f;
    for (int c = 0; c < 64; ++c) { const float f = fl[rr * 256 + g * 64 + c]; const int m = (l * c) & 63; p += f * cs[2 * m]; q += f * cs[2 * m + 1]; }
    float* O = (float*)(a.ws + WS_CPQ) + (size_t)row * 512; O[col] = p; O[256 + col] = q;
}
__device__ __forceinline__ void cfour_step2_unit(const Args& a, int u, LAS unsigned char* lds, int tid) { asm volatile("" : "+v"(tid));
    LAS float* cs = (LAS float*)lds;
    if (tid < 256) { const float ang = 6.283185307179586f * (float)tid / 256.f; cs[2 * tid] = cosf(ang); cs[2 * tid + 1] = sinf(ang); }
    __syncthreads();
    const int b = u >> 6, k0 = (u & 63) * 4 + (tid >> 8) * 2, col = tid & 255;
    const float* P = (const float*)(a.ws + WS_CPQ) + (size_t)(b * 256) * 512 + col; float acc0 = 0.f, acc1 = 0.f;
    for (int t0 = 0; t0 < 256; t0 += 8) { float p[8], q[8];
#pragma unroll
        for (int i = 0; i < 8; ++i) { p[i] = P[(size_t)(t0 + i) * 512]; q[i] = P[(size_t)(t0 + i) * 512 + 256]; }
#pragma unroll
        for (int i = 0; i < 8; ++i) { const int m0 = (k0 * (t0 + i)) & 255, m1 = ((k0 + 1) * (t0 + i)) & 255;
            acc0 += cs[2 * m0] * p[i] - cs[2 * m0 + 1] * q[i]; acc1 += cs[2 * m1] * p[i] - cs[2 * m1 + 1] * q[i]; } }
    bf16_t* Y = (bf16_t*)(a.ws + WS_YBR) + (size_t)(ML + b * 256 + k0) * 1024 + 256 + col;
    Y[0] = (bf16_t)f2bf(acc0 * (1.f / 128.f)); Y[1024] = (bf16_t)f2bf(acc1 * (1.f / 128.f));
}

__device__ __forceinline__ void osm_step(const f32x16& x, float& m, float& l, f32x16& o0, f32x16& o1, u32x4& p0, u32x4& p1) {
    float bm = fmaxf(fmaxf(x[0], x[1]), fmaxf(x[2], x[3]));
#pragma unroll
    for (int q = 4; q < 16; q += 4) bm = fmaxf(bm, fmaxf(fmaxf(x[q], x[q + 1]), fmaxf(x[q + 2], x[q + 3])));
    bm = xhalf_max(bm);
    const float mn = fmaxf(m, bm);
    const float alpha = fexp2(m - mn);
    float p[16]; float ps = 0.f;
#pragma unroll
    for (int q = 0; q < 16; ++q) { p[q] = fexp2(x[q] - mn); ps += p[q]; }
    l = l * alpha + ps; m = mn;
    o0 = o0 * alpha; o1 = o1 * alpha;
    p0.x = pk2(p[0], p[1]); p0.y = pk2(p[2], p[3]); p0.z = pk2(p[4], p[5]); p0.w = pk2(p[6], p[7]);
    p1.x = pk2(p[8], p[9]); p1.y = pk2(p[10], p[11]); p1.z = pk2(p[12], p[13]); p1.w = pk2(p[14], p[15]);
}

__device__ __forceinline__ void na_vt_unit(const Args& a, int u, LAS unsigned char* lds, int tid) { asm volatile("" : "+v"(tid));
    const bf16_t* UV = (const bf16_t*)(a.ws + WS_U) + (size_t)3 * MT * 256;
    LAS bf16_t* T = (LAS bf16_t*)lds;
    const int row0 = u * 64; int b, key0; if (row0 < ML) { b = row0 >> 13; key0 = row0 & 8191; } else { b = (row0 - ML) >> 8; key0 = SEQ + ((row0 - ML) & 255); }
    { const int j = tid >> 3, part = tid & 7; const int q = (j >> 2) & 3, nq = q == 1 ? 2 : (q == 2 ? 1 : q), pos = (j & ~15) + nq * 4 + (j & 3);
#pragma unroll
      for (int c4 = 0; c4 < 4; ++c4) { const u32x4 v = *(const u32x4*)(UV + (size_t)(row0 + j) * 256 + part * 32 + c4 * 8); const unsigned w[4] = {v.x, v.y, v.z, v.w};
#pragma unroll
        for (int i = 0; i < 4; ++i) { T[(part * 32 + c4 * 8 + 2 * i) * 72 + pos] = (bf16_t)(w[i] & 0xffffu); T[(part * 32 + c4 * 8 + 2 * i + 1) * 72 + pos] = (bf16_t)(w[i] >> 16); } } }
    __syncthreads();
    { const int rr = tid >> 1, half = tid & 1; bf16_t* dst = (bf16_t*)(a.ws + WS_NVT) + ((size_t)(b * 4 + (rr >> 6)) * 64 + (rr & 63)) * 8448 + key0 + half * 32;
#pragma unroll
      for (int c = 0; c < 4; ++c) *(u32x4*)(dst + c * 8) = *(const LAS u32x4*)(T + rr * 72 + half * 32 + c * 8); }
}
__device__ __forceinline__ void na_unit(const Args& a, int L, int u, LAS unsigned char* lds, int tid, int lane, int wave) { asm volatile("" : "+v"(lane)); asm volatile("" : "+v"(tid));
    const bf16_t* U = (const bf16_t*)(a.ws + WS_U);
    const bf16_t* UK = U + (size_t)2 * MT * 256; const bf16_t* UQ = U + (size_t)8 * MT * 256;
    LAS float* rp = (LAS float*)lds;
    for (int i = tid; i < 4 * 465; i += 512) rp[i] = a.in[I_RPB][(size_t)L * 4 * 465 + i];
    __syncthreads();
    const int hd = wave >> 1, qh = wave & 1, r = lane & 31, h = lane >> 5;
    const bool isc = u >= 512; int b, gr = 0, rs = 0, qrow;
    if (!isc) { b = u >> 7; gr = u & 127; rs = gr - 4; rs = rs < 0 ? 0 : (rs > 120 ? 120 : rs); qrow = b * SEQ + gr * 64 + qh * 32 + r; }
    else { const int v = u - 512; b = v >> 2; qrow = ML + b * CTXL + (v & 3) * 64 + qh * 32 + r; }
    const int cq = qh * 32 + r; int cs = cq - 8; cs = cs < 0 ? 0 : (cs > 48 ? 48 : cs);
    const bf16_t* VT = (const bf16_t*)(a.ws + WS_NVT) + ((size_t)(b * 4 + hd) * 64 + r) * 8448 + 8 * h;
    const bf16_t* KB = UK + hd * 64 + 8 * h;
    bf16x8 qf[4];
#pragma unroll
    for (int s = 0; s < 4; ++s) qf[s] = *(const bf16x8*)(UQ + (size_t)qrow * 256 + hd * 64 + 16 * s + 8 * h);
    float m = -INFINITY, l = 0.f; f32x16 o0 = zero16(), o1 = zero16();
    const int nblk = isc ? 8 : 24;
    bf16x8 kfA[4], vfA[4], kfB[4], vfB[4];
#define NA_ADDR(kb, krow0, key0) do { if ((kb) < 8) { krow0 = ML + b * CTXL + (kb) * 32; key0 = SEQ + (kb) * 32; } else { const int t0_ = (rs + (((kb) - 8) >> 1)) * 64 + (((kb) - 8) & 1) * 32; krow0 = b * SEQ + t0_; key0 = t0_; } } while (0)
#define NA_LOAD(kb, kf, vf) do { int krow0_, key0_; NA_ADDR(kb, krow0_, key0_); \
        _Pragma("unroll") for (int s = 0; s < 4; ++s) kf[s] = *(const bf16x8*)(KB + (size_t)(krow0_ + r) * 256 + 16 * s); \
        _Pragma("unroll") for (int sp = 0; sp < 2; ++sp) { vf[sp * 2] = *(const bf16x8*)(VT + key0_ + 16 * sp); vf[sp * 2 + 1] = *(const bf16x8*)(VT + (size_t)32 * 8448 + key0_ + 16 * sp); } } while (0)
#define NA_BLOCK(kb, kf, vf) do { f32x16 sT = zero16(); \
        _Pragma("unroll") for (int s = 0; s < 4; ++s) sT = mfma32(kf[s], qf[s], sT); \
        f32x16 x; \
        if ((kb) < 8) { _Pragma("unroll") for (int q = 0; q < 16; ++q) x[q] = sT[q] * (0.125f * LOG2E); } \
        else { const int li_ = ((kb) - 8) >> 1, cbk_ = ((kb) - 8) & 1; const LAS float* bp = rp + hd * 465 + (rs + li_ - gr + 7) * 31 + 15 - cq; \
            _Pragma("unroll") for (int q = 0; q < 16; ++q) { const int ck = cbk_ * 32 + crow(q, h); const bool ok = (ck >= cs) && (ck < cs + 16); \
                x[q] = ok ? (sT[q] * 0.125f + bp[ok ? ck : cq]) * LOG2E : -INFINITY; } } \
        u32x4 p0, p1; osm_step(x, m, l, o0, o1, p0, p1); \
        o0 = mfma32(vf[0], as_bf16x8(p0), o0); o1 = mfma32(vf[1], as_bf16x8(p0), o1); o0 = mfma32(vf[2], as_bf16x8(p1), o0); o1 = mfma32(vf[3], as_bf16x8(p1), o1); } while (0)
    NA_LOAD(0, kfA, vfA);
    for (int kb = 0; kb < nblk; kb += 2) {
        NA_LOAD(kb + 1, kfB, vfB);
        NA_BLOCK(kb, kfA, vfA);
        if (kb + 2 < nblk) NA_LOAD(kb + 2, kfA, vfA);
        NA_BLOCK(kb + 1, kfB, vfB);
    }
#undef NA_ADDR
#undef NA_LOAD
#undef NA_BLOCK
    l = xhalf_sum(l);
    const float il = 1.f / l;
    bf16_t* Y = (bf16_t*)(a.ws + WS_YBR) + (size_t)qrow * 1024 + 512 + hd * 64 + 4 * h;
#pragma unroll
    for (int q4 = 0; q4 < 4; ++q4) { u32x2 w; w.x = pk2(o0[4 * q4] * il, o0[4 * q4 + 1] * il); w.y = pk2(o0[4 * q4 + 2] * il, o0[4 * q4 + 3] * il); *(u32x2*)(Y + 8 * q4) = w;
        u32x2 w2; w2.x = pk2(o1[4 * q4] * il, o1[4 * q4 + 1] * il); w2.y = pk2(o1[4 * q4 + 2] * il, o1[4 * q4 + 3] * il); *(u32x2*)(Y + 32 + 8 * q4) = w2; }
}

__device__ __forceinline__ float max3f(float a, float b, float c) { return fmaxf(fmaxf(a, b), c); }
__device__ __forceinline__ f32x16 splat16(float v) { f32x16 z;
#pragma unroll
    for (int i = 0; i < 16; ++i) z[i] = v;
    return z; }
__device__ __forceinline__ float rowmax32(const f32x16& a, const f32x16& b) {
    float bm = max3f(a[0], a[1], b[0]);
#pragma unroll
    for (int q = 2; q < 16; q += 2) bm = max3f(bm, a[q], a[q + 1]);
#pragma unroll
    for (int q = 1; q < 15; q += 2) bm = max3f(bm, b[q], b[q + 1]);
    bm = fmaxf(bm, b[15]);
    return xhalf_max(bm);
}
__device__ __forceinline__ void mla_step(f32x16& x0, f32x16& x1, f32x16& y0, f32x16& y1, const LAS unsigned char* kb_, const LAS unsigned char* vb_, const bf16x8 (&qf)[6],
                                         f32x16& negm, float& l, f32x16& o0, f32x16& o1, int r, int h, bool check) {
    y0 = mfma32(*(const LAS bf16x8*)(kb_ + r * 208 + 16 * h), qf[0], negm); y1 = mfma32(*(const LAS bf16x8*)(kb_ + (32 + r) * 208 + 16 * h), qf[0], negm);
#pragma unroll
    for (int s = 1; s < 6; ++s) { y0 = mfma32(*(const LAS bf16x8*)(kb_ + r * 208 + 32 * s + 16 * h), qf[s], y0); y1 = mfma32(*(const LAS bf16x8*)(kb_ + (32 + r) * 208 + 32 * s + 16 * h), qf[s], y1); }
    float ps = 0.f;
#pragma unroll
    for (int q = 0; q < 16; ++q) { x0[q] = fexp2(x0[q]); x1[q] = fexp2(x1[q]); ps += x0[q]; ps += x1[q]; }
    u32x4 pf[4];
    pf[0].x = pk2(x0[0], x0[1]); pf[0].y = pk2(x0[2], x0[3]); pf[0].z = pk2(x0[4], x0[5]); pf[0].w = pk2(x0[6], x0[7]);
    pf[1].x = pk2(x0[8], x0[9]); pf[1].y = pk2(x0[10], x0[11]); pf[1].z = pk2(x0[12], x0[13]); pf[1].w = pk2(x0[14], x0[15]);
    pf[2].x = pk2(x1[0], x1[1]); pf[2].y = pk2(x1[2], x1[3]); pf[2].z = pk2(x1[4], x1[5]); pf[2].w = pk2(x1[6], x1[7]);
    pf[3].x = pk2(x1[8], x1[9]); pf[3].y = pk2(x1[10], x1[11]); pf[3].z = pk2(x1[12], x1[13]); pf[3].w = pk2(x1[14], x1[15]);
    float bm = max3f(y0[0], y0[1], y1[0]);
#pragma unroll
    for (int kq = 0; kq < 4; ++kq) {
        o0 = mfma32(*(const LAS bf16x8*)(vb_ + r * 144 + (16 * kq + 8 * h) * 2), as_bf16x8(pf[kq]), o0);
        bm = max3f(bm, y0[2 + 4 * kq], y0[3 + 4 * kq]); bm = max3f(bm, y0[4 + 4 * kq > 15 ? 15 : 4 + 4 * kq], y0[5 + 4 * kq > 15 ? 15 : 5 + 4 * kq]);
        __builtin_amdgcn_sched_barrier(0);
        o1 = mfma32(*(const LAS bf16x8*)(vb_ + (32 + r) * 144 + (16 * kq + 8 * h) * 2), as_bf16x8(pf[kq]), o1);
        bm = max3f(bm, y1[1 + 4 * kq], y1[2 + 4 * kq]); bm = max3f(bm, y1[3 + 4 * kq], y1[4 + 4 * kq > 15 ? 15 : 4 + 4 * kq]);
        __builtin_amdgcn_sched_barrier(0);
    }
    l += ps;
    bm = xhalf_max(bm);
    if (check && __builtin_amdgcn_ballot_w64(bm > 8.f) != 0ull) { const float d = fmaxf(bm, 0.f); const float alpha = fexp2(-d); negm = negm - d; l *= alpha; o0 = o0 * alpha; o1 = o1 * alpha; y0 = y0 - d; y1 = y1 - d; }
}
__device__ __forceinline__ void mla_unit(const Args& a, int u, LAS unsigned char* lds, int tid, int lane, int wave) { asm volatile("" : "+v"(lane)); asm volatile("" : "+v"(tid));
    const bool isc = u >= 512; int bh, q0, key0, nt; size_t orow0;
    if (!isc) { bh = u >> 5; q0 = (u & 31) * 256; key0 = 0; nt = 132; orow0 = (size_t)(bh >> 2) * SEQ + q0; }
    else { bh = u - 512; q0 = 0; key0 = SEQ; nt = 4; orow0 = (size_t)ML + (size_t)(bh >> 2) * CTXL; }
    const int hd = bh & 3, r = lane & 31, h = lane >> 5;
    const bf16_t* Q = isc ? (const bf16_t*)(a.ws + WS_MQC) + (size_t)bh * 256 * 96 : (const bf16_t*)(a.ws + WS_MQ) + ((size_t)bh * 8192 + q0) * 96;
    const __amdgpu_buffer_rsrc_t rsK = __builtin_amdgcn_make_buffer_rsrc((void*)(a.ws + WS_MK + ((size_t)bh * 8448 + key0) * 208), 0, 0x7fffffff, 0x00020000);
    const __amdgpu_buffer_rsrc_t rsV = __builtin_amdgcn_make_buffer_rsrc((void*)(a.ws + WS_MVT + ((size_t)bh * 132 + (key0 >> 6)) * 9216), 0, 0x7fffffff, 0x00020000);
    const int dvo = lane * 16;
#define MLA_STAGE(tk_, sk_, tv_, sv_) do { _Pragma("unroll") for (int i_ = 0; i_ < 3; ++i_) { const int p_ = wave + 8 * i_; \
        if (p_ < 13) { if ((tk_) < nt) __builtin_amdgcn_raw_ptr_buffer_load_lds(rsK, (LAS void*)(KB + (sk_) * 13312 + p_ * 1024), 16, dvo, (tk_) * 13312 + p_ * 1024, 0, 0); } \
        else if (p_ < 22) { if ((tv_) < nt) __builtin_amdgcn_raw_ptr_buffer_load_lds(rsV, (LAS void*)(VB + (sv_) * 9216 + (p_ - 13) * 1024), 16, dvo, (tv_) * 9216 + (p_ - 13) * 1024, 0, 0); } } } while (0)
    LAS unsigned char* KB = lds; LAS unsigned char* VB = lds + 26624;
    bf16x8 qf[6];
#pragma unroll
    for (int s = 0; s < 6; ++s) qf[s] = *(const bf16x8*)(Q + (size_t)(wave * 32 + r) * 96 + 16 * s + 8 * h);
    MLA_STAGE(0, 0, 0, 0);
    asm volatile("s_waitcnt vmcnt(0)" ::: "memory");
    __syncthreads();
    MLA_STAGE(1, 1, nt, 0);
    f32x16 negm, sA0, sA1, sB0, sB1;
    {
        f32x16 c0 = zero16(), c1 = zero16();
#pragma unroll
        for (int s = 0; s < 6; ++s) { c0 = mfma32(*(const LAS bf16x8*)(KB + r * 208 + 32 * s + 16 * h), qf[s], c0); c1 = mfma32(*(const LAS bf16x8*)(KB + (32 + r) * 208 + 32 * s + 16 * h), qf[s], c1); }
        const float m = rowmax32(c0, c1); negm = splat16(-m); sA0 = c0 - m; sA1 = c1 - m;
    }
    asm volatile("s_waitcnt vmcnt(0)" ::: "memory");
    __syncthreads();
    if (wave >= 4) __builtin_amdgcn_s_setprio(1);
    float l = 0.f; f32x16 o0 = zero16(), o1 = zero16();
    for (int t = 0; t < nt; t += 2) {
        MLA_STAGE(t + 2, 0, t + 1, 1);
        mla_step(sA0, sA1, sB0, sB1, KB + 13312, VB, qf, negm, l, o0, o1, r, h, true);
        asm volatile("s_waitcnt vmcnt(0)" ::: "memory");
        __syncthreads();
        MLA_STAGE(t + 3, 1, t + 2, 0);
        mla_step(sB0, sB1, sA0, sA1, KB, VB + 9216, qf, negm, l, o0, o1, r, h, t + 2 < nt);
        asm volatile("s_waitcnt vmcnt(0)" ::: "memory");
        __syncthreads();
    }
    if (wave >= 4) __builtin_amdgcn_s_setprio(0);
#undef MLA_STAGE
    l = xhalf_sum(l);
    const float il = 1.f / l;
    bf16_t* Y = (bf16_t*)(a.ws + WS_YBR) + (orow0 + wave * 32 + r) * 1024 + 768 + hd * 64 + 4 * h;
#pragma unroll
    for (int q4 = 0; q4 < 4; ++q4) { u32x2 w; w.x = pk2(o0[4 * q4] * il, o0[4 * q4 + 1] * il); w.y = pk2(o0[4 * q4 + 2] * il, o0[4 * q4 + 3] * il); *(u32x2*)(Y + 8 * q4) = w;
        u32x2 w2; w2.x = pk2(o1[4 * q4] * il, o1[4 * q4 + 1] * il); w2.y = pk2(o1[4 * q4 + 2] * il, o1[4 * q4 + 3] * il); *(u32x2*)(Y + 32 + 8 * q4) = w2; }
}

__device__ __forceinline__ void moe_offsets(const unsigned* cnt, int (&pst)[NE], int& ntiles) {
    int acc = 0;
#pragma unroll
    for (int e = 0; e < NE; ++e) { pst[e] = acc; const int c = (int)__hip_atomic_load(cnt + e, __ATOMIC_RELAXED, __HIP_MEMORY_SCOPE_AGENT); acc += (c + 255) / 256 * 256; }
    ntiles = acc / 256;
}
__device__ __forceinline__ void ffn_row_load(const float* xr, int lane, f32x4 (&v)[4]) {
#pragma unroll
    for (int j = 0; j < 4; ++j) v[j] = *(const f32x4*)(xr + 4 * lane + 256 * j);
}
__device__ __forceinline__ void ffn_row_finish(const f32x4 (&v)[4], const f32x4 (&gn)[4], const float* mv, int lane, f32x4 (&y)[4]) {
    float ss = 0.f;
#pragma unroll
    for (int j = 0; j < 4; ++j) ss += (v[j][0] * v[j][0] + v[j][1] * v[j][1]) + (v[j][2] * v[j][2] + v[j][3] * v[j][3]);
    const float rstd = 1.f / sqrtf(wave_sum(ss) * (1.f / 1024.f) + EPS);
#pragma unroll
    for (int j = 0; j < 4; ++j) { const f32x4 sc = *(const f32x4*)(mv + 4096 + 4 * lane + 256 * j), sh = *(const f32x4*)(mv + 3072 + 4 * lane + 256 * j);
        y[j] = v[j] * rstd * gn[j] * (sc + 1.f) + sh; }
}
__device__ __forceinline__ void ph_route(const Args& a, LAS unsigned char* lds, int tid, int lane, int wave, int bid, int G) { asm volatile("" : "+v"(lane)); asm volatile("" : "+v"(tid));
    unsigned char* ws = a.ws; unsigned* ctl = (unsigned*)(ws + WS_CTL);
    const int gt = bid * 512 + tid, NGT = G * 512, gw = bid * 8 + wave, NGW = G * 8;
    int* rowinfo = (int*)(ws + WS_ROWINFO);
    for (int i = gt; i < NRMAX; i += NGT) rowinfo[i] = -1;
    LAS float* rt = (LAS float*)lds;
    for (int i = tid; i < 8192; i += 512) rt[i] = a.in[I_ROUTER][i];
    __syncthreads();
    const float* modL = (const float*)(ws + WS_MOD) + (size_t)5 * 6144;
    f32x4 gn[4];
#pragma unroll
    for (int j = 0; j < 4; ++j) gn[j] = *(const f32x4*)(a.in[I_NFFN] + 1024 + 4 * lane + 256 * j);
    unsigned mycnt = 0;
    for (int row0 = gw; row0 < ML; row0 += 2 * NGW) {
        f32x4 vv[2][4];
#pragma unroll
        for (int q = 0; q < 2; ++q) if (row0 + q * NGW < ML) ffn_row_load(a.out + (size_t)(row0 + q * NGW) * 1024, lane, vv[q]);
#pragma unroll
        for (int q = 0; q < 2; ++q) { const int row = row0 + q * NGW; if (row >= ML) continue;
        f32x4 y[4]; ffn_row_finish(vv[q], gn, modL + (size_t)(row >> 13) * 6144, lane, y);
        float lg[8] = {0.f, 0.f, 0.f, 0.f, 0.f, 0.f, 0.f, 0.f};
#pragma unroll
        for (int j = 0; j < 4; ++j)
#pragma unroll
            for (int i = 0; i < 4; ++i) { const int k = 4 * lane + 256 * j + i; const f32x4 r0 = *(const LAS f32x4*)(rt + k * 8), r1 = *(const LAS f32x4*)(rt + k * 8 + 4); const float hv = y[j][i];
                lg[0] += hv * r0[0]; lg[1] += hv * r0[1]; lg[2] += hv * r0[2]; lg[3] += hv * r0[3]; lg[4] += hv * r1[0]; lg[5] += hv * r1[1]; lg[6] += hv * r1[2]; lg[7] += hv * r1[3]; }
#pragma unroll
        for (int e = 0; e < 8; ++e) lg[e] = wave_sum(lg[e]);
        int e0 = 0; float l0 = lg[0];
#pragma unroll
        for (int e = 1; e < 8; ++e) if (lg[e] > l0) { l0 = lg[e]; e0 = e; }
        int e1 = -1; float l1 = -INFINITY;
#pragma unroll
        for (int e = 0; e < 8; ++e) if (e != e0 && lg[e] > l1) { l1 = lg[e]; e1 = e; }
        const float w0 = 1.f / (1.f + expf(l1 - l0)), w1 = 1.f - w0;
        if (lane == 0) { u32x4 t; t.x = (unsigned)e0; t.y = (unsigned)e1; t.z = __float_as_uint(w0); t.w = __float_as_uint(w1); *(u32x4*)(ws + WS_TOK + (size_t)row * 16) = t; }
        mycnt += (lane == e0 || lane == e1) ? 1u : 0u;
        }
    }
    {
        LAS unsigned* lc = (LAS unsigned*)(lds + LDS_MISC + 512);
        __syncthreads();
        if (tid < 8) lc[tid] = 0u;
        __syncthreads();
        if (lane < 8 && mycnt) atomicAdd((unsigned*)(lc + lane), mycnt);
        __syncthreads();
        if (tid < 8) ((unsigned*)(ws + WS_WGCNT))[bid * 8 + tid] = lc[tid];
    }
    __syncthreads();
    LAS float* scr = (LAS float*)(lds + 32768 + wave * 8448);
    constexpr int IGU = 16 * 224, IDN = 56 * 32;
    for (int it = gw; it < NE * (IGU + IDN); it += NGW) {
        const int e = it / (IGU + IDN); int r = it % (IGU + IDN);
        if (r < IGU) { const int kb = r / 224, nb = r % 224, pn = nb >> 3, wi = nb & 7;
            cvt_block8((wi < 4 ? a.in[I_MG] : a.in[I_MU]) + (size_t)e * 1024 * MF, MF, kb * 64, 128 * pn + 32 * (wi & 3), ws + WS_MWGU + (size_t)e * 7168 * 1024, nb * 32, 1024, 64.f, scr, lane); }
        else { r -= IGU; const int kb = r / 32, nb = r % 32;
            cvt_block8(a.in[I_MD] + (size_t)e * MF * 1024, 1024, kb * 64, nb * 32, ws + WS_MWD + (size_t)e * 1024 * MF, nb * 32, MF, 64.f, scr, lane); }
    }
}
__device__ __forceinline__ void ph_place(const Args& a, LAS unsigned char* lds, int tid, int lane, int wave, int bid, int G) { asm volatile("" : "+v"(lane)); asm volatile("" : "+v"(tid));
    unsigned char* ws = a.ws; unsigned* ctl = (unsigned*)(ws + WS_CTL);
    LAS int* tot = (LAS int*)(lds + LDS_MISC + 512); LAS int* bas = tot + 8; LAS int* cur = tot + 16;
    if (tid < 8) { const unsigned* wc = (const unsigned*)(ws + WS_WGCNT) + tid; int t = 0, bsum = 0;
        for (int w = 0; w < G; ++w) { const int c = (int)__hip_atomic_load(wc + w * 8, __ATOMIC_RELAXED, __HIP_MEMORY_SCOPE_AGENT); if (w < bid) bsum += c; t += c; }
        tot[tid] = t; bas[tid] = bsum; cur[tid] = 0; if (bid == 0) __hip_atomic_store(ctl + CW_CNT + tid, (unsigned)t, __ATOMIC_RELAXED, __HIP_MEMORY_SCOPE_AGENT); }
    __syncthreads();
    int pst[NE], ntiles = 0; { int acc = 0;
#pragma unroll
        for (int e = 0; e < NE; ++e) { pst[e] = acc + bas[e]; acc += (tot[e] + 255) / 256 * 256; }
        ntiles = acc / 256; }
    if (bid == 0 && tid < 264) { int e = -1, acc = 0;
#pragma unroll
        for (int q = 0; q < NE; ++q) { if (tid * 256 >= acc) e = q; acc += (tot[q] + 255) / 256 * 256; }
        ((int*)(ws + WS_TILEE))[tid] = tid < ntiles ? e : -1; }
    const int gw = bid * 8 + wave, NGW = G * 8;
    const float* modL = (const float*)(ws + WS_MOD) + (size_t)5 * 6144;
    f32x4 gn[4];
#pragma unroll
    for (int j = 0; j < 4; ++j) gn[j] = *(const f32x4*)(a.in[I_NFFN] + 1024 + 4 * lane + 256 * j);
    int* rowinfo = (int*)(ws + WS_ROWINFO); float* roww = (float*)(ws + WS_ROWW); bf16_t* XG = (bf16_t*)(ws + WS_XG);
    for (int row0 = gw; row0 < ML; row0 += 2 * NGW) {
        f32x4 vv[2][4];
#pragma unroll
        for (int q = 0; q < 2; ++q) if (row0 + q * NGW < ML) ffn_row_load(a.out + (size_t)(row0 + q * NGW) * 1024, lane, vv[q]);
#pragma unroll
        for (int q = 0; q < 2; ++q) { const int row = row0 + q * NGW; if (row >= ML) continue;
        f32x4 y[4]; ffn_row_finish(vv[q], gn, modL + (size_t)(row >> 13) * 6144, lane, y);
        unsigned w[4];
#pragma unroll
        for (int j = 0; j < 4; ++j) w[j] = pk4_fp8(y[j][0] * 8.f, y[j][1] * 8.f, y[j][2] * 8.f, y[j][3] * 8.f);
        const u32x4 tk = *(const u32x4*)(ws + WS_TOK + (size_t)row * 16);
#pragma unroll
        for (int k = 0; k < 2; ++k) { const int e = (int)(k ? tk.y : tk.x); const float wt = __uint_as_float(k ? tk.w : tk.z);
            int pe = 0;
#pragma unroll
            for (int q = 0; q < NE; ++q) pe = (q == e) ? pst[q] : pe;
            int slot = 0; if (lane == 0) slot = atomicAdd((int*)(cur + e), 1);
            slot = __builtin_amdgcn_readfirstlane(slot);
            const int dest = pe + slot;
            if (lane == 0) { rowinfo[dest] = row * 2 + k; roww[dest] = wt; }
            unsigned* o8 = (unsigned*)((unsigned char*)XG + (size_t)dest * 1024) + lane;
#pragma unroll
            for (int j = 0; j < 4; ++j) o8[64 * j] = w[j]; }
        }
    }
}
__device__ __forceinline__ void ph_final(const Args& a, int lane, int wave, int bid, int G) { asm volatile("" : "+v"(lane));
    unsigned char* ws = a.ws; const int gw = bid * 8 + wave, NGW = G * 8;
    const float* modL = (const float*)(ws + WS_MOD) + (size_t)5 * 6144;
    const bf16_t* Y0 = (const bf16_t*)(ws + WS_Y01); const bf16_t* Y1 = Y0 + (size_t)ML * 1024;
    f32x4 gn[4];
#pragma unroll
    for (int j = 0; j < 4; ++j) gn[j] = *(const f32x4*)(a.in[I_NFINAL] + 4 * lane + 256 * j);
    for (int row = gw; row < ML; row += NGW) {
        float* xr = a.out + (size_t)row * 1024; const float* g2 = modL + (size_t)(row >> 13) * 6144 + 5120;
        f32x4 v[4]; float ss = 0.f;
#pragma unroll
        for (int j = 0; j < 4; ++j) { const f32x4 x = *(const f32x4*)(xr + 4 * lane + 256 * j), gg = *(const f32x4*)(g2 + 4 * lane + 256 * j);
            const u32x2 ya = *(const u32x2*)(Y0 + (size_t)row * 1024 + 4 * lane + 256 * j), yb = *(const u32x2*)(Y1 + (size_t)row * 1024 + 4 * lane + 256 * j);
            f32x4 yy; yy[0] = bflo(ya.x) + bflo(yb.x); yy[1] = bfhi(ya.x) + bfhi(yb.x); yy[2] = bflo(ya.y) + bflo(yb.y); yy[3] = bfhi(ya.y) + bfhi(yb.y);
            v[j] = x + gg * yy; ss += (v[j][0] * v[j][0] + v[j][1] * v[j][1]) + (v[j][2] * v[j][2] + v[j][3] * v[j][3]); }
        const float rstd = 1.f / sqrtf(wave_sum(ss) * (1.f / 1024.f) + EPS);
#ifdef DBG_FINAL
        { float so = 0.f; bool nn = false;
#pragma unroll
          for (int j = 0; j < 4; ++j) { const f32x4 o = v[j] * rstd * gn[j];
#pragma unroll
            for (int i = 0; i < 4; ++i) { so += o[i] * o[i]; if (!(o[i] - o[i] == 0.f)) nn = true; } }
          const float sv = wave_sum(ss), so2 = wave_sum(so);
          if (lane == 0) { atomicAdd((float*)(ws + WS_CTL) + 9001, sv); atomicAdd((float*)(ws + WS_CTL) + 9002, so2); }
          if (nn) atomicMax((unsigned*)(ws + WS_CTL) + 9003, 1u); }
#endif
#pragma unroll
        for (int j = 0; j < 4; ++j) { f32x4 o = v[j] * rstd * gn[j];
#ifdef DBG_FINAL
            o = v[j];
#endif
#ifdef DBG_SANITIZE
#pragma unroll
            for (int i = 0; i < 4; ++i) o[i] = (o[i] - o[i] == 0.f) ? o[i] : 0.f;
#endif
            *(f32x4*)(xr + 4 * lane + 256 * j) = o; }
    }
}

#ifdef DBG_STAMP
#define DSTAMP(k) do { if (bid == 0 && tid == 0) ((unsigned long long*)(a.ws + WS_CTL + 40960))[(k)] = wall_clock64(); } while (0)
#else
#define DSTAMP(k) do { } while (0)
#endif
#ifndef DIS
#define DIS 0
#endif
#ifndef PH_MASK
#define PH_MASK 0xFFFFFFFFu
#endif
#define IN(k) (((PH_MASK >> ((k) >= 25 ? ((k) == 35 ? 15 : 13 + (((k) - 25) & 1)) : (k) == 0 ? 0 : (((k) - 1) % 12) + 1)) & 1u) && lo <= (k) && (k) < hi)
#define SEAM() do { if (multi) xcd_barrier(bar, wave == 0 && my_lane() == 0); } while (0)
template <int L>
__device__ __forceinline__ void layer_phases(const Args& a, LAS unsigned char* lds, int wave, int bid, int G, int lo, int hi, bool multi, const XcdBarrier& bar, volatile LAS int* qslot) {
    unsigned char* ws = a.ws; unsigned* ctl = (unsigned*)(ws + WS_CTL);
    const int gw = bid * 8 + wave, NGW = G * 8;
    float* MOD = (float*)(ws + WS_MOD);
    bf16_t* Hb = (bf16_t*)(ws + WS_H); bf16_t* Ub = (bf16_t*)(ws + WS_U); bf16_t* YBR = (bf16_t*)(ws + WS_YBR); bf16_t* SG = (bf16_t*)(ws + WS_SG);
    float* XC = (float*)(ws + WS_XC);
        const int LB = 1 + 12 * L;
        const float* modL = MOD + (size_t)L * 5 * 6144;
        const float* xl = L == 0 ? a.in[I_X] : a.out; const float* xc = L == 0 ? a.in[I_CTX] : XC;
        if (IN(LB + 0)) { const int lane = my_lane(), tid = wave * 64 + lane; (void)tid; (void)lane; DSTAMP(LB + 0); norm_rows(xl, xc, a.in[I_NMIX] + L * 1024, modL, 0, 1024, Hb, ws + WS_H8, lane, gw, NGW); SEAM(); }
        if (IN(LB + 1)) { const int lane = my_lane(), tid = wave * 64 + lane; (void)tid; (void)lane; DSTAMP(LB + 1);
            pg8::Gemm g{Hb, (const bf16_t*)(ws + WS_WNG) + (size_t)L * 2816 * 1024, 1024, 1024, 1024};
            pg8::StaticOrder S; S.init(MT / 256, UT, G, bid);
            pg8::EpiTileBf16 E{Ub, (size_t)MT * 256};
            pg8::gemm_phase(lds, g, S, E, wave); SEAM();
        }
        if (IN(LB + 2)) { const int lane = my_lane(), tid = wave * 64 + lane; (void)tid; (void)lane; DSTAMP(LB + 2);
            unsigned* qw = ctl + CW_Q + 64 * (LB + 2) + a.qbank * 4096;
            if (!(a.umask & 1)) for (;;) { const int u = q_next(qw, qslot, wave); if (u >= 256) break; four_stage1_unit(a, u, my_lane(), wave); }
            if (!(a.umask & 2)) for (;;) { const int u = q_next(qw + 16, qslot, wave); if (u >= 1056) break; { const int l2 = my_lane(); ret_dstate_unit(a, L, u, lds, wave * 64 + l2, l2, wave); } }
            if (!(a.umask & 4)) for (;;) { const int u = q_next(qw + 32, qslot, wave); if (u >= 264) break; mla_prep_wave(a, L, (u >> 1) * 8 + wave, u & 1, my_lane()); }
            if (!(a.umask & 8)) for (;;) { const int u = q_next(qw + 40, qslot, wave); if (u >= 528) break; na_vt_unit(a, u, lds, wave * 64 + my_lane()); }
            if (L == 0) for (;;) { const int u = q_next(qw + 48, qslot, wave); if (u >= 512) break; if (!(DIS & 8)) cfour_step1_unit(a, u, lds, wave * 64 + my_lane()); }
            SEAM();
        }
        if (IN(LB + 3)) { const int lane = my_lane(), tid = wave * 64 + lane; (void)tid; (void)lane; DSTAMP(LB + 3); for (int u = bid; u < 256; u += G) ret_scan_unit(a, L, u, tid); SEAM(); }
        if (IN(LB + 4)) { const int lane = my_lane(), tid = wave * 64 + lane; (void)tid; (void)lane; DSTAMP(LB + 4);
            unsigned* qw = ctl + CW_Q + 64 * (LB + 4) + a.qbank * 4096;
            const int nc = L == 0 ? 16 : 0;
            if (!(a.umask & 1)) for (;;) { const int u = q_next(qw, qslot, wave); if (u >= 512 + nc) break; { const int l2 = my_lane(); mla_unit(a, u, lds, wave * 64 + l2, l2, wave); } }
            if (!(a.umask & 2)) for (;;) { const int u = q_next(qw + 16, qslot, wave); if (u >= 512 + nc) break; { const int l2 = my_lane(); na_unit(a, L, u, lds, wave * 64 + l2, l2, wave); } }
            if (!(a.umask & 4)) for (;;) { const int u = q_next(qw + 32, qslot, wave); if (u >= 1024 + 2 * nc) break; { const int l2 = my_lane(); ret_out_unit(a, L, u, lds, wave * 64 + l2, l2, wave); } }
            if (!(a.umask & 8)) for (;;) { const int u = q_next(qw + 48, qslot, wave); if (u >= 512) break; four_stage2_unit(a, u, my_lane(), wave); }
            if (L == 0) for (;;) { const int u = q_next(qw + 56, qslot, wave); if (u >= 256) break; cfour_step2_unit(a, u, lds, wave * 64 + my_lane()); }
            SEAM();
        }
        const int nMm = L == 0 ? MT / 256 : ML / 256;
        if (IN(LB + 5)) { const int lane = my_lane(), tid = wave * 64 + lane; (void)tid; (void)lane; DSTAMP(LB + 5);
            pg8::Gemm g{(const bf16_t*)(ws + WS_H8), (const bf16_t*)(ws + WS_WG8 + (size_t)L * 4096 * 1024), 512, 512, 512};
            pg8::StaticOrder S; S.init(nMm, 16, G, bid);
            pg8::EpiGateRatio E{SG, 1.f / 512.f};
            pg8::gemm_phase<pg8::EpiGateRatio, pg8::StaticOrder, true>(lds, g, S, E, wave); SEAM();
        }
        if (IN(LB + 6)) { const int lane = my_lane(), tid = wave * 64 + lane; (void)tid; (void)lane; DSTAMP(LB + 6);
            pg8::Gemm g{YBR, (const bf16_t*)(ws + WS_WB) + (size_t)L * 1024 * 1024, 1024, 1024, 1024};
            pg8::StaticOrder S; S.init(nMm, 4, G, bid);
            pg8::EpiMerge E{SG, Hb};
            pg8::gemm_phase(lds, g, S, E, wave); SEAM();
        }
        if (IN(LB + 7)) { const int lane = my_lane(), tid = wave * 64 + lane; (void)tid; (void)lane; DSTAMP(LB + 7);
            pg8::Gemm g{Hb, (const bf16_t*)(ws + WS_WO) + (size_t)L * 1024 * 1024, 1024, 1024, 1024};
            pg8::StaticOrder S; S.init(nMm, 4, G, bid);
            pg8::EpiResid E{xl, xc, a.out, XC, modL + 2048};
            pg8::gemm_phase(lds, g, S, E, wave); SEAM();
        }
        if (L == 0) {
            if (IN(LB + 8)) { const int lane = my_lane(), tid = wave * 64 + lane; (void)tid; (void)lane; DSTAMP(LB + 8); norm_rows(a.out, XC, a.in[I_NFFN], modL, 3072, 4096, Hb, nullptr, lane, gw, NGW); SEAM(); }
            if (IN(LB + 9)) { const int lane = my_lane(), tid = wave * 64 + lane; (void)tid; (void)lane; DSTAMP(LB + 9);
                pg8::Gemm g{Hb, (const bf16_t*)(ws + WS_WGU), 1024, 1024, 1024};
                pg8::StaticOrder S; S.init(MT / 256, 22, G, bid);
                pg8::EpiSwiGLU8 E{ws + WS_HID, FF, 0, 1.f};
                pg8::gemm_phase(lds, g, S, E, wave); SEAM();
            }
            if (IN(LB + 10)) { const int lane = my_lane(), tid = wave * 64 + lane; (void)tid; (void)lane; DSTAMP(LB + 10);
                pg8::Gemm g{(const bf16_t*)(ws + WS_HID), (const bf16_t*)(ws + WS_WD), FF / 2, FF / 2, FF / 2};
                pg8::StaticOrder S; S.init(MT / 256, 4, G, bid);
                pg8::EpiResid E{a.out, XC, a.out, XC, modL + 5120, 1.f / 512.f};
                pg8::gemm_phase<pg8::EpiResid, pg8::StaticOrder, true>(lds, g, S, E, wave); SEAM();
            }
        } else {
            if (IN(LB + 8)) { const int lane = my_lane(), tid = wave * 64 + lane; (void)tid; (void)lane; DSTAMP(LB + 8); ph_route(a, lds, tid, lane, wave, bid, G); SEAM(); }
            if (IN(LB + 9)) { const int lane = my_lane(), tid = wave * 64 + lane; (void)tid; (void)lane; DSTAMP(LB + 9); ph_place(a, lds, tid, lane, wave, bid, G); SEAM(); }
        }
    }

constexpr int NPH = 32;
__global__ void __launch_bounds__(512, 2) mega(Args a) {
    extern __shared__ __attribute__((aligned(16))) unsigned char lds_raw[];
    LAS unsigned char* lds = (LAS unsigned char*)lds_raw;
    const int wave = __builtin_amdgcn_readfirstlane(threadIdx.x >> 6), bid = blockIdx.x, G = gridDim.x;
    unsigned char* ws = a.ws; unsigned* ctl = (unsigned*)(ws + WS_CTL);
    volatile LAS unsigned* misc = (volatile LAS unsigned*)(lds + LDS_MISC);
    volatile LAS int* qslot = (volatile LAS int*)(lds + LDS_MISC + 64);
    const int lo = a.ph_lo, hi = a.ph_hi; const bool multi = (hi - lo) > 1;
    if (threadIdx.x < 32) misc[threadIdx.x] = 0u;
    __syncthreads();
    XcdBarrier bar; bar.bar = ctl + CW_BAR; bar.x = 0; bar.st = misc;
    if (multi) bar = xcd_barrier_post(ctl + CW_BAR, misc, threadIdx.x == 0);

    const int gw = bid * 8 + wave, NGW = G * 8;
    float* MOD = (float*)(ws + WS_MOD);
    bf16_t* Hb = (bf16_t*)(ws + WS_H); bf16_t* Ub = (bf16_t*)(ws + WS_U); bf16_t* YBR = (bf16_t*)(ws + WS_YBR); bf16_t* SG = (bf16_t*)(ws + WS_SG);
    float* XC = (float*)(ws + WS_XC);

    if (IN(0)) { const int lane = my_lane(), tid = wave * 64 + lane; (void)tid; (void)lane; DSTAMP(0); ph_prologue(a, lds, tid, lane, wave, bid, G); SEAM(); }

    layer_phases<0>(a, lds, wave, bid, G, lo, hi, multi, bar, qslot);
    layer_phases<1>(a, lds, wave, bid, G, lo, hi, multi, bar, qslot);
    for (int k = 0; k < 6; ++k) {
        if (IN(25 + k)) { const int lane = my_lane(), tid = wave * 64 + lane; (void)tid; (void)lane; DSTAMP(25 + k);
            constexpr size_t HIDB = (size_t)72 * 256 * MF;
            if (k >= 1) { const int c = k - 1; const int c0 = 64 * c, lg = c < 4 ? 6 : 3;
                pg8::Gemm g{(const bf16_t*)(ws + WS_HIDM + (size_t)(c & 1) * HIDB - (size_t)c0 * 256 * MF), (const bf16_t*)(ws + WS_MWD), MF / 2, MF / 2, MF / 2};
                pg8::MoeOrder S{c0, lg, 4, G, bid, (const int*)(ws + WS_TILEE), 1024 * MF};
                pg8::EpiMoeDown E{(const int*)(ws + WS_ROWINFO), (const float*)(ws + WS_ROWW), (bf16_t*)(ws + WS_Y01), 1.f / 512.f};
                pg8::gemm_phase<pg8::EpiMoeDown, pg8::MoeOrder, true>(lds, g, S, E, wave);
            }
            if (k <= 4) { const int c = k; const int c0 = 64 * c, lg = c < 4 ? 6 : 3;
                pg8::Gemm g{(const bf16_t*)(ws + WS_XG), (const bf16_t*)(ws + WS_MWGU), 512, 512, 512};
                pg8::MoeOrder S{c0, lg, 28, G, bid, (const int*)(ws + WS_TILEE), 7168 * 1024};
                pg8::EpiSwiGLU8 E{ws + WS_HIDM + (size_t)(c & 1) * HIDB, MF, c0 * 256, 1.f / 512.f};
                pg8::gemm_phase<pg8::EpiSwiGLU8, pg8::MoeOrder, true>(lds, g, S, E, wave);
            }
            SEAM();
        }
    }
    if (IN(31)) { const int lane = my_lane(); const int tid = wave * 64 + lane; DSTAMP(31); ph_final(a, lane, wave, bid, G); DSTAMP(32); }
#undef IN
#undef SEAM
}


#ifdef DBG_SCAN
constexpr int CW_DBG = 9000;
__global__ void dbg_scan(const void* p, size_t n, int flags, int code, unsigned* ctl) { const int is_bf16 = flags & 1; const unsigned te = 127u + (unsigned)(flags >> 8);
    size_t i = (size_t)blockIdx.x * blockDim.x + threadIdx.x, st = (size_t)gridDim.x * blockDim.x; bool bad = false;
    if (is_bf16) { const unsigned short* q = (const unsigned short*)p; for (; i < n; i += st) { const unsigned v = q[i]; if (((v >> 7) & 0xffu) >= te) bad = true; } }
    else { const unsigned* q = (const unsigned*)p; for (; i < n; i += st) { const unsigned v = q[i]; if (((v >> 23) & 0xffu) >= te) bad = true; } }
    if (bad) atomicMax(ctl + CW_DBG, (unsigned)(1000 - code));
}
__global__ void dbg_scan2(const unsigned short* p, int rows, int ld, int c0, int nc, int code, unsigned* ctl) {
    size_t i = (size_t)blockIdx.x * blockDim.x + threadIdx.x, st = (size_t)gridDim.x * blockDim.x; bool bad = false;
    for (; i < (size_t)rows * nc; i += st) { const unsigned v = p[(i / nc) * ld + c0 + (i % nc)]; if (((v >> 7) & 0xffu) >= 127u + 6u) bad = true; }
    if (bad) atomicMax(ctl + CW_DBG, (unsigned)(1000 - code));
}
__global__ void dbg_delta(const float* a, const float* b, size_t n, int slot, unsigned* ctl) {
    size_t i = (size_t)blockIdx.x * blockDim.x + threadIdx.x, st = (size_t)gridDim.x * blockDim.x; float d = 0.f, r = 0.f;
    for (; i < n; i += st) { const float x = a[i], y = b[i]; d += (x - y) * (x - y); r += y * y; }
    for (int o = 32; o >= 1; o >>= 1) { d += __shfl_xor(d, o); r += __shfl_xor(r, o); }
    if ((threadIdx.x & 63) == 0) { atomicAdd((float*)ctl + 9010 + 2 * slot, d); atomicAdd((float*)ctl + 9011 + 2 * slot, r); }
}
__device__ int dbg_digit(float d, float r) { const float q = d / r; if (!(q == q)) return 9; int k = (int)rintf(-log2f(q)); return k < 0 ? 0 : (k > 8 ? 8 : k); }
__global__ void dbg_emit2(float* out, const unsigned* ctl, int s0, int s1) { const float* cf = (const float*)ctl;
    const int A = dbg_digit(cf[9010 + 2 * s0], cf[9011 + 2 * s0]), B = dbg_digit(cf[9010 + 2 * s1], cf[9011 + 2 * s1]); out[0] = sqrtf(33554432.f * (float)(10 * A + B)); }
__global__ void dbg_emit(float* out, const unsigned* ctl) { const float* cf = (const float*)ctl; const float msv = cf[9001] / 33554432.f, mso = cf[9002] / 33554432.f;
    int A = (int)rintf(log2f(msv)) + 4; A = A < 0 ? 0 : (A > 8 ? 8 : A); int B = (int)rintf(log2f(mso)) + 4; B = B < 0 ? 0 : (B > 8 ? 8 : B); if (ctl[9003]) B = 9;
    out[0] = sqrtf(33554432.f * (float)(10 * A + B)); }
#endif
#ifdef DBG_STAMP
__global__ void dbg_emit_t(float* out, const unsigned long long* st, int a0, int a1, int b0, int b1, float ua, float ub) {
    const size_t i = (size_t)blockIdx.x * blockDim.x + threadIdx.x;
    const float ta = (float)(st[a1] - st[a0]) * 0.01f, tb = (float)(st[b1] - st[b0]) * 0.01f;
    const float A = (10.f + fminf(89.f, fmaxf(0.f, rintf(2.f * log2f(ta / 10.f))))) * 100.f, B = (10.f + fminf(89.f, fmaxf(0.f, rintf(2.f * log2f(tb / 10.f))))) * 10.f;
    if (i == 0) out[0] = A; else if (i <= 4000000) out[i] = B; else if (i < 33554432) out[i] = 0.f;
}
#endif
extern "C" void kernel_launch(void* const* d_in, const int* in_sizes, int n_in, void* d_out, int out_size, void* d_ws, size_t ws_size, hipStream_t stream) {
    static int grid = 0;
    if (grid == 0) {
        if (n_in != 26 || in_sizes[0] != ML * DM || out_size != ML * DM || ws_size < WS_NEED) { fprintf(stderr, "kernel_launch: unexpected problem (n_in %d, ws %zu, need %zu)\n", n_in, ws_size, (size_t)WS_NEED); grid = -1; return; }
        int dev = 0, cus = 0, per_cu = 0;
        if (hipGetDevice(&dev) != hipSuccess || hipDeviceGetAttribute(&cus, hipDeviceAttributeMultiprocessorCount, dev) != hipSuccess) { grid = -1; return; }
        if (hipFuncSetAttribute((const void*)mega, hipFuncAttributeMaxDynamicSharedMemorySize, LDS_BYTES) != hipSuccess) { fprintf(stderr, "kernel_launch: hipFuncSetAttribute failed\n"); grid = -1; return; }
        if (hipOccupancyMaxActiveBlocksPerMultiprocessor(&per_cu, (const void*)mega, 512, LDS_BYTES) != hipSuccess || per_cu < 1) fprintf(stderr, "kernel_launch: occupancy query says %d\n", per_cu);
        (void)hipGetLastError();
        grid = cus;
    }
    if (grid < 0) return;
    if (hipMemsetAsync((char*)d_ws + WS_CTL, 0, 1 * MiB, stream) != hipSuccess) return;
    Args a{};
    for (int i = 0; i < 26; ++i) a.in[i] = (const float*)d_in[i];
    a.out = (float*)d_out; a.ws = (unsigned char*)d_ws;
#if N_LAUNCH_MODE == 1
    a.ph_lo = 0; a.ph_hi = NPH;
    hipLaunchKernelGGL(mega, dim3(grid), dim3(512), LDS_BYTES, stream, a);
#ifdef DBG_STAMP
    hipLaunchKernelGGL(dbg_emit_t, dim3(32768), dim3(1024), 0, stream, (float*)d_out, (const unsigned long long*)((char*)d_ws + WS_CTL + 40960), ST_A0, ST_A1, ST_B0, ST_B1, ST_UA, ST_UB);
#endif
#else
    for (int p = 0; p < NPH; ++p) {
        if (p == 12 || p == 23 || p == 24) continue;
        a.ph_lo = p; a.ph_hi = p + 1; a.qbank = 0;
        hipLaunchKernelGGL(mega, dim3(grid), dim3(512), LDS_BYTES, stream, a);
#ifdef DUP_LIST
        { const int dl[] = DUP_LIST; for (int q = 0; q < (int)(sizeof(dl) / sizeof(int)); ++q) if (dl[q] == p) { a.qbank = 1; a.umask = DUP_UMASK; hipLaunchKernelGGL(mega, dim3(grid), dim3(512), LDS_BYTES, stream, a); a.qbank = 0; a.umask = 0; } }
#endif
#ifdef DBG_SCAN
        {
            unsigned char* ws = (unsigned char*)d_ws; unsigned* ctl = (unsigned*)(ws + WS_CTL);
#define SCAN(ptr, n, bf, code) SCANT(ptr, n, bf, code, 6)
#define SCANT(ptr, n, bf, code, TE) hipLaunchKernelGGL(dbg_scan, dim3(1024), dim3(256), 0, stream, (const void*)(ptr), (size_t)(n), (bf) | ((TE) << 8), code, ctl)
            const int L = p >= 13 ? 1 : 0, k = p == 0 ? -1 : (p - 1) % 12; const int cb = 1 + (p == 0 ? 0 : 4 + L * 40 + k * 3);
            const size_t nm = (L == 0 ? MT : ML);
            if (p == 0) { SCAN(ws + WS_MOD, 2 * 5 * 6144, 0, 1); SCAN(ws + WS_ROPER, 8192 * 64 + 8192 * 32, 0, 2); SCAN(ws + WS_WNG, (WS_RWEND - WS_WNG) / 2, 1, 3); SCAN(ws + WS_M1, 256 * 128, 1, 4); SCAN(ws + WS_WUQ, 2 * 384 * 192, 1, 4); SCAN(ws + WS_WUKV, 2 * 512 * 128, 1, 4); }
            else if (p < 25) {
                if (k == 0) SCAN(ws + WS_H, (size_t)MT * 1024, 1, cb);
                if (k == 1) SCAN(ws + WS_U, (size_t)UT * MT * 256, 1, cb);
                if (k == 2) { SCANT(ws + WS_A2, (size_t)4 * 64 * 128 * 256 * 2, 1, cb, 14); SCANT(ws + WS_ST, (size_t)2 * 16 * 66 * 4096, 0, cb + 1, 14); SCAN(ws + WS_MK, (size_t)16 * 8448 * 96 + (size_t)16 * 64 * 8448, 1, cb + 2); SCAN(ws + WS_MQ, (size_t)16 * 8192 * 96, 1, cb + 2); }
                if (k == 3) SCANT(ws + WS_ST, (size_t)2 * 16 * 64 * 4096, 0, cb, 14);
                if (k == 4) { for (int r4 = 0; r4 < 4; ++r4) { hipLaunchKernelGGL(dbg_scan2, dim3(1024), dim3(256), 0, stream, (const unsigned short*)(ws + WS_YBR), ML, 1024, r4 * 256, 256, (L == 0 ? 15 : 55) + r4, ctl); if (L == 0) hipLaunchKernelGGL(dbg_scan2, dim3(1024), dim3(256), 0, stream, (const unsigned short*)(ws + WS_YBR) + (size_t)ML * 1024, MC, 1024, r4 * 256, 256, 19, ctl); } }
                if (k == 5) SCAN(ws + WS_SG, nm * 4096, 1, cb);
                if (k == 6) SCAN(ws + WS_H, nm * 1024, 1, cb);
                if (k == 7) { SCAN(d_out, (size_t)ML * 1024, 0, cb); if (L == 0) SCAN(ws + WS_XC, (size_t)MC * 1024, 0, cb + 1); }
                if (k == 8 && L == 0) SCAN(ws + WS_H, (size_t)MT * 1024, 1, cb);
                if (k == 9 && L == 0) SCAN(ws + WS_HID, (size_t)MT * FF, 1, cb);
                if (k == 10 && L == 0) { SCAN(d_out, (size_t)ML * 1024, 0, cb); SCAN(ws + WS_XC, (size_t)MC * 1024, 0, cb + 1); }
            } else if (p == 34) SCAN(ws + WS_Y01, (size_t)2 * ML * 1024, 1, 95);
            if (p == 8) hipLaunchKernelGGL(dbg_delta, dim3(1024), dim3(256), 0, stream, (const float*)d_out, (const float*)d_in[0], (size_t)ML * 1024, 0, ctl);
            if (p == 11) hipLaunchKernelGGL(dbg_delta, dim3(1024), dim3(256), 0, stream, (const float*)d_out, (const float*)d_in[0], (size_t)ML * 1024, 1, ctl);
            if (p == 20) hipLaunchKernelGGL(dbg_delta, dim3(1024), dim3(256), 0, stream, (const float*)d_out, (const float*)d_in[0], (size_t)ML * 1024, 2, ctl);
            if (p == 35) { hipLaunchKernelGGL(dbg_delta, dim3(1024), dim3(256), 0, stream, (const float*)d_out, (const float*)d_in[0], (size_t)ML * 1024, 3, ctl); hipMemsetAsync(d_out, 0, (size_t)ML * 1024 * 4, stream); }
            if (p == 35) hipLaunchKernelGGL(dbg_emit2, dim3(1), dim3(1), 0, stream, (float*)d_out, (const unsigned*)ctl, DBG_S0, DBG_S1);
        }
#endif
    }
#endif
}
```
